# Optimizing an MI355X kernel written in HIP

```python
import math
import jax, jax.numpy as jnp
from jax import lax
import numpy as np


D_MODEL = 1024
BATCH = 4
SEQ = 8192
DEPTH = 2

D_MIX = D_MODEL
D_LRU = D_MIX // 2
D_ATT = D_MIX - D_LRU
HEAD_DIM = 64
N_HEADS = D_ATT // HEAD_DIM
N_KV_GROUPS = 2
HEADS_PER_GROUP = N_HEADS // N_KV_GROUPS
KV_WIDTH = N_KV_GROUPS * HEAD_DIM
LRU_BLOCKS = 8
LRU_BLOCK_W = D_LRU // LRU_BLOCKS
LRU_C = 8.0
CONV_WIDTH = 4
CMP_BLOCK = 32
CMP_STRIDE = 16
CMP_HIDDEN = 2 * HEAD_DIM
SEL_BLOCK = 64
N_SELECT = 16
WINDOW = 512
NSA_QBLOCK = 64
N_BRANCH = 3
N_BUCKETS = 32
MAX_EXACT = N_BUCKETS // 2
MAX_DISTANCE = 128
D_FF = 2816
N_EXPERTS = 8
TOP_K = 2
MOE_BLOCK = 128
N_DENSE = (DEPTH + 1) // 2
N_MOE = DEPTH // 2
OFF_Q = 2 * D_LRU
OFF_KV = OFF_Q + D_ATT
OFF_GATE = OFF_KV + 6 * KV_WIDTH
D_IN = OFF_GATE + N_BRANCH * N_HEADS
NEG_INF = -1e30
FORCE_SCORE = 1e4
RMS_EPS = 1e-6

kernel_name = 'hybrid_rglru_nsa_moe_trunk'


def rms_norm(x, g):
    xf = x.astype(jnp.float32)
    y = xf * lax.rsqrt(jnp.mean(xf * xf, axis=-1, keepdims=True) + RMS_EPS)
    return (y * g.astype(jnp.float32)).astype(x.dtype)


def t5_bucket(dist):
    n = jnp.maximum(dist, 0)
    nf = jnp.maximum(n, 1).astype(jnp.float32)
    large = MAX_EXACT + (jnp.log(nf / MAX_EXACT) / math.log(MAX_DISTANCE / MAX_EXACT)
                         * (N_BUCKETS - MAX_EXACT)).astype(jnp.int32)
    large = jnp.minimum(large, N_BUCKETS - 1)
    return jnp.where(n < MAX_EXACT, n, large)


def masked_softmax(s, mask):
    s = jnp.where(mask, s, NEG_INF)
    m = jnp.max(s, axis=-1, keepdims=True)
    e = jnp.where(mask, jnp.exp(s - m), 0.0)
    return e / jnp.maximum(jnp.sum(e, axis=-1, keepdims=True), 1e-30)


def rg_lru(x, wa, ba, wx, bx, lam):
    b_, s_, _ = x.shape
    xb = x.reshape(b_, s_, LRU_BLOCKS, LRU_BLOCK_W)
    r = jax.nn.sigmoid(jnp.einsum('bshi,hij->bshj', xb, wa).reshape(b_, s_, D_LRU) + ba)
    i = jax.nn.sigmoid(jnp.einsum('bshi,hij->bshj', xb, wx).reshape(b_, s_, D_LRU) + bx)
    log_a = -LRU_C * r * jax.nn.softplus(-lam)
    a = jnp.exp(log_a)
    u = jnp.sqrt(-jnp.expm1(2.0 * log_a)) * (i * x)

    def combine(c1, c2):
        a1, b1 = c1
        a2, b2 = c2
        return a1 * a2, a2 * b1 + b2

    _, h = lax.associative_scan(combine, (a, u), axis=1)
    return h


def lru_group(x_in, gate_in, conv_w, conv_b, wa, ba, wx, bx, lam):
    xc = lax.conv_general_dilated(x_in, conv_w[:, None, :], window_strides=(1,),
                                  padding=[(CONV_WIDTH - 1, 0)],
                                  dimension_numbers=('NWC', 'WIO', 'NWC'),
                                  feature_group_count=D_LRU) + conv_b
    return jax.nn.gelu(gate_in) * rg_lru(xc, wa, ba, wx, bx, lam)


def compress(kv, pos, w1, w2):
    s_ = kv.shape[2]
    n_cmp = (s_ - CMP_BLOCK) // CMP_STRIDE + 1
    idx = jnp.arange(n_cmp)[:, None] * CMP_STRIDE + jnp.arange(CMP_BLOCK)[None, :]
    blocks = kv[:, :, idx] + pos
    h = jax.nn.gelu(jnp.einsum('bgnld,ldc->bgnc', blocks, w1))
    return jnp.einsum('bgnc,cd->bgnd', h, w2)


def nsa_group(q, kc_raw, vc_raw, ks_raw, vs_raw, kw_raw, vw_raw, gates,
              q_g, k_g, cmp_pos, cmp_w1, cmp_w2, rel_bias):
    b_, s_ = q.shape[:2]
    G, HPG, QB = N_KV_GROUPS, HEADS_PER_GROUP, NSA_QBLOCK
    nqb = s_ // QB
    n_sel_blocks = s_ // SEL_BLOCK
    n_sel = min(N_SELECT, n_sel_blocks)
    n_cmp = (s_ - CMP_BLOCK) // CMP_STRIDE + 1
    scale = HEAD_DIM ** -0.5

    q = rms_norm(q.reshape(b_, s_, N_HEADS, HEAD_DIM), q_g)
    q_blocks = q.reshape(b_, nqb, QB, G, HPG, HEAD_DIM).transpose(1, 0, 3, 4, 2, 5)
    g_blocks = jax.nn.sigmoid(gates).reshape(b_, nqb, QB, N_BRANCH, G, HPG).transpose(1, 0, 4, 5, 2, 3)

    def kv_heads(t):
        return t.reshape(b_, s_, G, HEAD_DIM).transpose(0, 2, 1, 3)

    kc = rms_norm(compress(kv_heads(kc_raw), cmp_pos[0], cmp_w1[0], cmp_w2[0]), k_g)
    vc = compress(kv_heads(vc_raw), cmp_pos[1], cmp_w1[1], cmp_w2[1])
    ks_blk = rms_norm(kv_heads(ks_raw), k_g).reshape(b_, G, n_sel_blocks, SEL_BLOCK, HEAD_DIM)
    vs_blk = kv_heads(vs_raw).reshape(b_, G, n_sel_blocks, SEL_BLOCK, HEAD_DIM)
    pad = ((0, 0), (0, 0), (WINDOW, 0), (0, 0))
    kw_pad = jnp.pad(rms_norm(kv_heads(kw_raw), k_g), pad)
    vw_pad = jnp.pad(kv_heads(vw_raw), pad)

    cmp_start = jnp.arange(n_cmp) * CMP_STRIDE
    cmp_end = cmp_start + CMP_BLOCK - 1
    sel_start = jnp.arange(n_sel_blocks) * SEL_BLOCK
    overlap = jnp.clip(jnp.minimum(cmp_end[:, None], sel_start[None, :] + SEL_BLOCK - 1)
                       - jnp.maximum(cmp_start[:, None], sel_start[None, :]) + 1, 0, None)
    cmp_to_sel = overlap.astype(jnp.float32) / CMP_BLOCK
    rel_bias_g = rel_bias.reshape(N_BUCKETS, G, HPG).transpose(1, 0, 2)
    gather = jax.vmap(jax.vmap(lambda kb, ix: kb[ix]))
    bias_of = jax.vmap(lambda tb, bk: tb[bk], in_axes=(0, 1), out_axes=1)

    def head_bias(dist):
        bb = rel_bias[t5_bucket(dist)]
        return bb.transpose(2, 0, 1).reshape(G, HPG, *dist.shape).astype(jnp.float32)

    def block_fn(args):
        qb, gb, qi = args
        t = qi * QB + jnp.arange(QB)
        s = jnp.einsum('bghqd,bgnd->bghqn', qb, kc).astype(jnp.float32) * scale \
            + head_bias(t[:, None] - cmp_end[None, :])
        p_cmp = masked_softmax(s, cmp_end[None, :] <= t[:, None])
        o_cmp = jnp.einsum('bghqn,bgnd->bghqd', p_cmp.astype(vc.dtype), vc)
        imp = jnp.einsum('bghqn,nj->bgqj', p_cmp, cmp_to_sel)
        blk = jnp.arange(n_sel_blocks)
        score = jnp.where(blk[None, :] == (t // SEL_BLOCK)[:, None], FORCE_SCORE,
                          jnp.where(sel_start[None, :] <= t[:, None], imp, -1.0))
        top_val, top_idx = lax.top_k(score, n_sel)
        ks = gather(ks_blk, top_idx).reshape(b_, G, QB, n_sel * SEL_BLOCK, HEAD_DIM)
        vs = gather(vs_blk, top_idx).reshape(b_, G, QB, n_sel * SEL_BLOCK, HEAD_DIM)
        pos = (top_idx[..., None] * SEL_BLOCK + jnp.arange(SEL_BLOCK)).reshape(b_, G, QB, n_sel * SEL_BLOCK)
        valid = jnp.repeat(top_val >= 0, SEL_BLOCK, axis=-1) & (pos <= t[:, None])
        bias_s = jnp.moveaxis(bias_of(rel_bias_g, t5_bucket(t[:, None] - pos)), -1, 2).astype(jnp.float32)
        s = jnp.einsum('bghqd,bgqkd->bghqk', qb, ks).astype(jnp.float32) * scale + bias_s
        p = masked_softmax(s, valid[:, :, None])
        o_slc = jnp.einsum('bghqk,bgqkd->bghqd', p.astype(vs.dtype), vs)
        kw = lax.dynamic_slice_in_dim(kw_pad, qi * QB, WINDOW + QB, axis=2)
        vw = lax.dynamic_slice_in_dim(vw_pad, qi * QB, WINDOW + QB, axis=2)
        pos_w = qi * QB - WINDOW + jnp.arange(WINDOW + QB)
        dist = t[:, None] - pos_w[None, :]
        mask_w = (pos_w[None, :] >= 0) & (dist >= 0) & (dist < WINDOW)
        s = jnp.einsum('bghqd,bgkd->bghqk', qb, kw).astype(jnp.float32) * scale + head_bias(dist)
        p = masked_softmax(s, mask_w)
        o_win = jnp.einsum('bghqk,bgkd->bghqd', p.astype(vw.dtype), vw)
        gb = gb.astype(o_cmp.dtype)
        return gb[..., 0:1] * o_cmp + gb[..., 1:2] * o_slc + gb[..., 2:3] * o_win

    o = lax.map(block_fn, (q_blocks, g_blocks, jnp.arange(nqb)))
    return o.transpose(1, 0, 4, 2, 3, 5).reshape(b_, s_, D_ATT)


def swiglu(x, w_gate, w_up, w_down):
    return (jax.nn.silu(x @ w_gate) * (x @ w_up)) @ w_down


def moe_swiglu(x2d, w_router, w_gate, w_up, w_down):
    n_tok = x2d.shape[0]
    n_asg = n_tok * TOP_K
    logits = (x2d @ w_router).astype(jnp.float32)
    top_vals, top_idx = lax.top_k(logits, TOP_K)
    weights = jax.nn.softmax(top_vals, axis=-1)
    e_flat = top_idx.reshape(-1)
    tok_flat = jnp.arange(n_asg) // TOP_K
    w_flat = weights.reshape(-1)
    order = jnp.argsort(e_flat)
    e_sorted = e_flat[order]
    counts = jnp.bincount(e_flat, length=N_EXPERTS)
    padded = (counts + MOE_BLOCK - 1) // MOE_BLOCK * MOE_BLOCK
    pad_end = jnp.cumsum(padded)
    pad_start = pad_end - padded
    sort_start = jnp.cumsum(counts) - counts
    dest = pad_start[e_sorted] + (jnp.arange(n_asg) - sort_start[e_sorted])
    n_rows = n_asg + N_EXPERTS * MOE_BLOCK
    n_blk = n_rows // MOE_BLOCK
    x_buf = jnp.zeros((n_rows, x2d.shape[1]), x2d.dtype).at[dest].set(x2d[tok_flat[order]])
    tok_buf = jnp.zeros((n_rows,), jnp.int32).at[dest].set(tok_flat[order])
    w_buf = jnp.zeros((n_rows,), jnp.float32).at[dest].set(w_flat[order])
    blk_expert = jnp.minimum(jnp.searchsorted(pad_end, jnp.arange(n_blk) * MOE_BLOCK, side='right'),
                             N_EXPERTS - 1)

    def expert_block(args):
        xb, e = args
        return swiglu(xb, w_gate[e], w_up[e], w_down[e])

    y_buf = lax.map(expert_block, (x_buf.reshape(n_blk, MOE_BLOCK, -1), blk_expert)).reshape(n_rows, -1)
    return jax.ops.segment_sum(y_buf * w_buf[:, None].astype(y_buf.dtype), tok_buf, num_segments=n_tok)


def setup_inputs(seed: int = 0) -> dict:
    key = jax.random.key(seed)
    ks = jax.random.split(key, 32)

    def nrm(k, shape, scale):
        return jax.random.normal(k, shape, jnp.float32) * scale

    u = jax.random.uniform(ks[9], (DEPTH, D_LRU), jnp.float32, minval=0.9, maxval=0.999)
    a0 = u ** (1.0 / LRU_C)
    return {
        'x': nrm(ks[0], (BATCH, SEQ, D_MODEL), 1.0),
        'rel_bias': nrm(ks[1], (N_BUCKETS, N_HEADS), 0.5),
        'norm1_g': 1.0 + nrm(ks[2], (DEPTH, D_MODEL), 0.01),
        'w_in': nrm(ks[3], (DEPTH, D_MODEL, D_IN), D_MODEL ** -0.5),
        'conv_w': nrm(ks[4], (DEPTH, CONV_WIDTH, D_LRU), CONV_WIDTH ** -0.5),
        'conv_b': nrm(ks[5], (DEPTH, D_LRU), 0.01),
        'lru_wa': nrm(ks[6], (DEPTH, LRU_BLOCKS, LRU_BLOCK_W, LRU_BLOCK_W), LRU_BLOCK_W ** -0.5),
        'lru_ba': nrm(ks[7], (DEPTH, D_LRU), 0.01),
        'lru_wx': nrm(ks[8], (DEPTH, LRU_BLOCKS, LRU_BLOCK_W, LRU_BLOCK_W), LRU_BLOCK_W ** -0.5),
        'lru_bx': nrm(ks[10], (DEPTH, D_LRU), 0.01),
        'lru_lambda': jnp.log(a0) - jnp.log1p(-a0),
        'q_norm_g': 1.0 + nrm(ks[11], (DEPTH, HEAD_DIM), 0.01),
        'k_norm_g': 1.0 + nrm(ks[12], (DEPTH, HEAD_DIM), 0.01),
        'cmp_pos': nrm(ks[13], (DEPTH, 2, CMP_BLOCK, HEAD_DIM), 0.02),
        'cmp_w1': nrm(ks[14], (DEPTH, 2, CMP_BLOCK, HEAD_DIM, CMP_HIDDEN), (CMP_BLOCK * HEAD_DIM) ** -0.5),
        'cmp_w2': nrm(ks[15], (DEPTH, 2, CMP_HIDDEN, HEAD_DIM), CMP_HIDDEN ** -0.5),
        'gate_b': nrm(ks[16], (DEPTH, N_BRANCH * N_HEADS), 0.01),
        'out_norm_g': 1.0 + nrm(ks[17], (DEPTH, D_MIX), 0.01),
        'w_out': nrm(ks[18], (DEPTH, D_MIX, D_MODEL), D_MIX ** -0.5),
        'norm2_g': 1.0 + nrm(ks[19], (DEPTH, D_MODEL), 0.01),
        'ffn_w_gate': nrm(ks[20], (N_DENSE, D_MODEL, D_FF), D_MODEL ** -0.5),
        'ffn_w_up': nrm(ks[21], (N_DENSE, D_MODEL, D_FF), D_MODEL ** -0.5),
        'ffn_w_down': nrm(ks[22], (N_DENSE, D_FF, D_MODEL), D_FF ** -0.5),
        'router_w': nrm(ks[23], (N_MOE, D_MODEL, N_EXPERTS), D_MODEL ** -0.5),
        'moe_w_gate': nrm(ks[24], (N_MOE, N_EXPERTS, D_MODEL, D_FF), D_MODEL ** -0.5),
        'moe_w_up': nrm(ks[25], (N_MOE, N_EXPERTS, D_MODEL, D_FF), D_MODEL ** -0.5),
        'moe_w_down': nrm(ks[26], (N_MOE, N_EXPERTS, D_FF, D_MODEL), D_FF ** -0.5),
    }


def reference(x, rel_bias, norm1_g, w_in, conv_w, conv_b, lru_wa, lru_ba, lru_wx, lru_bx,
              lru_lambda, q_norm_g, k_norm_g, cmp_pos, cmp_w1, cmp_w2, gate_b, out_norm_g,
              w_out, norm2_g, ffn_w_gate, ffn_w_up, ffn_w_down, router_w, moe_w_gate,
              moe_w_up, moe_w_down):
    b_, s_, _ = x.shape
    split_at = [D_LRU, OFF_Q, OFF_KV] + [OFF_KV + j * KV_WIDTH for j in range(1, 7)]
    for l in range(DEPTH):
        h = rms_norm(x, norm1_g[l])
        proj = h @ w_in[l]
        (lru_x, lru_gate, q, kc, vc, ksl, vsl, kwn, vwn, gts) = jnp.split(proj, split_at, axis=-1)
        y_lru = lru_group(lru_x, lru_gate, conv_w[l], conv_b[l], lru_wa[l], lru_ba[l],
                          lru_wx[l], lru_bx[l], lru_lambda[l])
        y_att = nsa_group(q, kc, vc, ksl, vsl, kwn, vwn, gts + gate_b[l], q_norm_g[l], k_norm_g[l],
                          cmp_pos[l], cmp_w1[l], cmp_w2[l], rel_bias)
        mix = jnp.concatenate([rms_norm(y_lru, out_norm_g[l, :D_LRU]),
                               rms_norm(y_att, out_norm_g[l, D_LRU:])], axis=-1)
        x = x + mix @ w_out[l]
        h = rms_norm(x, norm2_g[l])
        if l % 2 == 0:
            f = swiglu(h, ffn_w_gate[l // 2], ffn_w_up[l // 2], ffn_w_down[l // 2])
        else:
            f = moe_swiglu(h.reshape(b_ * s_, D_MODEL), router_w[l // 2], moe_w_gate[l // 2],
                           moe_w_up[l // 2], moe_w_down[l // 2]).reshape(b_, s_, D_MODEL)
        x = x + f
    return x
```

```cpp
#include <hip/hip_runtime.h>
#include <cstdio>
#include <cstdint>

namespace pg8 {
#define PG8_LAS __attribute__((address_space(3)))
typedef unsigned short bf16_t;
typedef short bf16x8 __attribute__((ext_vector_type(8)));
typedef float f32x4 __attribute__((ext_vector_type(4)));
typedef unsigned u32x4 __attribute__((ext_vector_type(4)));
constexpr int BM = 256, BK = 64, HALF = 128, HTB = HALF * BK * 2  , STAGE_BYTES = 8 * HTB, NXCD = 8, WGM = 8;

__host__ __device__ __forceinline__ int lds_byte(int r, int c) { const int st = (r >> 4) * 2 + (c >> 5), rr = r & 15, cc = c & 31, ob = rr * 64 + cc * 2; return st * 1024 + (ob ^ (((ob >> 9) & 1) << 5)); }
__host__ __device__ __forceinline__ void stage_rc(int b, int& R, int& C) { const int st = b / 1024, sb = b % 1024, swz = sb ^ (((sb >> 9) & 1) << 5); R = (st >> 1) * 16 + swz / 64; C = (st & 1) * 32 + (swz % 64) / 2; }
__host__ __device__ __forceinline__ int perm32(int rho) { const int n = rho >> 4, i = rho & 15; return 8 * (i >> 2) + 4 * n + (i & 3); }

struct Unit { int pm, pn; int idx = 0; };
struct Gemm { const bf16_t* A; const bf16_t* Bt; int M, N, K; int lda = 0, ldb = 0; };

struct StaticOrder {
    int nM, nN, nwg, G, c;
    const int* pexp; size_t estride;
    __host__ __device__ void init(int nM_, int nN_, int G_, int c_) { nM = nM_; nN = nN_; nwg = nM * nN; G = G_; c = c_; pexp = nullptr; estride = 0; }
    __host__ __device__ bool next(int i, Unit& u) const {
        const long L = (long)i * G + c; if (L >= nwg) return false;
        int wgid = (int)L; { const int q = nwg / NXCD, r = nwg % NXCD, xcd = wgid % NXCD, off = wgid / NXCD; wgid = (xcd < r ? xcd * (q + 1) : r * (q + 1) + (xcd - r) * q) + off; }
        const int nig = WGM * nN, gid = wgid / nig, fm = gid * WGM, gsz = (nM - fm) < WGM ? (nM - fm) : WGM;
        u.pm = fm + ((wgid % nig) % gsz); u.pn = (wgid % nig) / gsz; return true;
    }
    __device__ __forceinline__ size_t b_off(const Unit& u) const { return pexp ? (size_t)pexp[u.pm] * estride : (size_t)0; }
    __device__ __forceinline__ void a_ready(const Unit&) const {}
    __device__ __forceinline__ void done(const Unit&) const {}
};

__device__ __forceinline__ unsigned cvt_pk_bf16(float lo, float hi) { unsigned r; asm volatile("v_cvt_pk_bf16_f32 %0, %1, %2" : "=v"(r) : "v"(lo), "v"(hi)); return r; }

struct NoMid { static constexpr bool ON = false; };
__device__ __forceinline__ float rstd512(const float* S8, int row) { const f32x4 a = *(const f32x4*)(S8 + (size_t)row * 8), b = *(const f32x4*)(S8 + (size_t)row * 8 + 4);
    return 1.0f / sqrtf((((a[0] + a[1]) + (a[2] + a[3])) + ((b[0] + b[1]) + (b[2] + b[3]))) * (1.0f / 512.0f) + 1e-6f); }
typedef float f32x2t __attribute__((ext_vector_type(2)));
struct MidRatio { static constexpr bool ON = true; const PG8_LAS f32x2t* T;
    __device__ __forceinline__ void load(const Unit& u, int wr, int fr, int fq, float (&f)[2][4]) const {
#pragma unroll
        for (int ai = 0; ai < 2; ++ai)
#pragma unroll
            for (int m = 0; m < 4; ++m) f[ai][m] = T[u.idx * 256 + wr * 64 + fr + ai * HALF + m * 16].x;
    }
    __device__ __forceinline__ void load_final(const Unit& u, int wr, int fr, int fq, float (&f)[2][4]) const {
#pragma unroll
        for (int ai = 0; ai < 2; ++ai)
#pragma unroll
            for (int m = 0; m < 4; ++m) f[ai][m] = T[u.idx * 256 + wr * 64 + fr + ai * HALF + m * 16].y;
    }
};
__device__ __forceinline__ f32x4 row_ssq_load(const float* SSQ, int row, int fq) { return *(const f32x4*)(SSQ + (size_t)row * 16 + 4 * fq); }
__device__ __forceinline__ float row_rstd_fin(const f32x4 p) {
    float s = (p[0] + p[1]) + (p[2] + p[3]); s += __shfl_xor(s, 16); s += __shfl_xor(s, 32);
    return 1.0f / sqrtf(s * (1.0f / 1024.0f) + 1e-6f);
}
template <bool SCALE> struct EpiBf16 {
    static constexpr bool PERM = true, AFTER_DRAIN = false;
    bf16_t* O; int ldc; const float* SSQ;
    __device__ __forceinline__ void operator()(const f32x4 (&acc)[2][2][4][2], const Unit& u, int wr, int wc, int fr, int fq) const {
        const int row0 = u.pm * BM + wr * 64 + fr; const int col0 = u.pn * BM + wc * 32 + 8 * fq;
        f32x4 sq[2][4];
        if (SCALE) {
#pragma unroll
            for (int ai = 0; ai < 2; ++ai)
#pragma unroll
                for (int m = 0; m < 4; ++m) sq[ai][m] = row_ssq_load(SSQ, row0 + ai * HALF + m * 16, fq);
        }
#pragma unroll
        for (int ai = 0; ai < 2; ++ai)
#pragma unroll
            for (int m = 0; m < 4; ++m) { const int row = row0 + ai * HALF + m * 16; bf16_t* rowp = O + (size_t)row * ldc + col0;
                const float rs = SCALE ? row_rstd_fin(sq[ai][m]) : 1.0f;
#pragma unroll
                for (int bj = 0; bj < 2; ++bj) { const f32x4 v0 = acc[ai][bj][m][0] * rs, v1 = acc[ai][bj][m][1] * rs;
                    u32x4 w; w.x = cvt_pk_bf16(v0[0], v0[1]); w.y = cvt_pk_bf16(v0[2], v0[3]); w.z = cvt_pk_bf16(v1[0], v1[1]); w.w = cvt_pk_bf16(v1[2], v1[3]);
                    *(u32x4*)(rowp + bj * HALF) = w; } }
    }
};
__device__ __forceinline__ float silu_f(float x) { return x * __builtin_amdgcn_rcpf(1.0f + __builtin_amdgcn_exp2f(-1.44269504089f * x)); }
template <int SCALE, bool OUT8 = (SCALE == 2)> struct EpiSwiGLU {
    static constexpr bool PERM = true, AFTER_DRAIN = false;
    bf16_t* H; int ldh; const float* SSQ; const int* rowtok;
    __device__ __forceinline__ void operator()(const f32x4 (&acc)[2][2][4][2], const Unit& u, int wr, int wc, int fr, int fq) const {
        const int row0 = u.pm * BM + wr * 64 + fr; const int col0 = u.pn * HALF + wc * 32 + 8 * fq;
        f32x4 sq[2][4]; float rsv[2][4];
#pragma unroll
        for (int ai = 0; ai < 2; ++ai)
#pragma unroll
            for (int m = 0; m < 4; ++m) { if (SCALE == 2) rsv[ai][m] = SSQ[row0 + ai * HALF + m * 16]; else sq[ai][m] = row_ssq_load(SSQ, row0 + ai * HALF + m * 16, fq); }
#pragma unroll
        for (int ai = 0; ai < 2; ++ai)
#pragma unroll
            for (int m = 0; m < 4; ++m) { const int row = row0 + ai * HALF + m * 16; bf16_t* rowp = H + (size_t)row * ldh + col0;
                const float rs = (SCALE == 2) ? rsv[ai][m] : row_rstd_fin(sq[ai][m]);
                const f32x4 g0 = acc[ai][0][m][0] * rs, g1 = acc[ai][0][m][1] * rs, u0 = acc[ai][1][m][0] * rs, u1 = acc[ai][1][m][1] * rs;
                if constexpr (OUT8) {
                    const float h0 = 8.f * silu_f(g0[0]) * u0[0], h1 = 8.f * silu_f(g0[1]) * u0[1], h2 = 8.f * silu_f(g0[2]) * u0[2], h3 = 8.f * silu_f(g0[3]) * u0[3];
                    const float h4 = 8.f * silu_f(g1[0]) * u1[0], h5 = 8.f * silu_f(g1[1]) * u1[1], h6 = 8.f * silu_f(g1[2]) * u1[2], h7 = 8.f * silu_f(g1[3]) * u1[3];
                    int q0 = 0, q1 = 0; q0 = __builtin_amdgcn_cvt_pk_fp8_f32(h0, h1, q0, false); q0 = __builtin_amdgcn_cvt_pk_fp8_f32(h2, h3, q0, true); q1 = __builtin_amdgcn_cvt_pk_fp8_f32(h4, h5, q1, false); q1 = __builtin_amdgcn_cvt_pk_fp8_f32(h6, h7, q1, true);
                    typedef unsigned u32x2 __attribute__((ext_vector_type(2))); u32x2 w8; w8.x = (unsigned)q0; w8.y = (unsigned)q1;
                    *(u32x2*)((unsigned char*)H + (size_t)row * ldh + col0) = w8;
                } else {
                u32x4 w; w.x = cvt_pk_bf16(silu_f(g0[0]) * u0[0], silu_f(g0[1]) * u0[1]); w.y = cvt_pk_bf16(silu_f(g0[2]) * u0[2], silu_f(g0[3]) * u0[3]);
                w.z = cvt_pk_bf16(silu_f(g1[0]) * u1[0], silu_f(g1[1]) * u1[1]); w.w = cvt_pk_bf16(silu_f(g1[2]) * u1[2], silu_f(g1[3]) * u1[3]);
                *(u32x4*)rowp = w; } }
    }
};
struct EpiProbeSum {
    static constexpr bool PERM = true, AFTER_DRAIN = false;
    float* sink;
    __device__ __forceinline__ void operator()(const f32x4 (&acc)[2][2][4][2], const Unit& u, int wr, int wc, int fr, int fq) const {
        f32x4 s = acc[0][0][0][0];
#pragma unroll
        for (int ai = 0; ai < 2; ++ai)
#pragma unroll
            for (int bj = 0; bj < 2; ++bj)
#pragma unroll
                for (int m = 0; m < 4; ++m)
#pragma unroll
                    for (int n = 0; n < 2; ++n) s += acc[ai][bj][m][n];
        sink[(size_t)(u.pm * 16 + u.pn) * 512 + threadIdx.x] = (s[0] + s[1]) + (s[2] + s[3]);
    }
};
struct EpiResF32 {
    static constexpr bool PERM = false, AFTER_DRAIN = false;
    const float* base; float* out; int ldc;
    __device__ __forceinline__ void operator()(const f32x4 (&acc)[2][2][4][2], const Unit& u, int wr, int wc, int fr, int fq) const {
        const int row0 = u.pm * BM + wr * 64 + fr, col0 = u.pn * BM + wc * 32 + 4 * fq;
#pragma unroll
        for (int ai = 0; ai < 2; ++ai)
#pragma unroll
            for (int m = 0; m < 4; ++m) { const size_t ro = (size_t)(row0 + ai * HALF + m * 16) * ldc + col0;
#pragma unroll
                for (int bj = 0; bj < 2; ++bj)
#pragma unroll
                    for (int n = 0; n < 2; ++n) { const f32x4 b = *(const f32x4*)(base + ro + bj * HALF + n * 16); *(f32x4*)(out + ro + bj * HALF + n * 16) = acc[ai][bj][m][n] + b; } }
    }
};
struct EpiResNorm {
    static constexpr bool PERM = false, AFTER_DRAIN = false;
    const float* base; float* out; int ldc; const float* gn; bf16_t* XG; float* SSQ;
    __device__ __forceinline__ void operator()(const f32x4 (&acc)[2][2][4][2], const Unit& u, int wr, int wc, int fr, int fq) const {
        const int row0 = u.pm * BM + wr * 64 + fr, col0 = u.pn * BM + wc * 32 + 4 * fq;
        f32x4 gv[2][2];
#pragma unroll
        for (int bj = 0; bj < 2; ++bj)
#pragma unroll
            for (int n = 0; n < 2; ++n) gv[bj][n] = *(const f32x4*)(gn + col0 + bj * HALF + n * 16);
#pragma unroll
        for (int ai = 0; ai < 2; ++ai)
#pragma unroll
            for (int m = 0; m < 4; ++m) { const int row = row0 + ai * HALF + m * 16; const size_t ro = (size_t)row * ldc + col0; float ss = 0.f;
#pragma unroll
                for (int bj = 0; bj < 2; ++bj)
#pragma unroll
                    for (int n = 0; n < 2; ++n) { const f32x4 v = acc[ai][bj][m][n] + *(const f32x4*)(base + ro + bj * HALF + n * 16); *(f32x4*)(out + ro + bj * HALF + n * 16) = v;
                        ss += (v[0] * v[0] + v[1] * v[1]) + (v[2] * v[2] + v[3] * v[3]); const f32x4 xg = v * gv[bj][n];
                        typedef unsigned u32x2 __attribute__((ext_vector_type(2)));
                        u32x2 w; w.x = cvt_pk_bf16(xg[0], xg[1]); w.y = cvt_pk_bf16(xg[2], xg[3]); *(u32x2*)(XG + ro + bj * HALF + n * 16) = w; }
                ss += __shfl_xor(ss, 16); ss += __shfl_xor(ss, 32);
                if (fq == 0) SSQ[(size_t)row * 16 + u.pn * 4 + wc] = ss; }
    }
};
template <bool RS = false> struct EpiResBf16Norm {
    static constexpr bool PERM = true, AFTER_DRAIN = false;
    const bf16_t* base; bf16_t* out; int ldc; float* SSQ; unsigned char* x8; const PG8_LAS f32x2t* T = nullptr;
    __device__ __forceinline__ void operator()(const f32x4 (&acc)[2][2][4][2], const Unit& u, int wr, int wc, int fr, int fq) const {
        const int row0 = u.pm * BM + wr * 64 + fr; const int col0 = u.pn * BM + wc * 32 + 8 * fq;
#pragma unroll
        for (int ai = 0; ai < 2; ++ai) {
        u32x4 bb[2][4][2];
#pragma unroll
            for (int m = 0; m < 4; ++m)
#pragma unroll
                for (int bj = 0; bj < 2; ++bj) bb[ai][m][bj] = *(const u32x4*)(base + (size_t)(row0 + ai * HALF + m * 16) * ldc + col0 + bj * HALF);
#pragma unroll
            for (int m = 0; m < 4; ++m) { const int row = row0 + ai * HALF + m * 16; const size_t ro = (size_t)row * ldc + col0; float ss = 0.f;
                const float rsc = RS ? T[u.idx * 256 + wr * 64 + fr + ai * HALF + m * 16].y : 1.0f;
#pragma unroll
                for (int bj = 0; bj < 2; ++bj) { const u32x4 b = bb[ai][m][bj];
                    f32x4 v0 = acc[ai][bj][m][0] * rsc, v1 = acc[ai][bj][m][1] * rsc;
                    v0[0] += __uint_as_float(b.x << 16); v0[1] += __uint_as_float(b.x & 0xffff0000u); v0[2] += __uint_as_float(b.y << 16); v0[3] += __uint_as_float(b.y & 0xffff0000u);
                    v1[0] += __uint_as_float(b.z << 16); v1[1] += __uint_as_float(b.z & 0xffff0000u); v1[2] += __uint_as_float(b.w << 16); v1[3] += __uint_as_float(b.w & 0xffff0000u);
                    ss += ((v0[0] * v0[0] + v0[1] * v0[1]) + (v0[2] * v0[2] + v0[3] * v0[3])) + ((v1[0] * v1[0] + v1[1] * v1[1]) + (v1[2] * v1[2] + v1[3] * v1[3]));
                    u32x4 w; w.x = cvt_pk_bf16(v0[0], v0[1]); w.y = cvt_pk_bf16(v0[2], v0[3]); w.z = cvt_pk_bf16(v1[0], v1[1]); w.w = cvt_pk_bf16(v1[2], v1[3]);
                    *(u32x4*)(out + ro + bj * HALF) = w;
                    if (x8) { int q0 = 0, q1 = 0; q0 = __builtin_amdgcn_cvt_pk_fp8_f32(v0[0], v0[1], q0, false); q0 = __builtin_amdgcn_cvt_pk_fp8_f32(v0[2], v0[3], q0, true); q1 = __builtin_amdgcn_cvt_pk_fp8_f32(v1[0], v1[1], q1, false); q1 = __builtin_amdgcn_cvt_pk_fp8_f32(v1[2], v1[3], q1, true);
                        typedef unsigned u32x2 __attribute__((ext_vector_type(2))); u32x2 w8; w8.x = (unsigned)q0; w8.y = (unsigned)q1; *(u32x2*)(x8 + ro + bj * HALF) = w8; } }
                ss += __shfl_xor(ss, 16); ss += __shfl_xor(ss, 32);
                if (fq == 0) SSQ[(size_t)row * 16 + u.pn * 4 + wc] = ss; }
            asm volatile("" ::: "memory"); }
    }
};
template <bool FIRST> struct EpiMoeDown {
    static constexpr bool PERM = false, AFTER_DRAIN = false;
    const int* rowtok; const float* roww; float* out; int ldc; const bf16_t* xb;
    __device__ __forceinline__ void operator()(const f32x4 (&acc)[2][2][4][2], const Unit& u, int wr, int wc, int fr, int fq) const {
        const int row0 = u.pm * BM + wr * 64 + fr, col0 = u.pn * BM + wc * 32 + 4 * fq;
        int tk[2][4]; float wk[2][4];
#pragma unroll
        for (int ai = 0; ai < 2; ++ai)
#pragma unroll
            for (int m = 0; m < 4; ++m) { tk[ai][m] = rowtok[row0 + ai * HALF + m * 16]; wk[ai][m] = roww[row0 + ai * HALF + m * 16]; }
#pragma unroll
        for (int ai = 0; ai < 2; ++ai)
#pragma unroll
            for (int m = 0; m < 4; ++m) { const int tok = tk[ai][m]; const float w = wk[ai][m];
                if (tok >= 0) { float* op = out + (size_t)tok * ldc + col0; const bf16_t* bp = xb + (size_t)tok * ldc + col0;
#pragma unroll
                    for (int bj = 0; bj < 2; ++bj)
#pragma unroll
                        for (int n = 0; n < 2; ++n) { f32x4 b;
                            if (FIRST) { typedef unsigned u32x2 __attribute__((ext_vector_type(2))); const u32x2 q = *(const u32x2*)(bp + bj * HALF + n * 16);
                                b[0] = __uint_as_float(q.x << 16); b[1] = __uint_as_float(q.x & 0xffff0000u); b[2] = __uint_as_float(q.y << 16); b[3] = __uint_as_float(q.y & 0xffff0000u); }
                            else b = *(const f32x4*)(op + bj * HALF + n * 16);
                            *(f32x4*)(op + bj * HALF + n * 16) = acc[ai][bj][m][n] * w + b; } } }
    }
};

template <class Epi, class Sched, bool ALIGN_EPI = false, bool SP2 = false, bool FP8 = false, int FP8_ASCALE = 0x7f7f7f7f  , class Mid = NoMid>
__device__ __forceinline__ void gemm_phase(PG8_LAS unsigned char* lds, const Gemm g, const Sched& S, const Epi& E, const Mid& Mi = Mid()) {
    const int tid = threadIdx.x, wid = __builtin_amdgcn_readfirstlane(tid >> 6), lane = tid & 63, wr = wid >> 2, wc = wid & 3, fr = lane & 15, fq = lane >> 4;
    const int K = g.K, nt = K / BK, lda = g.lda ? g.lda : K, ldb = g.ldb ? g.ldb : K;
    unsigned voffA[2], voffB[2];
#pragma unroll
    for (int i = 0; i < 2; ++i) { int R, C; stage_rc(tid * 16 + i * 8192, R, C); const int Rb = Epi::PERM ? ((R & ~31) + perm32(R & 31)) : R;
        voffA[i] = (unsigned)(R * lda + C) * 2u; voffB[i] = (unsigned)(Rb * ldb + C) * 2u; }
    const size_t kstep = (size_t)(BK * 2);
    const size_t hstepA = (size_t)HALF * lda * 2, hstepB = (size_t)HALF * ldb * 2;
    const size_t tstepA = 2 * hstepA, tstepB = 2 * hstepB;
    const unsigned ldsw = (unsigned)wid * 1024u;
    const int aoff = lds_byte(wr * 64 + fr, fq * 8), boff = lds_byte(wc * 32 + fr, fq * 8);
    const int aoffL = lds_byte(wr * 64 + fr, fq * 16), aoffH = lds_byte(wr * 64 + fr, fq * 16 + 8), boffL = lds_byte(wc * 32 + fr, fq * 16), boffH = lds_byte(wc * 32 + fr, fq * 16 + 8);
    typedef int pg8_i4 __attribute__((ext_vector_type(4))); typedef int pg8_i8 __attribute__((ext_vector_type(8)));
#define PG8_SA(b, h) (((b) * 2 + (h)) * HTB)
#define PG8_SB(b, h) ((4 + (b) * 2 + (h)) * HTB)
#define PG8_STAGE(bufoff, gbase, voff) do { _Pragma("unroll") for (int _i = 0; _i < 2; ++_i) \
        __builtin_amdgcn_global_load_lds((const unsigned*)((const char*)(gbase) + (voff)[_i]), (PG8_LAS unsigned*)(lds + (bufoff) + ldsw + _i * 8192), 16, 0, 0); } while (0)
#define PG8_LDA(dst, b, h) do { if constexpr (FP8) { _Pragma("unroll") for (int m = 0; m < 4; ++m) { const pg8_i4 _lo = *(const PG8_LAS pg8_i4*)(lds + PG8_SA(b, h) + aoffL + m * 2048), _hi = *(const PG8_LAS pg8_i4*)(lds + PG8_SA(b, h) + aoffH + m * 2048); \
            dst##8[m] = __builtin_shufflevector(_lo, _hi, 0, 1, 2, 3, 4, 5, 6, 7); } } \
        else { _Pragma("unroll") for (int m = 0; m < 4; ++m) _Pragma("unroll") for (int k = 0; k < 2; ++k) dst[m][k] = *(const PG8_LAS bf16x8*)(lds + PG8_SA(b, h) + aoff + m * 2048 + k * 1024); } } while (0)
#define PG8_LDB(dst, b, h) do { if constexpr (FP8) { _Pragma("unroll") for (int n = 0; n < 2; ++n) { const pg8_i4 _lo = *(const PG8_LAS pg8_i4*)(lds + PG8_SB(b, h) + boffL + n * 2048), _hi = *(const PG8_LAS pg8_i4*)(lds + PG8_SB(b, h) + boffH + n * 2048); \
            dst##8[n] = __builtin_shufflevector(_lo, _hi, 0, 1, 2, 3, 4, 5, 6, 7); } } \
        else { _Pragma("unroll") for (int n = 0; n < 2; ++n) _Pragma("unroll") for (int k = 0; k < 2; ++k) dst[n][k] = *(const PG8_LAS bf16x8*)(lds + PG8_SB(b, h) + boff + n * 2048 + k * 1024); } } while (0)
#define PG8_MMA(ai, bj, At, Bt) do { __builtin_amdgcn_s_setprio(1); _Pragma("unroll") for (int m = 0; m < 4; ++m) _Pragma("unroll") for (int n = 0; n < 2; ++n) { \
        if constexpr (FP8) asm volatile("v_mfma_scale_f32_16x16x128_f8f6f4 %0, %1, %2, %0, %3, %4 op_sel_hi:[0,0,0]" : "+v"(acc[ai][bj][m][n]) : "v"(Bt##8[n]), "v"(At##8[m]), "v"(0x79797979), "v"(FP8_ASCALE)); \
        else { _Pragma("unroll") for (int k = 0; k < 2; ++k) acc[ai][bj][m][n] = __builtin_amdgcn_mfma_f32_16x16x32_bf16(Bt[n][k], At[m][k], acc[ai][bj][m][n], 0, 0, 0); } } \
        __builtin_amdgcn_s_setprio(0); } while (0)
#define PG8_WAIT_V(n) asm volatile("s_waitcnt vmcnt(" #n ")" ::: "memory")
#define PG8_WAIT_L(n) asm volatile("s_waitcnt lgkmcnt(" #n ")" ::: "memory")
#define PG8_BAR __builtin_amdgcn_s_barrier()
#define PG8_SCHED __builtin_amdgcn_sched_barrier(0)
    Unit cur, nxt; int ui = 0;
    if (!S.next(0, cur)) return;
    cur.idx = 0;
    f32x4 acc[2][2][4][2];
#pragma unroll
    for (int a = 0; a < 2; ++a)
#pragma unroll
        for (int b = 0; b < 2; ++b)
#pragma unroll
            for (int m = 0; m < 4; ++m)
#pragma unroll
                for (int n = 0; n < 2; ++n) acc[a][b][m][n] = (f32x4){0.f, 0.f, 0.f, 0.f};
    bf16x8 At[4][2], B0[2][2], B1[2][2];
    pg8_i8 At8[4], B08[2], B18[2];
    const char* cA = (const char*)g.A + (size_t)cur.pm * tstepA; const char* cB = (const char*)g.Bt + S.b_off(cur) + (size_t)cur.pn * tstepB;
    S.a_ready(cur);
    if constexpr (SP2) {
        PG8_STAGE(PG8_SB(0, 0), cB, voffB); PG8_STAGE(PG8_SB(0, 1), cB + hstepB, voffB); PG8_STAGE(PG8_SA(0, 0), cA, voffA); PG8_STAGE(PG8_SA(0, 1), cA + hstepA, voffA);
        if (wr == 1) PG8_BAR;
        PG8_WAIT_V(2); PG8_BAR;
        PG8_STAGE(PG8_SB(1, 0), cB + kstep, voffB); PG8_STAGE(PG8_SA(1, 0), cA + kstep, voffA); PG8_STAGE(PG8_SB(1, 1), cB + hstepB + kstep, voffB);
        PG8_WAIT_V(6); PG8_BAR;
    } else {
        PG8_STAGE(PG8_SB(0, 0), cB, voffB); PG8_STAGE(PG8_SA(0, 0), cA, voffA); PG8_STAGE(PG8_SB(0, 1), cB + hstepB, voffB); PG8_STAGE(PG8_SA(0, 1), cA + hstepA, voffA);
        if (wr == 1) PG8_BAR;
        PG8_WAIT_V(4); PG8_BAR;
        PG8_STAGE(PG8_SB(1, 0), cB + kstep, voffB); PG8_STAGE(PG8_SA(1, 0), cA + kstep, voffA); PG8_STAGE(PG8_SB(1, 1), cB + hstepB + kstep, voffB);
        PG8_WAIT_V(6); PG8_BAR;
    }
    for (;;) {
        const bool has_next = S.next(ui + 1, nxt); nxt.idx = ui + 1;
        const char* nA = has_next ? (const char*)g.A + (size_t)nxt.pm * tstepA : cA; const char* nB = has_next ? (const char*)g.Bt + S.b_off(nxt) + (size_t)nxt.pn * tstepB : cB;
#pragma unroll 1
        for (int t = 0; t < nt; t += 2) {
            const bool last = (t == nt - 2);
            const char* a1 = cA + (size_t)(t + 1) * kstep;
            const char* a2 = last ? nA : cA + (size_t)(t + 2) * kstep; const char* b2 = last ? nB : cB + (size_t)(t + 2) * kstep;
            const char* a3 = a2 + kstep; const char* b3 = b2 + kstep;
            if (last && has_next) S.a_ready(nxt);
            if constexpr (SP2) {
            PG8_LDB(B0, 0, 0); PG8_LDB(B1, 0, 1); PG8_SCHED; PG8_LDA(At, 0, 0); PG8_STAGE(PG8_SA(1, 1), a1 + hstepA, voffA);
            PG8_WAIT_V(8); PG8_WAIT_L(0); PG8_BAR; PG8_MMA(0, 0, At, B0); PG8_MMA(0, 1, At, B1); PG8_BAR; PG8_SCHED;
            PG8_LDA(At, 0, 1); PG8_STAGE(PG8_SB(0, 0), b2, voffB); PG8_STAGE(PG8_SB(0, 1), b2 + hstepB, voffB); PG8_STAGE(PG8_SA(0, 0), a2, voffA);
            PG8_WAIT_V(8); PG8_WAIT_L(0); PG8_BAR; PG8_MMA(1, 0, At, B0); PG8_MMA(1, 1, At, B1); PG8_BAR; PG8_SCHED;
            PG8_LDB(B0, 1, 0); PG8_LDB(B1, 1, 1); PG8_SCHED; PG8_LDA(At, 1, 0); PG8_STAGE(PG8_SA(0, 1), a2 + hstepA, voffA);
            PG8_WAIT_V(8); PG8_WAIT_L(0); PG8_BAR; PG8_MMA(0, 0, At, B0); PG8_MMA(0, 1, At, B1); PG8_BAR; PG8_SCHED;
            PG8_LDA(At, 1, 1); PG8_STAGE(PG8_SB(1, 0), b3, voffB); PG8_STAGE(PG8_SB(1, 1), b3 + hstepB, voffB); PG8_STAGE(PG8_SA(1, 0), a3, voffA);
            PG8_WAIT_V(8); PG8_WAIT_L(0); PG8_BAR; PG8_MMA(1, 0, At, B0); PG8_MMA(1, 1, At, B1); PG8_BAR; PG8_SCHED;
            } else {
            PG8_LDB(B0, 0, 0); PG8_SCHED; PG8_LDA(At, 0, 0); PG8_STAGE(PG8_SA(1, 1), a1 + hstepA, voffA);
            PG8_WAIT_L(8); PG8_BAR; PG8_WAIT_L(0); PG8_MMA(0, 0, At, B0); PG8_BAR; PG8_SCHED;
            PG8_LDB(B1, 0, 1); PG8_STAGE(PG8_SB(0, 0), b2, voffB);
            PG8_BAR; PG8_WAIT_L(0); PG8_MMA(0, 1, At, B1); PG8_BAR;
            PG8_LDA(At, 0, 1); PG8_STAGE(PG8_SA(0, 0), a2, voffA);
            PG8_BAR; PG8_WAIT_L(0); PG8_MMA(1, 0, At, B0); PG8_BAR; PG8_SCHED;
            PG8_STAGE(PG8_SB(0, 1), b2 + hstepB, voffB);
            PG8_WAIT_V(6); PG8_BAR; PG8_MMA(1, 1, At, B1); PG8_BAR;
            PG8_LDB(B0, 1, 0); PG8_SCHED; PG8_LDA(At, 1, 0); PG8_STAGE(PG8_SA(0, 1), a2 + hstepA, voffA);
            PG8_WAIT_L(8); PG8_BAR; PG8_WAIT_L(0); PG8_MMA(0, 0, At, B0); PG8_BAR; PG8_SCHED;
            PG8_LDB(B1, 1, 1); PG8_STAGE(PG8_SB(1, 0), b3, voffB);
            PG8_BAR; PG8_WAIT_L(0); PG8_MMA(0, 1, At, B1); PG8_BAR;
            PG8_LDA(At, 1, 1); PG8_STAGE(PG8_SA(1, 0), a3, voffA);
            PG8_BAR; PG8_WAIT_L(0); PG8_MMA(1, 0, At, B0); PG8_BAR; PG8_SCHED;
            PG8_STAGE(PG8_SB(1, 1), b3 + hstepB, voffB);
            PG8_WAIT_V(6); PG8_BAR; PG8_MMA(1, 1, At, B1); PG8_BAR;
            }
            if constexpr (Mid::ON) { if (t == nt / 2 - 2) { float mfac[2][4]; Mi.load(cur, wr, fr, fq, mfac);
#pragma unroll
                for (int a = 0; a < 2; ++a)
#pragma unroll
                    for (int b = 0; b < 2; ++b)
#pragma unroll
                        for (int m = 0; m < 4; ++m)
#pragma unroll
                            for (int n = 0; n < 2; ++n) acc[a][b][m][n] *= mfac[a][m]; } }
        }
        if constexpr (ALIGN_EPI) { if (wr == 0) PG8_BAR; }
        if constexpr (!Epi::AFTER_DRAIN) { E(acc, cur, wr, wc, fr, fq); S.done(cur); }
        if (!has_next) break;
#pragma unroll
        for (int a = 0; a < 2; ++a)
#pragma unroll
            for (int b = 0; b < 2; ++b)
#pragma unroll
                for (int m = 0; m < 4; ++m)
#pragma unroll
                    for (int n = 0; n < 2; ++n) acc[a][b][m][n] = (f32x4){0.f, 0.f, 0.f, 0.f};
        cur = nxt; cA = nA; cB = nB; ++ui;
        if constexpr (ALIGN_EPI) { if (wr == 1) PG8_BAR; }
    }
    PG8_WAIT_V(0);
    if constexpr (!ALIGN_EPI) { if (wr == 0) PG8_BAR; }
    PG8_BAR;
    if constexpr (Epi::AFTER_DRAIN) { E.fused(acc, cur, wr, wc, fr, fq, lds, wid, lane); S.done(cur); }
#undef PG8_SA
#undef PG8_SB
#undef PG8_STAGE
#undef PG8_LDA
#undef PG8_LDB
#undef PG8_MMA
#undef PG8_WAIT_V
#undef PG8_WAIT_L
#undef PG8_BAR
#undef PG8_SCHED
}
}

constexpr int NWAVES = 8, NTHR = 512;
constexpr int D = 1024, BATCH = 4, SEQ = 8192, M = BATCH * SEQ, DEPTH = 2;
constexpr int D_LRU = 512, HD = 64, NH = 8, NG = 2, HPG = 4;
constexpr int NPROJ = 2560, D_IN = 2328;
constexpr int C_LX = 0, C_LG = 512, C_Q = 1024, C_KC = 1536, C_VC = 1664, C_KS = 1792, C_VS = 1920, C_KW = 2048, C_VW = 2176, C_GT = 2304;
constexpr int FF = 2816, NE = 8, NGU = 2 * FF;
constexpr int NCMP = 511, NCMPP = 512, NSELB = 128, LCH = 64, NCHUNK = SEQ / LCH;
constexpr int MOE_ROWS = M + NE * 256, MOE_PANELS = MOE_ROWS / 256;
constexpr float RMS_EPS = 1e-6f;

constexpr size_t MiB = 1u << 20;
constexpr size_t WS_CTL = 0, CTL_ZERO_BYTES = 1 * MiB;
constexpr size_t WS_TAB = 1 * MiB;
constexpr size_t WS_KC = 2 * MiB, WS_VC = 2 * MiB + 512 * 1024;
constexpr size_t WS_AGGA = 3 * MiB, WS_AGGH = 4 * MiB, WS_HIN = 5 * MiB;
constexpr size_t WS_TOPE = 6 * MiB, WS_TOPW = 6 * MiB + 512 * 1024, WS_POS = 7 * MiB, WS_ROWTOK = 7 * MiB + 512 * 1024, WS_ROWW = 8 * MiB, WS_META = 8 * MiB + 512 * 1024, WS_ROWRS = 8 * MiB + 640 * 1024  , WS_RSTD = 13 * MiB  , WS_SSQ = 9 * MiB  , WS_SSQL = 11 * MiB, WS_SSQA = 12 * MiB  ;
constexpr size_t WS_WIN = 16 * MiB, WS_WOUT = 26 * MiB, WS_FGU = 30 * MiB, WS_FD = 41 * MiB, WS_MGU = 47 * MiB, WS_MD = 135 * MiB, WS_CW1 = 179 * MiB;
constexpr size_t WS_HN = 184 * MiB, WS_PROJ = 248 * MiB, WS_HID = 248 * MiB, WS_QN = 408 * MiB, WS_KSN = 440 * MiB, WS_KWN = 448 * MiB, WS_VST = 456 * MiB, WS_VWT = 464 * MiB, WS_MIX = 440 * MiB  , WS_FIN = 472 * MiB  , WS_XBUF = 440 * MiB, WS_END = 508 * MiB;
static_assert(WS_WIN + (size_t)DEPTH * NPROJ * D * 2 <= WS_WOUT && WS_FGU + (size_t)NGU * D * 2 <= WS_FD && WS_FD + (size_t)D * FF * 2 <= WS_MGU, "ws map 1");
static_assert(WS_MGU + (size_t)NE * NGU * D * 2 <= WS_MD && WS_MD + (size_t)NE * D * FF * 2 <= WS_CW1 && WS_CW1 + (size_t)4 * 128 * 2048 * 2 <= WS_HN, "ws map 2");
static_assert(WS_PROJ + (size_t)M * NPROJ * 2 <= WS_QN && WS_HID + (size_t)MOE_ROWS * FF * 2 <= WS_XBUF && WS_XBUF + (size_t)MOE_ROWS * D * 2 <= WS_END, "ws map 3");
constexpr int CW_BAR = 4096;
constexpr int CW_MOECNT = 16384;
constexpr int LDS_BYTES = 163840;
constexpr int MISC_OFF = LDS_BYTES - 256;

#define GAS __attribute__((address_space(1)))
#define LAS __attribute__((address_space(3)))
typedef unsigned short bf16;
typedef unsigned v4u __attribute__((ext_vector_type(4)));
typedef unsigned v2u __attribute__((ext_vector_type(2)));
typedef float f32x4 __attribute__((ext_vector_type(4)));
typedef short abf16x8 __attribute__((ext_vector_type(8)));
typedef float f32x16 __attribute__((ext_vector_type(16)));
#define LDS_WAIT() asm volatile("s_waitcnt lgkmcnt(0)" ::: "memory")
__device__ __forceinline__ unsigned f2bf(float f) { unsigned u = __builtin_bit_cast(unsigned, f); return (u + 0x7fffu + ((u >> 16) & 1u)) >> 16; }
__device__ __forceinline__ unsigned pk2(float lo, float hi) { return f2bf(lo) | (f2bf(hi) << 16); }
__device__ __forceinline__ float bf2f(bf16 v) { return __uint_as_float((unsigned)v << 16); }
__device__ __forceinline__ float bflo(unsigned w) { return __uint_as_float(w << 16); }
__device__ __forceinline__ float bfhi(unsigned w) { return __uint_as_float(w & 0xffff0000u); }
__device__ __forceinline__ float gelu_tanh(float x) { const float u = 0.7978845608028654f * (x + 0.044715f * x * x * x); const float e = __expf(2.0f * u); const float th = 1.0f - 2.0f / (e + 1.0f); return 0.5f * x * (1.0f + th); }
__device__ __forceinline__ float sigmoid_f(float x) { return 1.0f / (1.0f + __expf(-x)); }
__device__ __forceinline__ float wave_sum(float v) {
#pragma unroll
    for (int o = 1; o < 64; o <<= 1) v += __shfl_xor(v, o);
    return v;
}
__device__ const unsigned char T5_BUCKET[128] = {0, 1, 2, 3, 4, 5, 6, 7, 8, 9, 10, 11, 12, 13, 14, 15, 16, 16, 16, 17, 17, 18, 18, 18, 19, 19, 19, 20, 20, 20, 20, 21, 21, 21, 21, 22, 22, 22, 22, 22, 23, 23, 23, 23, 23, 23, 24, 24, 24, 24, 24, 24, 25, 25, 25, 25, 25, 25, 25, 26, 26, 26, 26, 26, 26, 26, 26, 27, 27, 27, 27, 27, 27, 27, 27, 27, 27, 28, 28, 28, 28, 28, 28, 28, 28, 28, 28, 29, 29, 29, 29, 29, 29, 29, 29, 29, 29, 29, 29, 30, 30, 30, 30, 30, 30, 30, 30, 30, 30, 30, 30, 30, 30, 31, 31, 31, 31, 31, 31, 31, 31, 31, 31, 31, 31, 31, 31, 31};

#define XB_TMO      128
#define XB_XCNT(j)  (256  + 64 * (j))
#define XB_XSUB(j)  (1280 + 64 * (j))
#define XB_XGEN(j)  (2304 + 64 * (j))
#define XB_TOP      3328
#define XB_TOPGEN   3392
#define XCD_BAR_WORDS 3456
#define XB_SPIN_CAP (1u << 18)

__device__ __forceinline__ unsigned xb_ld(unsigned* p)              { return __hip_atomic_load(p, __ATOMIC_RELAXED, __HIP_MEMORY_SCOPE_AGENT); }
__device__ __forceinline__ unsigned xb_add(unsigned* p, unsigned v) { return __hip_atomic_fetch_add(p, v, __ATOMIC_RELAXED, __HIP_MEMORY_SCOPE_AGENT); }
__device__ __forceinline__ unsigned xb_xcc_id() { return (unsigned)__builtin_amdgcn_s_getreg((3 << 11) | 20) & 0xFu; }
#define XB_SPIN(cond, bar) do { unsigned _sp = 0; while (cond) { __builtin_amdgcn_s_sleep(1); \
    if ((++_sp & 255u) == 0u) { if (xb_ld(&(bar)[XB_TMO])) break; if (_sp > XB_SPIN_CAP) { atomicAdd(&(bar)[XB_TMO], 1u); break; } } } } while (0)

struct XcdBarrier {
    unsigned* bar; unsigned x;
    volatile LAS unsigned* st;
};

__device__ __forceinline__ XcdBarrier xcd_barrier_post(unsigned* bar, volatile LAS unsigned* st) {
    XcdBarrier b; b.bar = bar; b.x = xb_xcc_id(); b.st = st;
    if (threadIdx.x == 0) (void)xb_add(&bar[XB_XCNT(b.x)], 1u);
    return b;
}
__device__ __forceinline__ void xcd_barrier_complete(unsigned* bar, unsigned x, unsigned& nloc, unsigned& nx) {
    const unsigned G = gridDim.x * gridDim.y * gridDim.z;
    unsigned sum, cnt, mine, sp = 0u;
    for (;;) {
        sum = 0u; cnt = 0u; mine = 0u;
#pragma unroll
        for (unsigned j = 0; j < 16; ++j) { const unsigned c = xb_ld(&bar[XB_XCNT(j)]); sum += c; cnt += (c > 0u) ? 1u : 0u; mine = (j == x) ? c : mine; }
        if (sum == G) break;
        __builtin_amdgcn_s_sleep(1);
        if ((++sp & 255u) == 0u) { if (xb_ld(&bar[XB_TMO])) break; if (sp > XB_SPIN_CAP) { atomicAdd(&bar[XB_TMO], 1u); break; } }
    }
    nloc = mine > 0u ? mine : 1u; nx = cnt > 0u ? cnt : 1u;
}

__device__ __forceinline__ void xcd_barrier(const XcdBarrier& b) {
    asm volatile("s_waitcnt vmcnt(0)" ::: "memory");
    __syncthreads();
    if (threadIdx.x == 0) {
        unsigned* bar = b.bar;
        __builtin_amdgcn_s_waitcnt(0);
        unsigned nloc = b.st[0], nx = b.st[1];
        if (nloc == 0u) { xcd_barrier_complete(bar, b.x, nloc, nx); b.st[0] = nloc; b.st[1] = nx; }
        const unsigned old = xb_add(&bar[XB_XSUB(b.x)], 1u);
        const unsigned gen = old / nloc;
        if (old + 1u == (gen + 1u) * nloc) {
            __builtin_amdgcn_fence(__ATOMIC_RELEASE, "agent");
            asm volatile("s_waitcnt vmcnt(0)" ::: "memory");
            const unsigned og = xb_add(&bar[XB_TOP], 1u);
            const unsigned tg = og / nx;
            if (og + 1u == (tg + 1u) * nx) xb_add(&bar[XB_TOPGEN], 1u);
            else XB_SPIN(xb_ld(&bar[XB_TOPGEN]) == tg, bar);
            __builtin_amdgcn_fence(__ATOMIC_ACQUIRE, "agent");
            xb_add(&bar[XB_XGEN(b.x)], 1u);
            asm volatile("s_waitcnt vmcnt(0)" ::: "memory");
        } else {
            XB_SPIN(xb_ld(&bar[XB_XGEN(b.x)]) == gen, bar);
            __builtin_amdgcn_fence(__ATOMIC_ACQUIRE, "agent");
            asm volatile("s_waitcnt vmcnt(0)" ::: "memory");
        }
    }
    __syncthreads();
}

struct Args { const float* in[27]; float* out; unsigned char* ws; int ph_lo, ph_hi, use_bar, pad; };
typedef const __attribute__((address_space(4))) Args KArgs;
__device__ __forceinline__ KArgs* kargs() { KArgs* p = (KArgs*)__builtin_amdgcn_kernarg_segment_ptr(); asm volatile("" : "+s"(p)); return p; }
#define INP(i) ((const float*)(kargs()->in[i]))
struct Ctx {
    LAS unsigned char* lds; unsigned char* ws; float* out;
    int tid, lane, wave, G, bid;
};
#define WSP(T, off) ((T*)(C.ws + (off)))

#ifndef INPROJ_FP8_MASK
#define INPROJ_FP8_MASK 2
#endif
#define INPROJ_FP8(l) (((INPROJ_FP8_MASK) >> (l)) & 1)
__device__ __forceinline__ void tr_item(const float* W, int N, bf16* WT, int ldt, int k0, int n0, int outrow0, LAS float* scr, int lane, const float* gain) {
    const int a = lane & 15, kq = lane >> 4; const int nn = n0 + 4 * a; const bool ok = nn < N;
    f32x4 v[16];
#pragma unroll
    for (int i = 0; i < 16; ++i) v[i] = ok ? *(const f32x4*)(W + (size_t)(k0 + 4 * i + kq) * N + nn) : (f32x4){0.f, 0.f, 0.f, 0.f};
#pragma unroll
    for (int i = 0; i < 16; ++i) { LAS float* d = scr + (4 * i + kq) * 65 + 4 * a; const float gk = gain ? gain[k0 + 4 * i + kq] : 1.0f; d[0] = v[i].x * gk; d[1] = v[i].y * gk; d[2] = v[i].z * gk; d[3] = v[i].w * gk; }
    LDS_WAIT(); asm volatile("" ::: "memory");
    const int c = lane & 7, nl = lane >> 3;
#pragma unroll
    for (int j = 0; j < 8; ++j) { const int n = nl + 8 * j; const LAS float* sp = scr + (8 * c) * 65 + n;
        v4u o; o.x = pk2(sp[0 * 65], sp[1 * 65]); o.y = pk2(sp[2 * 65], sp[3 * 65]); o.z = pk2(sp[4 * 65], sp[5 * 65]); o.w = pk2(sp[6 * 65], sp[7 * 65]);
        *(v4u*)(WT + (size_t)(outrow0 + n) * ldt + k0 + 8 * c) = o; }
    LDS_WAIT(); asm volatile("" ::: "memory");
}
__device__ __forceinline__ unsigned pk4_fp8(float a, float b, float c, float d) { int r = 0; r = __builtin_amdgcn_cvt_pk_fp8_f32(a, b, r, false); r = __builtin_amdgcn_cvt_pk_fp8_f32(c, d, r, true); return (unsigned)r; }
__device__ __forceinline__ void tr_item8(const float* W, int N, unsigned char* WT8, int ldt, int k0, int n0, int outrow0, LAS float* scr, int lane, const float* gain) {
    const int a = lane & 15, kq = lane >> 4; const int nn = n0 + 4 * a; const bool ok = nn < N;
    f32x4 v[16];
#pragma unroll
    for (int i = 0; i < 16; ++i) v[i] = ok ? *(const f32x4*)(W + (size_t)(k0 + 4 * i + kq) * N + nn) : (f32x4){0.f, 0.f, 0.f, 0.f};
#pragma unroll
    for (int i = 0; i < 16; ++i) { LAS float* d = scr + (4 * i + kq) * 65 + 4 * a; const float gk = gain ? 64.0f * gain[k0 + 4 * i + kq] : 64.0f; d[0] = v[i].x * gk; d[1] = v[i].y * gk; d[2] = v[i].z * gk; d[3] = v[i].w * gk; }
    LDS_WAIT(); asm volatile("" ::: "memory");
    const int c = lane & 7, nl = lane >> 3;
#pragma unroll
    for (int j = 0; j < 8; ++j) { const int n = nl + 8 * j; const LAS float* sp = scr + (8 * c) * 65 + n;
        v2u o; o.x = pk4_fp8(sp[0 * 65], sp[1 * 65], sp[2 * 65], sp[3 * 65]); o.y = pk4_fp8(sp[4 * 65], sp[5 * 65], sp[6 * 65], sp[7 * 65]);
        *(v2u*)(WT8 + (size_t)(outrow0 + n) * ldt + k0 + 8 * c) = o; }
    LDS_WAIT(); asm volatile("" ::: "memory");
}
__device__ __forceinline__ void tr_matrix(Ctx& C, const float* W, int K, int N, int NP, bf16* WT, int gu, int& cursor, const float* gain = nullptr, bool fp8 = false) {
    LAS float* scr = (LAS float*)(C.lds + C.wave * 16640);
    const int gw = C.bid * NWAVES + C.wave, NGW = C.G * NWAVES;
    const int nblk = NP / 64, nitems = (K / 64) * nblk;
    int first = (gw - (cursor % NGW) + NGW) % NGW;
    for (int it = first; it < nitems; it += NGW) {
        const int kb = it / nblk, nb = it % nblk, k0 = 64 * kb, n0 = 64 * nb;
        int orow = n0;
        if (gu) orow = (n0 / 128) * 256 + (n0 % 128) + (gu == 2 ? 128 : 0);
        if (fp8) tr_item8(W, N, (unsigned char*)WT, K, k0, n0, orow, scr, C.lane, gain); else tr_item(W, N, WT, K, k0, n0, orow, scr, C.lane, gain);
    }
    cursor += nitems;
}
__device__ __forceinline__ void rms_row_to_bf16(const float* xrow, const float* g, bf16* orow, int lane) {
    const f32x4* xr = (const f32x4*)xrow + lane; const f32x4* gr = (const f32x4*)g + lane;
    f32x4 v[4]; float s = 0.f;
#pragma unroll
    for (int j = 0; j < 4; ++j) { v[j] = xr[64 * j]; s += (v[j].x * v[j].x + v[j].y * v[j].y) + (v[j].z * v[j].z + v[j].w * v[j].w); }
    const float rstd = 1.0f / sqrtf(wave_sum(s) * (1.f / D) + RMS_EPS);
    unsigned long long* o8 = (unsigned long long*)orow + lane;
#pragma unroll
    for (int j = 0; j < 4; ++j) { const f32x4 gg = gr[64 * j]; o8[64 * j] = (unsigned long long)pk2(v[j].x * rstd * gg.x, v[j].y * rstd * gg.y) | ((unsigned long long)pk2(v[j].z * rstd * gg.z, v[j].w * rstd * gg.w) << 32); }
}
__device__ __forceinline__ void phase_norm(Ctx& C, const float* src, const float* g) {
    const int gw = C.bid * NWAVES + C.wave, NGW = C.G * NWAVES; bf16* HN = WSP(bf16, WS_HN);
    for (int m = gw; m < M; m += NGW) rms_row_to_bf16(src + (size_t)m * D, g, HN + (size_t)m * D, C.lane);
}
__device__ __forceinline__ void phase_prologue(Ctx& C) {
    const float* const out_norm_g = INP(17);
    const float* const norm2_g = INP(19);
    const float* const x = INP(0);
    const float* const rel_bias = INP(1);
    const float* const norm1_g = INP(2);
    const float* const w_in = INP(3);
    const float* const cmp_pos = INP(13);
    const float* const cmp_w1 = INP(14);
    const float* const w_out = INP(18);
    const float* const ffn_w_gate = INP(20);
    const float* const ffn_w_up = INP(21);
    const float* const ffn_w_down = INP(22);
    const float* const moe_w_gate = INP(24);
    const float* const moe_w_up = INP(25);
    const float* const moe_w_down = INP(26);
    int cur = 0;
    for (int l = 0; l < DEPTH; ++l) {
        tr_matrix(C, w_in + (size_t)l * D * D_IN, D, D_IN, NPROJ, WSP(bf16, WS_WIN) + (size_t)l * NPROJ * D, 0, cur, norm1_g + l * D, INPROJ_FP8(l));
        tr_matrix(C, w_out + (size_t)l * D * D, D, D, D, WSP(bf16, WS_WOUT) + (size_t)l * D * D, 0, cur, out_norm_g + l * D);
        for (int k = 0; k < 2; ++k) tr_matrix(C, cmp_w1 + (size_t)(l * 2 + k) * 2048 * 128, 2048, 128, 128, WSP(bf16, WS_CW1) + (size_t)(l * 2 + k) * 128 * 2048, 0, cur);
    }
    tr_matrix(C, ffn_w_gate, D, FF, FF, WSP(bf16, WS_FGU), 1, cur, norm2_g, true);
    tr_matrix(C, ffn_w_up, D, FF, FF, WSP(bf16, WS_FGU), 2, cur, norm2_g, true);
    tr_matrix(C, ffn_w_down, FF, D, D, WSP(bf16, WS_FD), 0, cur, nullptr, true);
    for (int e = 0; e < NE; ++e) {
        tr_matrix(C, moe_w_gate + (size_t)e * D * FF, D, FF, FF, (bf16*)(WSP(unsigned char, WS_MGU) + (size_t)e * NGU * D), 1, cur, norm2_g + D, true);
        tr_matrix(C, moe_w_up + (size_t)e * D * FF, D, FF, FF, (bf16*)(WSP(unsigned char, WS_MGU) + (size_t)e * NGU * D), 2, cur, norm2_g + D, true);
        tr_matrix(C, moe_w_down + (size_t)e * FF * D, FF, D, D, (bf16*)(WSP(unsigned char, WS_MD) + (size_t)e * D * FF), 0, cur, nullptr, true);
    }
    float* BT = WSP(float, WS_TAB); float* CB = WSP(float, WS_TAB + 8192);
    const int gt = C.bid * NTHR + C.tid, NGT = C.G * NTHR;
    for (int i = gt; i < NH * 128; i += NGT) { const int h = i >> 7, dd = i & 127; BT[i] = rel_bias[(int)T5_BUCKET[dd] * NH + h]; }
    if (gt < NH) { float mx = -3.0e38f; for (int bk = 0; bk < 32; ++bk) mx = fmaxf(mx, rel_bias[bk * NH + gt]); BT[NH * 128 + gt] = mx; }
    { const int gw = C.bid * NWAVES + C.wave, NGW = C.G * NWAVES;
      for (int i = gw; i < DEPTH * 2 * 128; i += NGW) { const int lk = i >> 7, c = i & 127; const float* pos = cmp_pos + (size_t)lk * 2048; const float* w1 = cmp_w1 + (size_t)lk * 2048 * 128 + c;
        float s = 0.f;
#pragma unroll 8
        for (int k = C.lane; k < 2048; k += 64) s += pos[k] * w1[(size_t)k * 128];
        s = wave_sum(s); if (C.lane == 0) CB[i] = s; } }
    { const float* const cmp_w2p = INP(15); v4u* W2F = (v4u*)WSP(unsigned char, WS_TAB + 65536);
      for (int i = gt; i < DEPTH * 2 * 16 * 64; i += NGT) { const int ln = i & 63, sm = (i >> 6) & 15, lk = i >> 10, s2 = sm >> 1, mt2 = sm & 1, cl2 = ln & 31, hh2 = ln >> 5;
          const float* p = cmp_w2p + (size_t)lk * 128 * 64 + (size_t)(16 * s2 + 8 * hh2) * 64 + 32 * mt2 + cl2;
          v4u a; a.x = pk2(p[0], p[64]); a.y = pk2(p[128], p[192]); a.z = pk2(p[256], p[320]); a.w = pk2(p[384], p[448]); W2F[i] = a; } }
    int* RT = WSP(int, WS_ROWTOK); float* RW = WSP(float, WS_ROWW);
    for (int i = gt; i < 2 * MOE_ROWS; i += NGT) { RT[i] = -1; RW[i] = 0.f; WSP(float, WS_ROWRS)[i] = 0.f; }
    { const int gw = C.bid * NWAVES + C.wave, NGW = C.G * NWAVES; bf16* XB = WSP(bf16, WS_HN); float* SSQ = WSP(float, WS_SSQ);
      for (int m0 = gw; m0 < M; m0 += 2 * NGW) {
          f32x4 v[2][4];
#pragma unroll
          for (int r = 0; r < 2; ++r) { const int m = m0 + r * NGW; const f32x4* xr = (const f32x4*)(x + (size_t)(m < M ? m : 0) * D) + C.lane;
#pragma unroll
              for (int j = 0; j < 4; ++j) v[r][j] = xr[64 * j]; }
#pragma unroll
          for (int r = 0; r < 2; ++r) { const int m = m0 + r * NGW; if (m >= M) break;
              float s2 = 0.f;
#pragma unroll
              for (int j = 0; j < 4; ++j) s2 += (v[r][j].x * v[r][j].x + v[r][j].y * v[r][j].y) + (v[r][j].z * v[r][j].z + v[r][j].w * v[r][j].w);
              s2 = wave_sum(s2);
              unsigned long long* o8 = (unsigned long long*)(XB + (size_t)m * D) + C.lane;
#pragma unroll
              for (int j = 0; j < 4; ++j) o8[64 * j] = (unsigned long long)pk2(v[r][j].x, v[r][j].y) | ((unsigned long long)pk2(v[r][j].z, v[r][j].w) << 32);
              if (C.lane < 16) SSQ[(size_t)m * 16 + C.lane] = (C.lane == 0) ? s2 : 0.f; } } }
}

__device__ __forceinline__ void prep_qknorm(Ctx& C, int l) {
    const float* const q_norm_g = INP(11);
    const float* const k_norm_g = INP(12);
    const int gw = C.bid * NWAVES + C.wave, NGW = C.G * NWAVES, lane = C.lane;
    const bf16* PROJ = WSP(bf16, WS_PROJ); bf16* QN = WSP(bf16, WS_QN); bf16* KSN = WSP(bf16, WS_KSN); bf16* KWN = WSP(bf16, WS_KWN);
    float qg[8], kg[8];
#pragma unroll
    for (int j = 0; j < 8; ++j) { qg[j] = 0.125f * q_norm_g[l * HD + (8 * lane) % 64 + j]; kg[j] = k_norm_g[l * HD + (8 * lane) % 64 + j]; }
    for (int m0 = gw; m0 < M; m0 += 4 * NGW) {
        v4u wq[4], wk[4];
        const int l32 = lane & 31; const int colk = (l32 < 16) ? (C_KS + 8 * l32) : (C_KW + 8 * (l32 - 16));
#pragma unroll
        for (int r = 0; r < 4; ++r) { const int m = m0 + r * NGW; const bf16* p = PROJ + (size_t)(m < M ? m : 0) * NPROJ; wq[r] = *(const v4u*)(p + C_Q + 8 * lane); wk[r] = *(const v4u*)(p + colk); }
#pragma unroll
        for (int r = 0; r < 4; ++r) {
            const int m = m0 + r * NGW; if (m >= M) break;
            const int b = m / SEQ, t = m % SEQ;
            {
                const v4u w = wq[r];
                float v[8] = {bflo(w.x), bfhi(w.x), bflo(w.y), bfhi(w.y), bflo(w.z), bfhi(w.z), bflo(w.w), bfhi(w.w)};
                float ss = 0.f;
#pragma unroll
                for (int j = 0; j < 8; ++j) ss += v[j] * v[j];
                ss += __shfl_xor(ss, 1); ss += __shfl_xor(ss, 2); ss += __shfl_xor(ss, 4);
                const float rstd = 1.0f / sqrtf(ss * (1.f / 64.f) + RMS_EPS);
                v4u o; o.x = pk2(v[0] * rstd * qg[0], v[1] * rstd * qg[1]); o.y = pk2(v[2] * rstd * qg[2], v[3] * rstd * qg[3]); o.z = pk2(v[4] * rstd * qg[4], v[5] * rstd * qg[5]); o.w = pk2(v[6] * rstd * qg[6], v[7] * rstd * qg[7]);
                *(v4u*)(QN + (size_t)m * 512 + 8 * lane) = o;
            }
            {
                const v4u w = wk[r];
                float v[8] = {bflo(w.x), bfhi(w.x), bflo(w.y), bfhi(w.y), bflo(w.z), bfhi(w.z), bflo(w.w), bfhi(w.w)};
                float ss = 0.f;
#pragma unroll
                for (int j = 0; j < 8; ++j) ss += v[j] * v[j];
                ss += __shfl_xor(ss, 1); ss += __shfl_xor(ss, 2); ss += __shfl_xor(ss, 4);
                const float rstd = 1.0f / sqrtf(ss * (1.f / 64.f) + RMS_EPS);
                v4u o; o.x = pk2(v[0] * rstd * kg[0], v[1] * rstd * kg[1]); o.y = pk2(v[2] * rstd * kg[2], v[3] * rstd * kg[3]); o.z = pk2(v[4] * rstd * kg[4], v[5] * rstd * kg[5]); o.w = pk2(v[6] * rstd * kg[6], v[7] * rstd * kg[7]);
                const int g = (l32 >> 3) & 1, dd = 8 * (l32 & 7);
                if (lane < 16) *(v4u*)(KSN + ((size_t)(b * NG + g) * SEQ + t) * HD + dd) = o;
                else if (lane < 32) *(v4u*)(KWN + ((size_t)(b * NG + g) * SEQ + t) * HD + dd) = o;
            }
        }
    }
    {
        bf16* VST = WSP(bf16, WS_VST); bf16* VWT = WSP(bf16, WS_VWT);
        const int mi = C.wave & 3, dh = C.wave >> 2, g = mi & 1; const int col = ((mi >> 1) ? C_VW : C_VS) + g * HD + dh * 32; bf16* dstm = (mi >> 1) ? VWT : VST;
        for (int it = C.bid; it < BATCH * (SEQ / 64); it += C.G) {
            const int b = it / (SEQ / 64), t0 = (it % (SEQ / 64)) * 64;
            const v4u* src = (const v4u*)(PROJ + (size_t)(b * SEQ + t0 + lane) * NPROJ + col);
            bf16* dst = dstm + ((size_t)(b * NG + g) * HD + dh * 32) * SEQ + t0 + lane;
#pragma unroll
            for (int c = 0; c < 4; ++c) { const v4u w = src[c];
                dst[(size_t)(8 * c + 0) * SEQ] = (bf16)(w.x & 0xffffu); dst[(size_t)(8 * c + 1) * SEQ] = (bf16)(w.x >> 16); dst[(size_t)(8 * c + 2) * SEQ] = (bf16)(w.y & 0xffffu); dst[(size_t)(8 * c + 3) * SEQ] = (bf16)(w.y >> 16);
                dst[(size_t)(8 * c + 4) * SEQ] = (bf16)(w.z & 0xffffu); dst[(size_t)(8 * c + 5) * SEQ] = (bf16)(w.z >> 16); dst[(size_t)(8 * c + 6) * SEQ] = (bf16)(w.w & 0xffffu); dst[(size_t)(8 * c + 7) * SEQ] = (bf16)(w.w >> 16); }
        }
    }
}
constexpr int CMP_HP = 136;
__device__ __forceinline__ void prep_compress(Ctx& C, int l) {
    const float* const k_norm_g = INP(12);
    const float* const cmp_w2 = INP(15);
    const bf16* PROJ = WSP(bf16, WS_PROJ); const float* CB = WSP(float, WS_TAB + 8192); const bf16* W1T = WSP(bf16, WS_CW1);
    LAS float* RED = (LAS float*)C.lds;
    LAS bf16* HL = (LAS bf16*)(C.lds + 16384);
    const int lane = C.lane, w = C.wave, mc = w & 3, kh = w >> 2, cl = lane & 31, hh = lane >> 5;
    for (int it = C.bid; it < 16 * 16; it += C.G) {
        const int rt = it & 15, kind = (it >> 4) & 1, g = (it >> 5) & 1, b = it >> 6, bg = b * NG + g, n0 = 32 * rt;
        const int col0 = (kind ? C_VC : C_KC) + g * HD;
        f32x16 acc;
#pragma unroll
        for (int i = 0; i < 16; ++i) acc[i] = 0.f;
        {
            const bf16* ap = W1T + ((size_t)(l * 2 + kind) * 128 + 32 * mc + cl) * 2048 + 1024 * kh + 8 * hh;
            const bf16* xb = PROJ + (size_t)b * SEQ * NPROJ + col0 + 8 * hh; const int tau0 = 16 * (n0 + cl) + 16 * kh;
#pragma unroll 1
            for (int q0 = 0; q0 < 16; q0 += 4) {
                abf16x8 af[4][4], bfr[4][4];
#pragma unroll
                for (int qq = 0; qq < 4; ++qq) { int tau = tau0 + q0 + qq; tau = tau < SEQ ? tau : SEQ - 1; const bf16* xp = xb + (size_t)tau * NPROJ;
#pragma unroll
                    for (int j = 0; j < 4; ++j) { af[qq][j] = *(const abf16x8*)(ap + 64 * (q0 + qq) + 16 * j); bfr[qq][j] = *(const abf16x8*)(xp + 16 * j); } }
#pragma unroll
                for (int qq = 0; qq < 4; ++qq)
#pragma unroll
                    for (int j = 0; j < 4; ++j) acc = __builtin_amdgcn_mfma_f32_32x32x16_bf16(af[qq][j], bfr[qq][j], acc, 0, 0, 0);
            }
        }
        if (kh == 1) {
#pragma unroll
            for (int i = 0; i < 16; ++i) RED[(mc * 16 + i) * 64 + lane] = acc[i];
        }
        __syncthreads();
        if (kh == 0) {
#pragma unroll
            for (int i = 0; i < 16; ++i) { const int c = 32 * mc + (i & 3) + 8 * (i >> 2) + 4 * hh;
                const float s = acc[i] + RED[(mc * 16 + i) * 64 + lane] + CB[(l * 2 + kind) * 128 + c];
                HL[cl * CMP_HP + c] = (bf16)f2bf(gelu_tanh(s)); }
        }
        __syncthreads();
        if (w == 0) {
            f32x16 o[2];
#pragma unroll
            for (int i = 0; i < 16; ++i) { o[0][i] = 0.f; o[1][i] = 0.f; }
            const v4u* W2F = (const v4u*)WSP(unsigned char, WS_TAB + 65536);
#pragma unroll
            for (int s = 0; s < 8; ++s) {
                const abf16x8 hb = *(const LAS abf16x8*)(HL + cl * CMP_HP + 16 * s + 8 * hh);
#pragma unroll
                for (int mt = 0; mt < 2; ++mt) { const v4u a = W2F[((l * 2 + kind) * 16 + 2 * s + mt) * 64 + lane];
                    o[mt] = __builtin_amdgcn_mfma_f32_32x32x16_bf16(__builtin_bit_cast(abf16x8, a), hb, o[mt], 0, 0, 0); }
            }
            const int n = n0 + cl; const bool okn = n < NCMP;
            if (kind == 0) {
                float ss = 0.f;
#pragma unroll
                for (int i = 0; i < 16; ++i) ss += o[0][i] * o[0][i] + o[1][i] * o[1][i];
                ss += __shfl_xor(ss, 32);
                const float rstd = 1.0f / sqrtf(ss * (1.f / 64.f) + RMS_EPS);
                bf16* dst = WSP(bf16, WS_KC) + ((size_t)bg * NCMPP + n) * HD;
#pragma unroll
                for (int mt = 0; mt < 2; ++mt)
#pragma unroll
                    for (int q4 = 0; q4 < 4; ++q4) { const int d0 = 32 * mt + 8 * q4 + 4 * hh; const float* kg = k_norm_g + l * HD + d0;
                        v2u ov; ov.x = okn ? pk2(o[mt][4 * q4] * rstd * kg[0], o[mt][4 * q4 + 1] * rstd * kg[1]) : 0u; ov.y = okn ? pk2(o[mt][4 * q4 + 2] * rstd * kg[2], o[mt][4 * q4 + 3] * rstd * kg[3]) : 0u;
                        *(v2u*)(dst + d0) = ov; }
            } else {
                bf16* dst = WSP(bf16, WS_VC) + (size_t)bg * HD * NCMPP + n;
#pragma unroll
                for (int mt = 0; mt < 2; ++mt)
#pragma unroll
                    for (int i = 0; i < 16; ++i) { const int dd = 32 * mt + (i & 3) + 8 * (i >> 2) + 4 * hh; dst[(size_t)dd * NCMPP] = okn ? (bf16)f2bf(o[mt][i]) : (bf16)0; }
            }
        }
    }
    __syncthreads();
}
__device__ __forceinline__ void mixnorm_row(const bf16* PROJ, bf16* MIX, const float (&g1)[8], const float (&g2)[8], size_t m, int lane) {
    const bf16* p = PROJ + m * NPROJ;
    const v4u w1 = *(const v4u*)(p + C_LG + 8 * lane), w2 = *(const v4u*)(p + C_Q + 8 * lane);
    float a[8] = {bflo(w1.x), bfhi(w1.x), bflo(w1.y), bfhi(w1.y), bflo(w1.z), bfhi(w1.z), bflo(w1.w), bfhi(w1.w)};
    float c[8] = {bflo(w2.x), bfhi(w2.x), bflo(w2.y), bfhi(w2.y), bflo(w2.z), bfhi(w2.z), bflo(w2.w), bfhi(w2.w)};
    float sa = 0.f, sc = 0.f;
#pragma unroll
    for (int j = 0; j < 8; ++j) { sa += a[j] * a[j]; sc += c[j] * c[j]; }
    const float ra = 1.0f / sqrtf(wave_sum(sa) * (1.f / 512.f) + RMS_EPS), rc = 1.0f / sqrtf(wave_sum(sc) * (1.f / 512.f) + RMS_EPS);
    v4u o1, o2;
    o1.x = pk2(a[0] * ra * g1[0], a[1] * ra * g1[1]); o1.y = pk2(a[2] * ra * g1[2], a[3] * ra * g1[3]); o1.z = pk2(a[4] * ra * g1[4], a[5] * ra * g1[5]); o1.w = pk2(a[6] * ra * g1[6], a[7] * ra * g1[7]);
    o2.x = pk2(c[0] * rc * g2[0], c[1] * rc * g2[1]); o2.y = pk2(c[2] * rc * g2[2], c[3] * rc * g2[3]); o2.z = pk2(c[4] * rc * g2[4], c[5] * rc * g2[5]); o2.w = pk2(c[6] * rc * g2[6], c[7] * rc * g2[7]);
    *(v4u*)(MIX + m * D + 8 * lane) = o1; *(v4u*)(MIX + m * D + 512 + 8 * lane) = o2;
}
constexpr int LRU_XC_LD = 72;
template <int PASS>
__device__ __forceinline__ void lru_chunks(Ctx& C, int l) {
    const float* const conv_w = INP(4);
    const float* const conv_b = INP(5);
    const float* const lru_wa = INP(6);
    const float* const lru_ba = INP(7);
    const float* const lru_wx = INP(8);
    const float* const lru_bx = INP(9);
    const float* const lru_lambda = INP(10);
    bf16* PROJ = WSP(bf16, WS_PROJ); float* AGGA = WSP(float, WS_AGGA); float* AGGH = WSP(float, WS_AGGH); const float* HIN = WSP(float, WS_HIN);
    const int lane = C.lane, h = C.wave, d = h * 64 + lane, hh = lane >> 5, cl = lane & 31;
    LAS bf16* XC = (LAS bf16*)(C.lds + h * (64 * LRU_XC_LD * 2));
    LAS bf16* GT = (LAS bf16*)(C.lds + 8 * (64 * LRU_XC_LD * 2) + h * (64 * LRU_XC_LD * 2));
    abf16x8 Wa[2][4], Wx[2][4];
#pragma unroll
    for (int nt = 0; nt < 2; ++nt)
#pragma unroll
        for (int ks = 0; ks < 4; ++ks) {
            const float* pa = lru_wa + ((size_t)(l * 8 + h) * 64 + 16 * ks + 8 * hh) * 64 + 32 * nt + cl; const float* px = lru_wx + ((size_t)(l * 8 + h) * 64 + 16 * ks + 8 * hh) * 64 + 32 * nt + cl;
            v4u a, x; a.x = pk2(pa[0], pa[64]); a.y = pk2(pa[128], pa[192]); a.z = pk2(pa[256], pa[320]); a.w = pk2(pa[384], pa[448]);
            x.x = pk2(px[0], px[64]); x.y = pk2(px[128], px[192]); x.z = pk2(px[256], px[320]); x.w = pk2(px[384], px[448]);
            Wa[nt][ks] = __builtin_bit_cast(abf16x8, a); Wx[nt][ks] = __builtin_bit_cast(abf16x8, x);
        }
    float ba[2], bx[2], c8[2];
#pragma unroll
    for (int nt = 0; nt < 2; ++nt) { const int ch = l * D_LRU + h * 64 + 32 * nt + cl; ba[nt] = lru_ba[ch]; bx[nt] = lru_bx[ch]; c8[nt] = -8.0f * log1pf(__expf(-lru_lambda[ch])); }
    const float cw0 = conv_w[(l * 4 + 0) * D_LRU + d], cw1 = conv_w[(l * 4 + 1) * D_LRU + d], cw2 = conv_w[(l * 4 + 2) * D_LRU + d], cw3 = conv_w[(l * 4 + 3) * D_LRU + d];
    const float cb = conv_b[l * D_LRU + d];
    for (int u = C.bid; u < BATCH * NCHUNK; u += C.G) {
        const int b = u / NCHUNK, ch = u % NCHUNK, t0 = ch * LCH;
        {
            const bf16* xp = PROJ + (size_t)(b * SEQ + t0) * NPROJ + C_LX + d;
            float xm3 = 0.f, xm2 = 0.f, xm1 = 0.f;
            if (t0 > 0) { xm3 = bf2f(xp[-3 * NPROJ]); xm2 = bf2f(xp[-2 * NPROJ]); xm1 = bf2f(xp[-1 * NPROJ]); }
#pragma unroll 8
            for (int tt = 0; tt < LCH; ++tt) {
                const float x0 = bf2f(xp[(size_t)tt * NPROJ]);
                if (PASS == 2) GT[tt * LRU_XC_LD + lane] = xp[(size_t)tt * NPROJ + (C_LG - C_LX)];
                const float xc = cw0 * xm3 + cw1 * xm2 + cw2 * xm1 + cw3 * x0 + cb;
                xm3 = xm2; xm2 = xm1; xm1 = x0;
                XC[tt * LRU_XC_LD + lane] = (bf16)f2bf(xc);
            }
        }
        float st[2], ap[2];
#pragma unroll
        for (int nt = 0; nt < 2; ++nt) { st[nt] = (PASS == 2) ? HIN[(size_t)(b * NCHUNK + ch) * D_LRU + h * 64 + 32 * nt + cl] : 0.f; ap[nt] = 1.f; }
        bf16* gbase = PROJ + (size_t)(b * SEQ + t0) * NPROJ + C_LG + h * 64;
#pragma unroll 1
        for (int mt = 0; mt < 2; ++mt) {
            const int goff = (32 * mt + 4 * hh) * NPROJ + cl;
            abf16x8 af[4];
#pragma unroll
            for (int ks = 0; ks < 4; ++ks) af[ks] = *(const LAS abf16x8*)(XC + (32 * mt + cl) * LRU_XC_LD + 16 * ks + 8 * hh);
#pragma unroll
            for (int nt = 0; nt < 2; ++nt) {
                f32x16 R, I;
#pragma unroll
                for (int i = 0; i < 16; ++i) { R[i] = 0.f; I[i] = 0.f; }
#pragma unroll
                for (int ks = 0; ks < 4; ++ks) { R = __builtin_amdgcn_mfma_f32_32x32x16_bf16(af[ks], Wa[nt][ks], R, 0, 0, 0); I = __builtin_amdgcn_mfma_f32_32x32x16_bf16(af[ks], Wx[nt][ks], I, 0, 0, 0); }
                float a[16], uu[16];
#pragma unroll
                for (int i = 0; i < 16; ++i) {
                    const int tok = 32 * mt + (i & 3) + 8 * (i >> 2) + 4 * hh;
                    const float xc = bf2f(XC[tok * LRU_XC_LD + 32 * nt + cl]);
                    const float r = __builtin_amdgcn_rcpf(1.0f + __builtin_amdgcn_exp2f(-1.44269504089f * (R[i] + ba[nt])));
                    const float ig = __builtin_amdgcn_rcpf(1.0f + __builtin_amdgcn_exp2f(-1.44269504089f * (I[i] + bx[nt])));
                    const float av = __builtin_amdgcn_exp2f(1.44269504089f * c8[nt] * r);
                    a[i] = av; uu[i] = __builtin_amdgcn_sqrtf(fmaxf(1.0f - av * av, 0.f)) * (ig * xc);
                }
                float Ak[4], Uk[4], pA[4], pU[4], cin[4];
#pragma unroll
                for (int k = 0; k < 4; ++k) { Ak[k] = (a[4 * k] * a[4 * k + 1]) * (a[4 * k + 2] * a[4 * k + 3]); float v = uu[4 * k]; v = a[4 * k + 1] * v + uu[4 * k + 1]; v = a[4 * k + 2] * v + uu[4 * k + 2]; v = a[4 * k + 3] * v + uu[4 * k + 3]; Uk[k] = v; }
#pragma unroll
                for (int k = 0; k < 4; ++k) { pA[k] = __shfl_xor(Ak[k], 32); pU[k] = __shfl_xor(Uk[k], 32); }
                float s = st[nt];
#pragma unroll
                for (int k = 0; k < 4; ++k) {
                    const float A0 = hh ? pA[k] : Ak[k], U0 = hh ? pU[k] : Uk[k], A1 = hh ? Ak[k] : pA[k], U1 = hh ? Uk[k] : pU[k];
                    const float mid = A0 * s + U0;
                    cin[k] = hh ? mid : s;
                    s = A1 * mid + U1;
                    ap[nt] *= A0 * A1;
                }
                st[nt] = s;
                if (PASS == 2) {
#pragma unroll
                    for (int k = 0; k < 4; ++k) { float v = cin[k];
#pragma unroll
                        for (int j = 0; j < 4; ++j) { const int i = 4 * k + j; v = a[i] * v + uu[i];
                            const int gi = goff + (j + 8 * k) * NPROJ + 32 * nt;
                            const float gt = bf2f(GT[(32 * mt + j + 8 * k + 4 * hh) * LRU_XC_LD + 32 * nt + cl]); const bf16 yb = (bf16)f2bf(gelu_tanh(gt) * v); gbase[gi] = yb;
                            XC[(32 * mt + j + 8 * k + 4 * hh) * LRU_XC_LD + 32 * nt + cl] = yb; }
                        asm volatile("" ::: "memory"); }
                }
            }
        }
        if (PASS == 1) {
#pragma unroll
            for (int nt = 0; nt < 2; ++nt) { AGGA[(size_t)(b * NCHUNK + ch) * D_LRU + h * 64 + 32 * nt + cl] = ap[nt]; AGGH[(size_t)(b * NCHUNK + ch) * D_LRU + h * 64 + 32 * nt + cl] = st[nt]; }
        } else {
            { const LAS v4u* xr = (const LAS v4u*)(XC + lane * LRU_XC_LD); float ss = 0.f;
#pragma unroll
              for (int c8 = 0; c8 < 8; ++c8) { const v4u q = xr[c8]; ss += (bflo(q.x) * bflo(q.x) + bfhi(q.x) * bfhi(q.x)) + (bflo(q.y) * bflo(q.y) + bfhi(q.y) * bfhi(q.y)) + (bflo(q.z) * bflo(q.z) + bfhi(q.z) * bfhi(q.z)) + (bflo(q.w) * bflo(q.w) + bfhi(q.w) * bfhi(q.w)); }
              WSP(float, WS_SSQL)[((size_t)b * SEQ + t0 + lane) * 8 + h] = ss; }
        }
    }
}
__device__ __forceinline__ void lru_carry(Ctx& C) {
    const float* __restrict__ AGGA = WSP(float, WS_AGGA); const float* __restrict__ AGGH = WSP(float, WS_AGGH); float* __restrict__ HIN = WSP(float, WS_HIN);
    const int gt = C.bid * NTHR + C.tid;
    if (gt < BATCH * D_LRU) {
        const int b = gt / D_LRU, d = gt % D_LRU; float hs = 0.f;
        for (int c0 = 0; c0 < NCHUNK; c0 += 16) {
            float a[16], hh[16];
#pragma unroll
            for (int i = 0; i < 16; ++i) { a[i] = AGGA[(size_t)(b * NCHUNK + c0 + i) * D_LRU + d]; hh[i] = AGGH[(size_t)(b * NCHUNK + c0 + i) * D_LRU + d]; }
#pragma unroll
            for (int i = 0; i < 16; ++i) { HIN[(size_t)(b * NCHUNK + c0 + i) * D_LRU + d] = hs; hs = a[i] * hs + hh[i]; }
        }
    }
}

constexpr int ATT_KB = 0, ATT_VB = 32768, ATT_CK = 0, ATT_CV = 8192, ATT_IMP = 16384, ATT_IMP_LD = 132, ATT_OACC = 65536, ATT_OACC_LD = 65,
              ATT_L = ATT_OACC + 256 * ATT_OACC_LD * 4, ATT_LIST = ATT_L + 1024, ATT_CNT = ATT_LIST + 128 * 64, ATT_M2F = ATT_CNT + 512, ATT_M2R = ATT_M2F + 1024, ATT_END1 = ATT_M2R + 1024,
              ATT_BT = ATT_IMP + 256 * ATT_IMP_LD * 4, ATT_SELM = ATT_BT + 4 * 128 * 4, ATT_RL = ATT_SELM + 64 * 16, ATT_END = ATT_RL + 1024;
static_assert(ATT_END1 <= ATT_BT, "att lds overlay");
static_assert(ATT_END <= MISC_OFF, "att lds");
template <int CTRL> __device__ __forceinline__ unsigned dpp_u(unsigned v) { return (unsigned)__builtin_amdgcn_update_dpp((int)v, (int)v, CTRL, 0xF, 0xF, false); }
template <int CTRL> __device__ __forceinline__ float dpp_f(float v) { return __int_as_float(__builtin_amdgcn_update_dpp(__float_as_int(v), __float_as_int(v), CTRL, 0xF, 0xF, false)); }
__device__ __forceinline__ float quad_sum(float v) { v += dpp_f<0xB1>(v); v += dpp_f<0x4E>(v); return v; }
__device__ __forceinline__ unsigned row16_max(unsigned v) { unsigned t; t = dpp_u<0x128>(v); v = v > t ? v : t; t = dpp_u<0x124>(v); v = v > t ? v : t; t = dpp_u<0x122>(v); v = v > t ? v : t; t = dpp_u<0x121>(v); v = v > t ? v : t; return v; }
__device__ __forceinline__ unsigned row16_or(unsigned v) { v |= dpp_u<0x128>(v); v |= dpp_u<0x124>(v); v |= dpp_u<0x122>(v); v |= dpp_u<0x121>(v); return v; }

struct AttLane {
    int t, h, hl, tokl;
    unsigned koff0, voff0;
    const LAS float* btl;
};
#define BZ_PIN(b) asm volatile("" : "+v"(b[0]), "+v"(b[1]), "+v"(b[2]), "+v"(b[3]), "+v"(b[4]), "+v"(b[5]), "+v"(b[6]), "+v"(b[7]), "+v"(b[8]), "+v"(b[9]), "+v"(b[10]), "+v"(b[11]), "+v"(b[12]), "+v"(b[13]), "+v"(b[14]), "+v"(b[15]))
__device__ __forceinline__ void att_qk(const LAS unsigned char* Kb, const abf16x8 (&Qf)[4], const AttLane& A, f32x16& S0, f32x16& S1) {
    const f32x16 z = {0.f, 0.f, 0.f, 0.f, 0.f, 0.f, 0.f, 0.f, 0.f, 0.f, 0.f, 0.f, 0.f, 0.f, 0.f, 0.f};
    abf16x8 a0[4], a1[4];
#pragma unroll
    for (int ks = 0; ks < 4; ++ks) { a0[ks] = *(const LAS abf16x8*)(Kb + (A.koff0 ^ ((unsigned)(ks) << 5))); a1[ks] = *(const LAS abf16x8*)(Kb + 4096 + (A.koff0 ^ ((unsigned)(ks) << 5))); }
    S0 = __builtin_amdgcn_mfma_f32_32x32x16_bf16(a0[0], Qf[0], z, 0, 0, 0); S1 = __builtin_amdgcn_mfma_f32_32x32x16_bf16(a1[0], Qf[0], z, 0, 0, 0);
#pragma unroll
    for (int ks = 1; ks < 4; ++ks) { S0 = __builtin_amdgcn_mfma_f32_32x32x16_bf16(a0[ks], Qf[ks], S0, 0, 0, 0); S1 = __builtin_amdgcn_mfma_f32_32x32x16_bf16(a1[ks], Qf[ks], S1, 0, 0, 0); }
}
template <bool SLOW, bool WIN, int MODE>
__device__ __forceinline__ void att_sm(const f32x16& S0, const f32x16& S1, const AttLane& A, unsigned (&Pk)[2][8], float& lsum, const float m2, const int kp0, const int kstride, LAS float* improw, const int gbase, float& icar) {
    const float c1 = 1.44269504089f;
    const int dbase = A.t - kp0 - kstride * 8 * A.h;
#pragma unroll
    for (int st = 0; st < 2; ++st) {
        float p[16];
        float bz[16];
        if (SLOW) {
#pragma unroll
            for (int i = 0; i < 16; ++i) { const int dist = dbase - kstride * (32 * st + 16 * (i >> 3) + (i & 7)); bz[i] = A.btl[dist < 0 ? 0 : (dist > 127 ? 127 : dist)]; }
            BZ_PIN(bz);
        }
#pragma unroll
        for (int i = 0; i < 16; ++i) {
            const float sv = st ? S1[i] : S0[i];
            if (SLOW) {
                const int dist = dbase - kstride * (32 * st + 16 * (i >> 3) + (i & 7));
                bool valid = dist >= 0; if (WIN) valid = valid && (dist < 512);
                const float x = (sv + bz[i]) * c1 - m2;
                const float e = __builtin_amdgcn_exp2f(x);
                p[i] = valid ? e : 0.f;
            } else {
                p[i] = __builtin_amdgcn_exp2f(sv * c1 - m2);
            }
            lsum += p[i];
        }
        if (MODE >= 1) {
#pragma unroll
            for (int i = 0; i < 8; ++i) Pk[st][i] = pg8::cvt_pk_bf16(p[2 * i], p[2 * i + 1]);
        }
        if (MODE == 3) {
            float a[4], c[4];
#pragma unroll
            for (int u = 0; u < 4; ++u) { c[u] = 0.5f * p[4 * u + 3]; a[u] = (p[4 * u] + p[4 * u + 1]) + (p[4 * u + 2] + c[u]); }
            const float pc1 = __shfl_xor(c[1], 32), pc3 = __shfl_xor(c[3], 32);
            typedef float f32x2s __attribute__((ext_vector_type(2)));
            f32x2s w0, w1; w0.x = a[0] + (A.h ? pc1 : icar); w0.y = a[1] + c[0]; w1.x = a[2] + (A.h ? pc3 : pc1); w1.y = a[3] + c[2];
            icar = pc3;
            *(LAS f32x2s*)(improw + gbase + 8 * st) = w0; *(LAS f32x2s*)(improw + gbase + 8 * st + 4) = w1;
        }
        if (MODE == 2) {
#pragma unroll
            for (int u = 0; u < 4; ++u) {
                const float c = 0.5f * p[4 * u + 3];
                const float a = quad_sum((p[4 * u] + p[4 * u + 1]) + (p[4 * u + 2] + c)); const float cs = quad_sum(c);
                const int G = gbase + 8 * st + 4 * (u >> 1) + (u & 1);
                if (A.hl == 0) { (void)__builtin_amdgcn_ds_faddf(improw + G, a, 0, 0, false); if (G + 1 < NSELB) (void)__builtin_amdgcn_ds_faddf(improw + G + 1, cs, 0, 0, false); }
            }
        }
    }
}
__device__ __forceinline__ void att_pv(const LAS unsigned char* Vb, const AttLane& A, const unsigned (&Pk)[2][8], f32x16 (&O)[2]) {
#pragma unroll
    for (int s4 = 0; s4 < 4; ++s4) {
        typedef unsigned u4v __attribute__((ext_vector_type(4)));
        u4v pw; pw.x = Pk[s4 >> 1][4 * (s4 & 1) + 0]; pw.y = Pk[s4 >> 1][4 * (s4 & 1) + 1]; pw.z = Pk[s4 >> 1][4 * (s4 & 1) + 2]; pw.w = Pk[s4 >> 1][4 * (s4 & 1) + 3];
        const abf16x8 pb = __builtin_bit_cast(abf16x8, pw);
        const abf16x8 v0 = *(const LAS abf16x8*)(Vb + (A.voff0 ^ ((unsigned)(s4) << 5))); const abf16x8 v1 = *(const LAS abf16x8*)(Vb + 4096 + (A.voff0 ^ ((unsigned)(s4) << 5)));
        O[0] = __builtin_amdgcn_mfma_f32_32x32x16_bf16(v0, pb, O[0], 0, 0, 0); O[1] = __builtin_amdgcn_mfma_f32_32x32x16_bf16(v1, pb, O[1], 0, 0, 0);
    }
}
__device__ __forceinline__ void att_qk_half(const LAS unsigned char* Kb, const int st, const abf16x8 (&Qf)[4], const AttLane& A, f32x16& S) {
    const f32x16 z = {0.f, 0.f, 0.f, 0.f, 0.f, 0.f, 0.f, 0.f, 0.f, 0.f, 0.f, 0.f, 0.f, 0.f, 0.f, 0.f};
    abf16x8 a[4];
#pragma unroll
    for (int ks = 0; ks < 4; ++ks) a[ks] = *(const LAS abf16x8*)(Kb + st * 4096 + (A.koff0 ^ ((unsigned)(ks) << 5)));
    S = __builtin_amdgcn_mfma_f32_32x32x16_bf16(a[0], Qf[0], z, 0, 0, 0);
#pragma unroll
    for (int ks = 1; ks < 4; ++ks) S = __builtin_amdgcn_mfma_f32_32x32x16_bf16(a[ks], Qf[ks], S, 0, 0, 0);
}
template <bool SLOW, bool WIN>
__device__ __forceinline__ void att_sm_half(const f32x16& S, const int st, const AttLane& A, unsigned (&Pk)[8], float& lsum, const float m2, const int kp0) {
    const float c1 = 1.44269504089f;
    const int dbase = A.t - kp0 - 8 * A.h - 32 * st;
    float p[16];
    float bz[16];
    if (SLOW) {
#pragma unroll
        for (int i = 0; i < 16; ++i) { const int dist = dbase - (16 * (i >> 3) + (i & 7)); bz[i] = A.btl[dist < 0 ? 0 : (dist > 127 ? 127 : dist)]; }
        BZ_PIN(bz);
    }
#pragma unroll
    for (int i = 0; i < 16; ++i) {
        if (SLOW) {
            const int dist = dbase - (16 * (i >> 3) + (i & 7));
            const float e = __builtin_amdgcn_exp2f((S[i] + bz[i]) * c1 - m2);
            bool valid = dist >= 0; if (WIN) valid = valid && (dist < 512);
            p[i] = valid ? e : 0.f;
        } else p[i] = __builtin_amdgcn_exp2f(S[i] * c1 - m2);
        lsum += p[i];
    }
#pragma unroll
    for (int i = 0; i < 8; ++i) Pk[i] = pg8::cvt_pk_bf16(p[2 * i], p[2 * i + 1]);
}
template <bool ZERO = false>
__device__ __forceinline__ void att_pv_half(const LAS unsigned char* Vb, const int st, const AttLane& A, const unsigned (&Pk)[8], f32x16 (&O)[2]) {
    const f32x16 z = {0.f, 0.f, 0.f, 0.f, 0.f, 0.f, 0.f, 0.f, 0.f, 0.f, 0.f, 0.f, 0.f, 0.f, 0.f, 0.f};
#pragma unroll
    for (int u = 0; u < 2; ++u) {
        typedef unsigned u4v __attribute__((ext_vector_type(4)));
        u4v pw; pw.x = Pk[4 * u + 0]; pw.y = Pk[4 * u + 1]; pw.z = Pk[4 * u + 2]; pw.w = Pk[4 * u + 3];
        const abf16x8 pb = __builtin_bit_cast(abf16x8, pw);
        const abf16x8 v0 = *(const LAS abf16x8*)(Vb + (A.voff0 ^ ((unsigned)(2 * st + u) << 5))); const abf16x8 v1 = *(const LAS abf16x8*)(Vb + 4096 + (A.voff0 ^ ((unsigned)(2 * st + u) << 5)));
        O[0] = __builtin_amdgcn_mfma_f32_32x32x16_bf16(v0, pb, (ZERO && u == 0) ? z : O[0], 0, 0, 0); O[1] = __builtin_amdgcn_mfma_f32_32x32x16_bf16(v1, pb, (ZERO && u == 0) ? z : O[1], 0, 0, 0);
    }
}
template <bool SLOW, bool WIN, int MODE>
__device__ __forceinline__ void att_block(const LAS unsigned char* Kb, const LAS unsigned char* Vb, const abf16x8 (&Qf)[4], const AttLane& A, f32x16 (&O)[2], float& lsum, const float m2,
                                          const int kp0, const int kstride, LAS float* improw, const int gbase, float& icar) {
    f32x16 S0, S1; unsigned Pk[2][8];
    att_qk(Kb, Qf, A, S0, S1);
    att_sm<SLOW, WIN, MODE>(S0, S1, A, Pk, lsum, m2, kp0, kstride, improw, gbase, icar);
    if (MODE >= 1) att_pv(Vb, A, Pk, O);
}
struct AttStage { v4u k, v; };
__device__ __forceinline__ void att_fetch_k(AttStage& R, const bf16* Kg, int tid) { const int r = tid >> 3, c = tid & 7; R.k = *(const v4u*)(Kg + (size_t)r * HD + c * 8); }
__device__ __forceinline__ void att_fetch_v(AttStage& R, const bf16* VTg, int ldv, int tid) { const int r = tid >> 3, c = tid & 7; R.v = *(const v4u*)(VTg + (size_t)r * ldv + c * 8); }
__device__ __forceinline__ void att_put_k(const AttStage& R, LAS unsigned char* lds, int buf, int tid) { const int r = tid >> 3, c = tid & 7; *(LAS v4u*)(lds + ATT_KB + buf * 8192 + (r * 8 + (c ^ ((r >> 1) & 7))) * 16) = R.k; }
__device__ __forceinline__ void att_put_v(const AttStage& R, LAS unsigned char* lds, int buf, int tid) { const int r = tid >> 3, c = tid & 7; *(LAS v4u*)(lds + ATT_VB + buf * 8192 + (r * 8 + (c ^ ((r >> 1) & 7))) * 16) = R.v; }
__device__ __forceinline__ void att_put_c(const AttStage& R, LAS unsigned char* lds, int tid) { const int r = tid >> 3, c = tid & 7; const int o = (r * 8 + (c ^ ((r >> 1) & 7))) * 16;
    *(LAS v4u*)(lds + ATT_CK + o) = R.k; *(LAS v4u*)(lds + ATT_CV + o) = R.v; }
__device__ __forceinline__ void att_fetch(AttStage& R, const bf16* Kg, const bf16* VTg, int ldv, int tid) { att_fetch_k(R, Kg, tid); att_fetch_v(R, VTg, ldv, tid); }
__device__ __forceinline__ void att_put(const AttStage& R, LAS unsigned char* lds, int buf, int tid) { att_put_k(R, lds, buf, tid); att_put_v(R, lds, buf, tid); }
__device__ __forceinline__ void att_dma(const bf16* g, const int pitch, LAS unsigned char* dstw, const int tid) {
    const int r = tid >> 3, c = (tid & 7) ^ ((r >> 1) & 7);
    __builtin_amdgcn_global_load_lds((const unsigned*)(g + (size_t)r * pitch + c * 8), (LAS unsigned*)dstw, 16, 0, 0);
}
template <bool SLOW, bool WIN>
__device__ __forceinline__ void att_pipe_iter(LAS unsigned char* lds, const bf16* kg, const bf16* vg, const int i, const int j, const int jk, const int jv, const bool sel, const int wv,
                                              const abf16x8 (&Qf)[4], const AttLane& A, f32x16& S0, f32x16& S1, f32x16 (&O)[2], float& ls, const float m2, const int tid) {
    att_dma(kg + (size_t)jk * 64 * HD, HD, lds + ATT_KB + ((i + 3) & 3) * 8192 + wv * 1024, tid);
    att_dma(vg + jv * 64, SEQ, lds + ATT_VB + ((i + 2) % 3) * 8192 + wv * 1024, tid);
    const LAS unsigned char* Kc = lds + ATT_KB + (i & 3) * 8192; const LAS unsigned char* Kn = lds + ATT_KB + ((i + 1) & 3) * 8192; const LAS unsigned char* Vb = lds + ATT_VB + (i % 3) * 8192;
    if (__ballot(sel) != 0ull) {
        unsigned Pk0[8], Pk1[8];
        att_qk_half(Kc, 1, Qf, A, S1);
        att_sm_half<SLOW, WIN>(S0, 0, A, Pk0, ls, m2, 64 * j);
        __builtin_amdgcn_sched_barrier(0);
        att_qk_half(Kn, 0, Qf, A, S0);
        att_pv_half(Vb, 0, A, Pk0, O);
        att_sm_half<SLOW, WIN>(S1, 1, A, Pk1, ls, m2, 64 * j);
        att_pv_half(Vb, 1, A, Pk1, O);
    } else {
        att_qk_half(Kn, 0, Qf, A, S0);
    }
    asm volatile("s_waitcnt vmcnt(2)" ::: "memory");
    __builtin_amdgcn_s_barrier();
    asm volatile("" ::: "memory");
}
__device__ __forceinline__ void att_pipe_start(LAS unsigned char* lds, const bf16* kg, const bf16* vg, const int j0, const int j1, const int j2, const int wv, const abf16x8 (&Qf)[4], const AttLane& A, f32x16& S0, const int tid) {
    att_dma(kg + (size_t)j0 * 64 * HD, HD, lds + ATT_KB + 0 * 8192 + wv * 1024, tid); att_dma(vg + j0 * 64, SEQ, lds + ATT_VB + 0 * 8192 + wv * 1024, tid);
    att_dma(kg + (size_t)j1 * 64 * HD, HD, lds + ATT_KB + 1 * 8192 + wv * 1024, tid); att_dma(vg + j1 * 64, SEQ, lds + ATT_VB + 1 * 8192 + wv * 1024, tid);
    att_dma(kg + (size_t)j2 * 64 * HD, HD, lds + ATT_KB + 2 * 8192 + wv * 1024, tid);
    asm volatile("s_waitcnt vmcnt(0)" ::: "memory");
    __builtin_amdgcn_s_barrier();
    asm volatile("" ::: "memory");
    att_qk_half(lds + ATT_KB, 0, Qf, A, S0);
}
template <bool SLOW>
__device__ __forceinline__ void att_visit(const LAS unsigned char* Kb, const LAS unsigned char* Vb, const bf16* QNb, const int j, const int qi, const int grp, const int cnt,
                                          const LAS unsigned char* list, const LAS float* M2, LAS float* Oacc, LAS float* Lacc, const AttLane& A0, const int lane) {
    AttLane A = A0;
    const int sl = 8 * grp + ((lane & 31) >> 2); const bool valid = sl < cnt;
    const int tok = valid ? (int)list[sl] : 0; const int row = tok * 4 + A.hl;
    abf16x8 Qf[4];
#pragma unroll
    for (int ks = 0; ks < 4; ++ks) Qf[ks] = __builtin_bit_cast(abf16x8, *(const v4u*)(QNb + (size_t)tok * 512 + A.hl * HD + 16 * ks + 8 * A.h));
    const float m2 = valid ? M2[row] : 3.0e38f;
    A.t = qi * 64 + tok;
    f32x16 S0, S1, O[2]; unsigned Pk0[8], Pk1[8]; float ls = 0.f;
    att_qk_half(Kb, 0, Qf, A, S0); att_qk_half(Kb, 1, Qf, A, S1);
    att_sm_half<SLOW, false>(S0, 0, A, Pk0, ls, m2, 64 * j);
    att_pv_half<true>(Vb, 0, A, Pk0, O);
    att_sm_half<SLOW, false>(S1, 1, A, Pk1, ls, m2, 64 * j);
    att_pv_half<false>(Vb, 1, A, Pk1, O);
    ls += __shfl_xor(ls, 32);
    if (valid) {
        if (A.h == 0) (void)__hip_atomic_fetch_add((LAS int*)Lacc + row, __float2int_rn(ls * 1048576.0f), __ATOMIC_RELAXED, __HIP_MEMORY_SCOPE_WORKGROUP);
        LAS int* op = (LAS int*)Oacc + row * ATT_OACC_LD + 4 * A.h;
#pragma unroll
        for (int mt = 0; mt < 2; ++mt)
#pragma unroll
            for (int q = 0; q < 4; ++q) {
#pragma unroll
                for (int e = 0; e < 4; ++e) (void)__hip_atomic_fetch_add(op + 32 * mt + e + 8 * q, __float2int_rn(O[mt][4 * q + e] * 1048576.0f), __ATOMIC_RELAXED, __HIP_MEMORY_SCOPE_WORKGROUP);
                __builtin_amdgcn_sched_barrier(0); }
    }
}
__device__ __forceinline__ void phase_att(Ctx& C, int l) {
    const float* const gate_b = INP(16);
    const float* const k_norm_g = INP(12);
    bf16* PROJ = WSP(bf16, WS_PROJ); const bf16* QN = WSP(bf16, WS_QN); const bf16* KSN = WSP(bf16, WS_KSN); const bf16* KWN = WSP(bf16, WS_KWN);
    const bf16* VST = WSP(bf16, WS_VST); const bf16* VWT = WSP(bf16, WS_VWT); const bf16* KC = WSP(bf16, WS_KC); const bf16* VCT = WSP(bf16, WS_VC); const float* BT = WSP(float, WS_TAB);
    LAS unsigned char* lds = C.lds;
    LAS float* IMP = (LAS float*)(lds + ATT_IMP); LAS float* BTL = (LAS float*)(lds + ATT_BT); LAS unsigned* SELM = (LAS unsigned*)(lds + ATT_SELM);
    const int tid = C.tid, lane = C.lane, w = C.wave;
    const float c1 = 1.44269504089f;
    AttLane A; A.h = lane >> 5; A.hl = lane & 3; A.tokl = 8 * w + ((lane & 31) >> 2);
    { const int rho = lane & 31; const int key0 = (rho & 19) | ((rho & 4) << 1) | ((rho & 8) >> 1);
      const int fk = (key0 >> 1) & 7, fv = (rho >> 1) & 7;
#pragma unroll
      for (int s = 0; s < 1; ++s) { A.koff0 = (unsigned)(key0 * 128 + ((A.h ^ fk) << 4)); A.voff0 = (unsigned)(rho * 128 + ((A.h ^ fv) << 4)); } }
    A.btl = BTL + A.hl * 128;
    float kn; { float v = fabsf(k_norm_g[l * HD + lane]);
#pragma unroll
      for (int o = 1; o < 64; o <<= 1) v = fmaxf(v, __shfl_xor(v, o)); kn = 8.0f * 1.01f * v; }
    for (int slot = C.bid; slot < 1024; slot += C.G) {
        const int rr = slot >> 8, k32 = (slot & 255) >> 3, bg = slot & 7, b = bg >> 1, g = bg & 1;
        const int qi = (rr == 0) ? 127 - k32 : (rr == 1) ? 64 + k32 : (rr == 2) ? 63 - k32 : k32;
        const int head = g * HPG + A.hl; A.t = qi * 64 + A.tokl;
        bf16* const Pu = PROJ + ((size_t)b * SEQ + 64 * qi) * NPROJ; const bf16* const Qu = QN + ((size_t)b * SEQ + 64 * qi) * 512;
        const int pofs = A.tokl * NPROJ, qofs = A.tokl * 512 + head * HD + 8 * A.h;
        float* const finu = WSP(float, WS_FIN) + (size_t)C.bid * (512 * 32);
        __syncthreads();
        int tidq = tid; asm volatile("" : "+v"(tidq));
        BTL[tid] = BT[(g * HPG + (tid >> 7)) * 128 + (tid & 127)];
        abf16x8 Qf[4]; float qn2 = 0.f;
#pragma unroll
        for (int ks = 0; ks < 4; ++ks) { const v4u wq = *(const v4u*)(Qu + qofs + 16 * ks); Qf[ks] = __builtin_bit_cast(abf16x8, wq);
            qn2 += bflo(wq.x) * bflo(wq.x) + bfhi(wq.x) * bfhi(wq.x) + bflo(wq.y) * bflo(wq.y) + bfhi(wq.y) * bfhi(wq.y) + bflo(wq.z) * bflo(wq.z) + bfhi(wq.z) * bfhi(wq.z) + bflo(wq.w) * bflo(wq.w) + bfhi(wq.w) * bfhi(wq.w); }
        qn2 += __shfl_xor(qn2, 32);
        const float bmax = BT[NH * 128 + head];
        const float b31 = BT[head * 128 + 127];
        const float m2ref = (sqrtf(qn2) * kn + bmax) * c1;
        const float m2far = m2ref - b31 * c1;
        f32x16 O[2];
        AttStage R;
        const int nkb = (4 * qi + 3 + 63) >> 6;
        const bf16* kcg = KC + (size_t)bg * NCMPP * HD; const bf16* vcg = VCT + (size_t)bg * HD * NCMPP;
        float lc = 0.f;
#pragma unroll
        for (int i = 0; i < 16; ++i) { O[0][i] = 0.f; O[1][i] = 0.f; }
        float icar = 0.f;
        int rowq = A.tokl * 4 + A.hl; asm volatile("" : "+v"(rowq));
        LAS float* improw = IMP + rowq * ATT_IMP_LD;
        att_fetch(R, kcg, vcg, NCMPP, tidq);
        for (int kb = 0; kb < nkb; ++kb) {
            att_put_c(R, lds, tidq); __syncthreads();
            if (kb + 1 < nkb) att_fetch(R, kcg + (size_t)(kb + 1) * 64 * HD, vcg + (kb + 1) * 64, NCMPP, tidq);
            if (qi >= 16 * kb + 18) att_block<false, false, 3>(lds + ATT_CK, lds + ATT_CV, Qf, A, O, lc, m2far, 0, 0, improw, 16 * kb + 2 * A.h, icar);
            else att_block<true, false, 3>(lds + ATT_CK, lds + ATT_CV, Qf, A, O, lc, m2ref, 1024 * kb + 31, 16, improw, 16 * kb + 2 * A.h, icar);
            __syncthreads();
        }
        lc += __shfl_xor(lc, 32);
        const float rl = lc > 0.f ? 1.0f / lc : 0.f;
        if (A.h == 0) ((LAS float*)(lds + ATT_RL))[rowq] = rl;
#pragma unroll
        for (int q = 0; q < 4; ++q) { f32x4* fin = (f32x4*)(finu + tid * 32);
            const float gate0 = rl * sigmoid_f(bf2f(Pu[pofs + C_GT + 0 * NH + head]) + gate_b[l * 24 + 0 * NH + head]);
            fin[q] = (f32x4){gate0 * O[0][4 * q], gate0 * O[0][4 * q + 1], gate0 * O[0][4 * q + 2], gate0 * O[0][4 * q + 3]};
            fin[4 + q] = (f32x4){gate0 * O[1][4 * q], gate0 * O[1][4 * q + 1], gate0 * O[1][4 * q + 2], gate0 * O[1][4 * q + 3]}; }
        __builtin_amdgcn_fence(__ATOMIC_RELEASE, "wavefront"); __builtin_amdgcn_wave_barrier(); __builtin_amdgcn_fence(__ATOMIC_ACQUIRE, "wavefront"); asm volatile("" ::: "memory");
        if (qi < 16) { if ((lane & 3) == 0 && lane < 32) { LAS unsigned* sm = SELM + A.tokl * 4; sm[0] = (qi == 31) ? 0xffffffffu : ((2u << qi) - 1u); sm[1] = 0u; sm[2] = 0u; sm[3] = 0u; } }
        else {
            for (int rd = 0; rd < 2; ++rd) {
                const int tk = 8 * w + 4 * rd + (lane >> 4), l16 = lane & 15; const LAS float* ir = IMP + tk * 4 * ATT_IMP_LD;
                const LAS float* rlp = (const LAS float*)(lds + ATT_RL) + tk * 4; const float r4[4] = {rlp[0], rlp[1], rlp[2], rlp[3]};
                unsigned key[8];
#pragma unroll
                for (int k = 0; k < 8; ++k) { const int j = l16 + 16 * k;
                    const unsigned bits = __float_as_uint((r4[0] * ir[j] + r4[1] * ir[ATT_IMP_LD + j]) + (r4[2] * ir[2 * ATT_IMP_LD + j] + r4[3] * ir[3 * ATT_IMP_LD + j]));
                    key[k] = (j < qi) ? ((bits & 0xFFFFFF80u) | (unsigned)(127 - j)) : 0u; }
                for (int it = 0; it < 15; ++it) {
                    unsigned mx = key[0];
#pragma unroll
                    for (int k = 1; k < 8; ++k) mx = key[k] > mx ? key[k] : mx;
                    mx = row16_max(mx);
#pragma unroll
                    for (int k = 0; k < 8; ++k) key[k] = (key[k] == mx) ? 0u : key[k];
                }
                unsigned mw[4];
#pragma unroll
                for (int wd = 0; wd < 4; ++wd) { const int j0 = l16 + 32 * wd, j1 = j0 + 16; unsigned v = 0u;
                    if (j0 < qi && key[2 * wd] == 0u) v |= 1u << l16; if (j1 < qi && key[2 * wd + 1] == 0u) v |= 1u << (l16 + 16); mw[wd] = row16_or(v); }
#pragma unroll
                for (int wd = 0; wd < 4; ++wd) mw[wd] |= ((qi >> 5) == wd) ? (1u << (qi & 31)) : 0u;
                if (l16 == 0) { LAS unsigned* sm = SELM + tk * 4; sm[0] = mw[0]; sm[1] = mw[1]; sm[2] = mw[2]; sm[3] = mw[3]; }
            }
        }
        {
            LAS float* Oacc = (LAS float*)(lds + ATT_OACC); LAS float* Lacc = (LAS float*)(lds + ATT_L); LAS unsigned char* LIST = lds + ATT_LIST; LAS int* CNTL = (LAS int*)(lds + ATT_CNT);
            LAS float* M2F = (LAS float*)(lds + ATT_M2F); LAS float* M2R = (LAS float*)(lds + ATT_M2R);
            const bf16* kg = KSN + (size_t)bg * SEQ * HD; const bf16* vg = VST + (size_t)bg * HD * SEQ;
            const bf16* QNb = QN + ((size_t)b * SEQ + 64 * qi) * 512 + g * HPG * HD;
            const int nfast = qi >= 2 ? qi - 2 : 0, nb = qi + 1, nch = (nb + 1) >> 1;
#define SLC_SEQ(i) ((i) >= nb ? qi : ((i) < nfast ? (i) : qi - ((i) - nfast)))
            __syncthreads();
            { const unsigned mw0 = SELM[lane * 4 + 0], mw1 = SELM[lane * 4 + 1], mw2 = SELM[lane * 4 + 2], mw3 = SELM[lane * 4 + 3];
              for (int j = w; j <= qi; j += 8) {
                  const int wd = j >> 5; const unsigned mwj = wd == 0 ? mw0 : wd == 1 ? mw1 : wd == 2 ? mw2 : mw3;
                  const bool bit = (mwj >> (j & 31)) & 1u; const unsigned long long mk = __ballot(bit);
                  const unsigned rank = __builtin_amdgcn_mbcnt_hi((unsigned)(mk >> 32), __builtin_amdgcn_mbcnt_lo((unsigned)mk, 0u));
                  if (bit) LIST[j * 64 + rank] = (unsigned char)lane;
                  if (lane == 0) CNTL[j] = __popcll(mk); } }
            if (A.h == 0) { M2F[rowq] = m2far; M2R[rowq] = m2ref; }
            for (int i = tid; i < 256 * ATT_OACC_LD + 256; i += NTHR) Oacc[i] = 0.f;
            asm volatile("s_waitcnt vmcnt(0)" ::: "memory"); __syncthreads();
            const int nch4 = (nb + 3) >> 2;
            for (int c = 0; c < nch4; ++c) {
#pragma unroll
                for (int q = 0; q < 4; ++q) { const int jq = SLC_SEQ(4 * c + q);
                    att_dma(kg + (size_t)jq * 64 * HD, HD, lds + ATT_KB + q * 8192 + w * 1024, tidq); att_dma(vg + jq * 64, SEQ, lds + ATT_VB + q * 8192 + w * 1024, tidq); }
                int jb[4], cb[4], nvb[4]; int tot = 0;
#pragma unroll
                for (int q = 0; q < 4; ++q) { jb[q] = SLC_SEQ(4 * c + q); cb[q] = (4 * c + q < nb) ? CNTL[jb[q]] : 0; nvb[q] = (cb[q] + 7) >> 3; tot += nvb[q]; }
                asm volatile("s_waitcnt vmcnt(0)" ::: "memory"); __syncthreads();
                for (int v = w; v < tot; v += 8) {
                    int q = 0, vv = v;
                    if (vv >= nvb[0]) { vv -= nvb[0]; q = 1; if (vv >= nvb[1]) { vv -= nvb[1]; q = 2; if (vv >= nvb[2]) { vv -= nvb[2]; q = 3; } } }
                    const int j = q == 0 ? jb[0] : q == 1 ? jb[1] : q == 2 ? jb[2] : jb[3]; const int cn = q == 0 ? cb[0] : q == 1 ? cb[1] : q == 2 ? cb[2] : cb[3];
                    const bool slow = (4 * c + q) >= nfast;
                    const LAS unsigned char* Kb = lds + ATT_KB + q * 8192; const LAS unsigned char* Vb = lds + ATT_VB + q * 8192;
                    if (slow) att_visit<true>(Kb, Vb, QNb, j, qi, vv, cn, LIST + j * 64, M2R, Oacc, Lacc, A, lane);
                    else att_visit<false>(Kb, Vb, QNb, j, qi, vv, cn, LIST + j * 64, M2F, Oacc, Lacc, A, lane);
                }
                __syncthreads();
            }
#undef SLC_SEQ
        }
        {
#pragma unroll
            for (int i = 0; i < 16; ++i) { O[0][i] = 0.f; O[1][i] = 0.f; }
            float lw = 0.f;
            const bf16* kg = KWN + (size_t)bg * SEQ * HD; const bf16* vg = VWT + (size_t)bg * HD * SEQ;
#pragma unroll
            for (int ks = 0; ks < 4; ++ks) Qf[ks] = __builtin_bit_cast(abf16x8, *(const v4u*)(Qu + qofs + 16 * ks));
            const int f0 = qi >= 7 ? qi - 7 : 0, nfast = qi >= 3 ? qi - 3 - f0 + 1 : 0, nslow = 1 + (qi >= 1) + (qi >= 2) + (qi >= 8), nb = nfast + nslow;
#define WIN_SEQ(i) ((i) >= nb ? qi : ((i) < nfast ? f0 + (i) : (((i) - nfast) < 3 ? qi - ((i) - nfast) : qi - 8)))
#ifndef ATT_REP_WIN
#define ATT_REP_WIN 1
#endif
#pragma unroll
            for (int rep = 0; rep < ATT_REP_WIN; ++rep) {
            f32x16 S0, S1;
            att_pipe_start(lds, kg, vg, WIN_SEQ(0), WIN_SEQ(1), WIN_SEQ(2), w, Qf, A, S0, tidq);
            for (int i = 0; i < nfast; ++i) {
                att_pipe_iter<false, true>(lds, kg, vg, i, f0 + i, WIN_SEQ(i + 3), WIN_SEQ(i + 2), true, w, Qf, A, S0, S1, O, lw, m2far, tidq);
            }
            for (int i = nfast; i < nb; ++i) {
                att_pipe_iter<true, true>(lds, kg, vg, i, WIN_SEQ(i), WIN_SEQ(i + 3), WIN_SEQ(i + 2), true, w, Qf, A, S0, S1, O, lw, m2ref, tidq);
            }
            asm volatile("s_waitcnt vmcnt(0)" ::: "memory"); __syncthreads();
            }
#undef WIN_SEQ
            lw += __shfl_xor(lw, 32);
            const float gate1 = sigmoid_f(bf2f(Pu[pofs + C_GT + 1 * NH + head]) + gate_b[l * 24 + 1 * NH + head]);
            const float gate2 = sigmoid_f(bf2f(Pu[pofs + C_GT + 2 * NH + head]) + gate_b[l * 24 + 2 * NH + head]);
            const f32x4* fin = (const f32x4*)(finu + tid * 32);
            const float sc = lw > 0.f ? gate2 / lw : 0.f;
#pragma unroll
            for (int i = 0; i < 16; ++i) { O[0][i] = sc * O[0][i]; O[1][i] = sc * O[1][i]; }
#pragma unroll
            for (int q = 0; q < 4; ++q) {
                const f32x4 f0 = fin[q], f1 = fin[4 + q];
#pragma unroll
                for (int e = 0; e < 4; ++e) { O[0][4 * q + e] += f0[e]; O[1][4 * q + e] += f1[e]; }
                asm volatile("" ::: "memory"); }
            { const int row = A.tokl * 4 + A.hl; const int lsel = ((const LAS int*)(lds + ATT_L))[row]; const float s1 = lsel > 0 ? gate1 / (float)lsel : 0.f;
              const LAS int* oa = (const LAS int*)(lds + ATT_OACC) + row * ATT_OACC_LD + 4 * A.h;
#pragma unroll
              for (int mt = 0; mt < 2; ++mt)
#pragma unroll
                  for (int i = 0; i < 16; ++i) O[mt][i] += s1 * (float)oa[32 * mt + (i & 3) + 8 * (i >> 2)]; }
            bf16* op = Pu + (pofs + C_Q + head * HD + 4 * A.h);
#pragma unroll
            for (int mt = 0; mt < 2; ++mt)
#pragma unroll
                for (int q4 = 0; q4 < 4; ++q4) { v2u o; o.x = pg8::cvt_pk_bf16(O[mt][4 * q4], O[mt][4 * q4 + 1]); o.y = pg8::cvt_pk_bf16(O[mt][4 * q4 + 2], O[mt][4 * q4 + 3]); *(v2u*)(op + 32 * mt + 8 * q4) = o; }
            { float ss = 0.f;
#pragma unroll
              for (int i = 0; i < 16; ++i) ss += O[0][i] * O[0][i] + O[1][i] * O[1][i];
              ss += __shfl_xor(ss, 32);
              if (A.h == 0) WSP(float, WS_SSQA)[((size_t)b * SEQ + A.t) * 8 + head] = ss; }
        }
    }
    __syncthreads();
}
__device__ __forceinline__ void phase_norm2_router(Ctx& C, int l, int li  ) {
    const float* const norm2_g = INP(19);
    const float* const router_w = INP(23);
    const bf16* XB = WSP(bf16, WS_HN);
    int* TOPE = WSP(int, WS_TOPE); float* TOPW = WSP(float, WS_TOPW); int* POS = WSP(int, WS_POS);
    unsigned* CNT = WSP(unsigned, WS_CTL) + CW_MOECNT;
    LAS unsigned* lcnt = (LAS unsigned*)C.lds;
    const int lane = C.lane;
    float rwl[16][8];
#pragma unroll
    for (int j = 0; j < 2; ++j)
#pragma unroll
        for (int i = 0; i < 8; ++i) { const int ch = 512 * j + 8 * lane + i; const float gch = norm2_g[l * D + ch]; const float* wr = router_w + ((size_t)li * D + ch) * NE;
#pragma unroll
            for (int e = 0; e < 8; ++e) rwl[8 * j + i][e] = gch * wr[e]; }
    for (int blk = C.bid; blk < M / 128; blk += C.G) {
        __syncthreads();
        if (C.tid < 32) lcnt[C.tid] = 0u;
        __syncthreads();
        v4u nx0 = *(const v4u*)(XB + (size_t)(blk * 128 + C.wave * 16) * D + 8 * lane), nx1 = *(const v4u*)(XB + (size_t)(blk * 128 + C.wave * 16) * D + 512 + 8 * lane);
        for (int rr = 0; rr < 16; ++rr) {
            const int m = blk * 128 + C.wave * 16 + rr;
            const v4u w0v = nx0, w1v = nx1;
            if (rr + 1 < 16) { nx0 = *(const v4u*)(XB + (size_t)(m + 1) * D + 8 * lane); nx1 = *(const v4u*)(XB + (size_t)(m + 1) * D + 512 + 8 * lane); }
            const float xv[16] = {bflo(w0v.x), bfhi(w0v.x), bflo(w0v.y), bfhi(w0v.y), bflo(w0v.z), bfhi(w0v.z), bflo(w0v.w), bfhi(w0v.w),
                                  bflo(w1v.x), bfhi(w1v.x), bflo(w1v.y), bfhi(w1v.y), bflo(w1v.z), bfhi(w1v.z), bflo(w1v.w), bfhi(w1v.w)};
            float s = 0.f, lg[8];
#pragma unroll
            for (int e = 0; e < 8; ++e) lg[e] = 0.f;
#pragma unroll
            for (int i = 0; i < 16; ++i) { s += xv[i] * xv[i];
#pragma unroll
                for (int e = 0; e < 8; ++e) lg[e] += xv[i] * rwl[i][e]; }
            const float rstd = 1.0f / sqrtf(wave_sum(s) * (1.f / D) + RMS_EPS);
#pragma unroll
            for (int e = 0; e < 8; ++e) lg[e] = wave_sum(lg[e]) * rstd;
            int e0 = 0; float v0 = lg[0];
#pragma unroll
            for (int e = 1; e < 8; ++e) if (lg[e] > v0) { v0 = lg[e]; e0 = e; }
            int e1 = -1; float v1 = -3.0e38f;
#pragma unroll
            for (int e = 0; e < 8; ++e) if (e != e0 && lg[e] > v1) { v1 = lg[e]; e1 = e; }
            const float w0 = 1.0f / (1.0f + __expf(v1 - v0)), w1 = 1.0f - w0;
            if (lane == 0) {
                const unsigned p0 = atomicAdd((unsigned*)&lcnt[e0], 1u), p1 = atomicAdd((unsigned*)&lcnt[8 + e1], 1u);
                TOPE[m] = e0; TOPE[M + m] = e1; TOPW[m] = w0; TOPW[M + m] = w1; POS[m] = (int)p0; POS[M + m] = (int)p1; WSP(float, WS_RSTD)[m] = rstd;
            }
        }
        __syncthreads();
        if (C.tid < 16) lcnt[16 + C.tid] = atomicAdd(&CNT[C.tid], lcnt[C.tid]);
        __syncthreads();
        if (C.tid < 128) { const int m = blk * 128 + C.tid; POS[m] += (int)lcnt[16 + TOPE[m]]; POS[M + m] += (int)lcnt[24 + TOPE[M + m]]; }
    }
    __syncthreads();
}
__device__ __forceinline__ void phase_route2(Ctx& C) {
    const unsigned* CNT = WSP(unsigned, WS_CTL) + CW_MOECNT; int* META = WSP(int, WS_META);
    const int* TOPE = WSP(int, WS_TOPE); const float* TOPW = WSP(float, WS_TOPW); const int* POS = WSP(int, WS_POS);
    int* RT = WSP(int, WS_ROWTOK); float* RW = WSP(float, WS_ROWW);
    LAS int* off = (LAS int*)C.lds;
    __syncthreads();
    if (C.tid < 2) { int o = 0; for (int e = 0; e < NE; ++e) { off[C.tid * 9 + e] = o; o += (int)((CNT[C.tid * 8 + e] + 255u) & ~255u); } off[C.tid * 9 + 8] = o; }
    __syncthreads();
    if (C.bid == 0) {
        if (C.tid < 2) { for (int e = 0; e < 9; ++e) META[C.tid * 512 + e] = (e < 8) ? off[C.tid * 9 + e] : off[C.tid * 9 + 8] / 256; }
        if (C.tid < 2 * MOE_PANELS) { const int r = C.tid / MOE_PANELS, p = C.tid % MOE_PANELS; int e = 0; for (int k = 1; k < NE; ++k) if (p * 256 >= off[r * 9 + k]) e = k; META[r * 512 + 16 + p] = e; }
    }
    const int gt = C.bid * NTHR + C.tid, NGT = C.G * NTHR;
    for (int i = gt; i < 2 * M; i += NGT) { const int r = i / M; const int m = i % M; const int row = off[r * 9 + TOPE[i]] + POS[i]; RT[r * MOE_ROWS + row] = m; RW[r * MOE_ROWS + row] = TOPW[i]; WSP(float, WS_ROWRS)[r * MOE_ROWS + row] = WSP(float, WS_RSTD)[m]; }
    __syncthreads();
}
__device__ __forceinline__ void moe_scatter(Ctx& C, int r) {
    const unsigned* CNT = WSP(unsigned, WS_CTL) + CW_MOECNT; const int* TOPE = WSP(int, WS_TOPE) + r * M; const int* POS = WSP(int, WS_POS) + r * M;
    const bf16* XBs = WSP(bf16, WS_HN); unsigned char* XBUF = WSP(unsigned char, WS_XBUF);
    const int gw = C.bid * NWAVES + C.wave, NGW = C.G * NWAVES, lane = C.lane;
    int off[9]; { int o = 0;
#pragma unroll
        for (int e = 0; e < NE; ++e) { off[e] = o; o += (int)((CNT[r * 8 + e] + 255u) & ~255u); } off[8] = o; }
    for (int m0 = gw * 4; m0 < M; m0 += NGW * 4) {
        v4u a[4], b[4]; int row[4];
#pragma unroll
        for (int q = 0; q < 4; ++q) { const int m = m0 + q; const int e = TOPE[m]; int o = off[0];
#pragma unroll
            for (int k = 1; k < NE; ++k) o = (e == k) ? off[k] : o;
            row[q] = o + POS[m]; const v4u* s = (const v4u*)(XBs + (size_t)m * D); a[q] = s[2 * lane]; b[q] = s[2 * lane + 1]; }
#pragma unroll
        for (int q = 0; q < 4; ++q) { v4u o;
            o.x = pk4_fp8(bflo(a[q].x), bfhi(a[q].x), bflo(a[q].y), bfhi(a[q].y)); o.y = pk4_fp8(bflo(a[q].z), bfhi(a[q].z), bflo(a[q].w), bfhi(a[q].w));
            o.z = pk4_fp8(bflo(b[q].x), bfhi(b[q].x), bflo(b[q].y), bfhi(b[q].y)); o.w = pk4_fp8(bflo(b[q].z), bfhi(b[q].z), bflo(b[q].w), bfhi(b[q].w));
            ((v4u*)(XBUF + (size_t)row[q] * D))[lane] = o; }
    }
#pragma unroll
    for (int e = 0; e < NE; ++e) { const int p0 = off[e] + (int)CNT[r * 8 + e], p1 = off[e + 1];
        for (int row = p0 + gw; row < p1; row += NGW) ((v4u*)(XBUF + (size_t)row * D))[lane] = (v4u){0u, 0u, 0u, 0u}; }
}


#ifndef DUP_MASK
#define DUP_MASK 0
#endif
#define DUPRUN(bit, ...) do { __VA_ARGS__; if constexpr ((DUP_MASK >> (bit)) & 1) { xcd_barrier(bar); __VA_ARGS__; } } while (0)
#define IN(k) (lo <= (k) && (k) < hi)
#define SEAM(k) do { if (IN(k) && IN((k) + 1)) xcd_barrier(bar); } while (0)
template <int R>
__device__ __forceinline__ void moe_rank(Ctx& C, const XcdBarrier& bar, int lo, int hi, PG8_LAS unsigned char* glds) {
    constexpr int r = R; constexpr int pr = 15 + 2 * R;
    const int* META = WSP(int, WS_META) + r * 512;
    if (IN(pr)) {
        const int npan = META[8];
        pg8::Gemm g{WSP(pg8::bf16_t, WS_XBUF), WSP(pg8::bf16_t, WS_MGU), MOE_ROWS, NGU, D / 2}; pg8::StaticOrder S; S.init(npan, NGU / 256, C.G, C.bid); S.pexp = META + 16; S.estride = (size_t)NGU * D;
        pg8::EpiSwiGLU<2> E{WSP(pg8::bf16_t, WS_HID), FF, WSP(float, WS_ROWRS) + r * MOE_ROWS, nullptr};
        DUPRUN(10, pg8::gemm_phase<pg8::EpiSwiGLU<2>, pg8::StaticOrder, true, true, true>(glds, g, S, E));
    } SEAM(pr);
    if (IN(pr + 1)) {
        const int npan = META[8];
        pg8::Gemm g{WSP(pg8::bf16_t, WS_HID), WSP(pg8::bf16_t, WS_MD), MOE_ROWS, D, FF / 2}; pg8::StaticOrder S; S.init(npan, D / 256, C.G, C.bid); S.pexp = META + 16; S.estride = (size_t)D * FF;
        pg8::EpiMoeDown<R == 0> E{WSP(int, WS_ROWTOK) + r * MOE_ROWS, WSP(float, WS_ROWW) + r * MOE_ROWS, C.out, D, WSP(pg8::bf16_t, WS_HN)};
        pg8::gemm_phase<pg8::EpiMoeDown<R == 0>, pg8::StaticOrder, true, true, true, 0x7c7c7c7c>(glds, g, S, E);
        if constexpr (R == 0) moe_scatter(C, 1);
    } SEAM(pr + 1);
}
template <int L>
__device__ __forceinline__ void layer_phases(Ctx& C, const XcdBarrier& bar, int lo, int hi, PG8_LAS unsigned char* glds) {
    constexpr int l = L; constexpr int pb = (L == 0) ? 1 : 8;
    if (IN(pb + 0)) {
        pg8::StaticOrder S; S.init(M / 256, NPROJ / 256, C.G, C.bid);
        pg8::EpiBf16<true> E{WSP(pg8::bf16_t, WS_PROJ), NPROJ, WSP(float, WS_SSQ)};
        if constexpr (INPROJ_FP8(L)) { pg8::Gemm g{WSP(pg8::bf16_t, WS_QN), WSP(pg8::bf16_t, WS_WIN) + (size_t)l * NPROJ * D, M, NPROJ, D / 2};
            pg8::gemm_phase<pg8::EpiBf16<true>, pg8::StaticOrder, true, true, true>(glds, g, S, E); }
        else { pg8::Gemm g{WSP(pg8::bf16_t, WS_HN), WSP(pg8::bf16_t, WS_WIN) + (size_t)l * NPROJ * D, M, NPROJ, D};
        DUPRUN(1, pg8::gemm_phase<pg8::EpiBf16<true>, pg8::StaticOrder, true, true>(glds, g, S, E)); }
    } SEAM(pb + 0);
    if (IN(pb + 1)) { DUPRUN(2, prep_qknorm(C, l)); DUPRUN(3, prep_compress(C, l)); DUPRUN(4, lru_chunks<1>(C, l)); } SEAM(pb + 1);
    if (IN(pb + 2)) { lru_carry(C); DUPRUN(5, phase_att(C, l)); } SEAM(pb + 2);
    if (IN(pb + 3)) { lru_chunks<2>(C, l); } SEAM(pb + 3);
    if (IN(pb + 4)) {
        pg8::Gemm g{WSP(pg8::bf16_t, WS_PROJ) + C_LG, WSP(pg8::bf16_t, WS_WOUT) + (size_t)l * D * D, M, D, D, NPROJ, 0}; pg8::StaticOrder S; S.init(M / 256, D / 256, C.G, C.bid);
        PG8_LAS pg8::f32x2t* T = (PG8_LAS pg8::f32x2t*)(glds + 131072 + 1024);
        { pg8::Unit uu; for (int i = 0; S.next(i, uu) && i < 4; ++i) if (C.tid < 256) { const int row = uu.pm * 256 + C.tid;
              const float rl = pg8::rstd512(WSP(float, WS_SSQL), row), ra = pg8::rstd512(WSP(float, WS_SSQA), row); T[i * 256 + C.tid] = (pg8::f32x2t){rl / ra, ra}; }
          __syncthreads(); }
        const pg8::MidRatio Mi{T};
        pg8::EpiResBf16Norm<true> E{WSP(pg8::bf16_t, WS_HN), WSP(pg8::bf16_t, WS_HN), D, WSP(float, WS_SSQ), (l == 0) ? WSP(unsigned char, WS_QN) : nullptr, T};
        pg8::gemm_phase<pg8::EpiResBf16Norm<true>, pg8::StaticOrder, true, true, false, 0x7f7f7f7f, pg8::MidRatio>(glds, g, S, E, Mi);
    } SEAM(pb + 4);
    if constexpr (L == 0) {
        if (IN(6)) {
            pg8::Gemm g{WSP(pg8::bf16_t, WS_QN), WSP(pg8::bf16_t, WS_FGU), M, NGU, D / 2}; pg8::StaticOrder S; S.init(M / 256, NGU / 256, C.G, C.bid);
            pg8::EpiSwiGLU<1, true> E{WSP(pg8::bf16_t, WS_HID), FF, WSP(float, WS_SSQ), nullptr};
            DUPRUN(9, pg8::gemm_phase<pg8::EpiSwiGLU<1, true>, pg8::StaticOrder, true, true, true>(glds, g, S, E));
        } SEAM(6);
        if (IN(7)) {
            pg8::Gemm g{WSP(pg8::bf16_t, WS_HID), WSP(pg8::bf16_t, WS_FD), M, D, FF / 2}; pg8::StaticOrder S; S.init(M / 256, D / 256, C.G, C.bid);
            pg8::EpiResBf16Norm<false> E{WSP(pg8::bf16_t, WS_HN), WSP(pg8::bf16_t, WS_HN), D, WSP(float, WS_SSQ), INPROJ_FP8(1) ? WSP(unsigned char, WS_QN) : nullptr};
            if constexpr ((DUP_MASK >> 13) & 1) { pg8::EpiProbeSum EP{WSP(float, WS_MIX)}; pg8::gemm_phase<pg8::EpiProbeSum, pg8::StaticOrder, true, true>(glds, g, S, EP); xcd_barrier(bar); }
            pg8::gemm_phase<pg8::EpiResBf16Norm<false>, pg8::StaticOrder, true, true, true, 0x7c7c7c7c>(glds, g, S, E);
        } SEAM(7);
    } else {
        if (IN(13)) { phase_norm2_router(C, l, 0); } SEAM(13);
        if (IN(14)) { phase_route2(C); moe_scatter(C, 0); } SEAM(14);
        moe_rank<0>(C, bar, lo, hi, glds); moe_rank<1>(C, bar, lo, hi, glds);
    }
}
#undef IN
#undef SEAM
__global__ void __launch_bounds__(NTHR, 2) fwd(Args args) {
    extern __shared__ __attribute__((aligned(16))) unsigned char lds[];
    Ctx C;
    C.lds = (LAS unsigned char*)lds; C.ws = args.ws; C.out = args.out;
    C.tid = threadIdx.x; C.lane = C.tid & 63; C.wave = __builtin_amdgcn_readfirstlane(C.tid >> 6); C.G = gridDim.x; C.bid = blockIdx.x;
    volatile LAS unsigned* MISC = (volatile LAS unsigned*)(C.lds + MISC_OFF);
    if (C.tid < 64) ((LAS unsigned*)(C.lds + MISC_OFF))[C.tid] = 0u;
    __syncthreads();
    XcdBarrier bar; bar.bar = WSP(unsigned, WS_CTL) + CW_BAR; bar.x = 0; bar.st = nullptr;
    if (args.use_bar) bar = xcd_barrier_post(WSP(unsigned, WS_CTL) + CW_BAR, MISC + 8);
    const int lo = args.ph_lo, hi = args.ph_hi;
#define IN(k) (lo <= (k) && (k) < hi)
#define SEAM(k) do { if (IN(k) && IN((k) + 1)) xcd_barrier(bar); } while (0)
    PG8_LAS unsigned char* glds = (PG8_LAS unsigned char*)lds;

        if (IN(0)) { DUPRUN(0, phase_prologue(C)); } SEAM(0);
    layer_phases<0>(C, bar, lo, hi, glds);
    layer_phases<1>(C, bar, lo, hi, glds);
#undef IN
#undef SEAM
}

constexpr int N_PHASES = 19;
extern "C" void kernel_launch(void* const* d_in, const int* in_sizes, int n_in, void* d_out, int out_size, void* d_ws, size_t ws_size, hipStream_t stream) {
    static int grid = 0;
    if (grid == 0) {
        if (n_in != 27 || in_sizes[0] != M * D || out_size != M * D || ws_size < WS_END) { fprintf(stderr, "kernel_launch: unexpected shapes (n_in %d, in0 %d, out %d, ws %zu); nothing launched\n", n_in, n_in > 0 ? in_sizes[0] : -1, out_size, ws_size); grid = -1; return; }
        int dev = 0, cus = 0;
        if (hipGetDevice(&dev) != hipSuccess || hipDeviceGetAttribute(&cus, hipDeviceAttributeMultiprocessorCount, dev) != hipSuccess) { grid = -1; return; }
        if (hipFuncSetAttribute((const void*)fwd, hipFuncAttributeMaxDynamicSharedMemorySize, LDS_BYTES) != hipSuccess) { fprintf(stderr, "kernel_launch: hipFuncSetAttribute failed\n"); grid = -1; return; }
        int per_cu = 0;
        if (hipOccupancyMaxActiveBlocksPerMultiprocessor(&per_cu, (const void*)fwd, NTHR, LDS_BYTES) != hipSuccess || per_cu < 1) fprintf(stderr, "kernel_launch: occupancy query says %d\n", per_cu);
        (void)hipGetLastError();
        grid = cus;
    }
    if (grid < 0) return;
    if (hipMemsetAsync((char*)d_ws + WS_CTL, 0, CTL_ZERO_BYTES, stream) != hipSuccess) return;
    Args a{};
    for (int i = 0; i < 27; ++i) a.in[i] = (const float*)d_in[i];
    a.out = (float*)d_out; a.ws = (unsigned char*)d_ws; a.pad = 0;
#ifndef MK_SPLIT
#define MK_SPLIT 0
#endif
#if MK_SPLIT
    for (int p = 0; p < N_PHASES; ++p) { a.ph_lo = p; a.ph_hi = p + 1; a.use_bar = 0; hipLaunchKernelGGL(fwd, dim3(grid), dim3(NTHR), LDS_BYTES, stream, a); }
#else
    a.ph_lo = 0; a.ph_hi = N_PHASES; a.use_bar = 1; hipLaunchKernelGGL(fwd, dim3(grid), dim3(NTHR), LDS_BYTES, stream, a);
#endif
}
```

```cpp
#include <hip/hip_runtime.h>
#include <cstdio>
#include <cstdint>

namespace pg8 {
#define PG8_LAS __attribute__((address_space(3)))
typedef unsigned short bf16_t;
typedef short bf16x8 __attribute__((ext_vector_type(8)));
typedef float f32x4 __attribute__((ext_vector_type(4)));
typedef unsigned u32x4 __attribute__((ext_vector_type(4)));
constexpr int BM = 256, BK = 64, HALF = 128, HTB = HALF * BK * 2  , STAGE_BYTES = 8 * HTB, NXCD = 8, WGM = 8;

__host__ __device__ __forceinline__ int lds_byte(int r, int c) { const int st = (r >> 4) * 2 + (c >> 5), rr = r & 15, cc = c & 31, ob = rr * 64 + cc * 2; return st * 1024 + (ob ^ (((ob >> 9) & 1) << 5)); }
__host__ __device__ __forceinline__ void stage_rc(int b, int& R, int& C) { const int st = b / 1024, sb = b % 1024, swz = sb ^ (((sb >> 9) & 1) << 5); R = (st >> 1) * 16 + swz / 64; C = (st & 1) * 32 + (swz % 64) / 2; }
__host__ __device__ __forceinline__ int perm32(int rho) { const int n = rho >> 4, i = rho & 15; return 8 * (i >> 2) + 4 * n + (i & 3); }

struct Unit { int pm, pn; int idx = 0; };
struct Gemm { const bf16_t* A; const bf16_t* Bt; int M, N, K; int lda = 0, ldb = 0; };

struct StaticOrder {
    int nM, nN, nwg, G, c;
    const int* pexp; size_t estride;
    __host__ __device__ void init(int nM_, int nN_, int G_, int c_) { nM = nM_; nN = nN_; nwg = nM * nN; G = G_; c = c_; pexp = nullptr; estride = 0; }
    __host__ __device__ bool next(int i, Unit& u) const {
        const long L = (long)i * G + c; if (L >= nwg) return false;
        int wgid = (int)L; { const int q = nwg / NXCD, r = nwg % NXCD, xcd = wgid % NXCD, off = wgid / NXCD; wgid = (xcd < r ? xcd * (q + 1) : r * (q + 1) + (xcd - r) * q) + off; }
        const int nig = WGM * nN, gid = wgid / nig, fm = gid * WGM, gsz = (nM - fm) < WGM ? (nM - fm) : WGM;
        u.pm = fm + ((wgid % nig) % gsz); u.pn = (wgid % nig) / gsz; return true;
    }
    __device__ __forceinline__ size_t b_off(const Unit& u) const { return pexp ? (size_t)pexp[u.pm] * estride : (size_t)0; }
    __device__ __forceinline__ void a_ready(const Unit&) const {}
    __device__ __forceinline__ void done(const Unit&) const {}
};

__device__ __forceinline__ unsigned cvt_pk_bf16(float lo, float hi) { unsigned r; asm volatile("v_cvt_pk_bf16_f32 %0, %1, %2" : "=v"(r) : "v"(lo), "v"(hi)); return r; }

struct NoMid { static constexpr bool ON = false; };
__device__ __forceinline__ float rstd512(const float* S8, int row) { const f32x4 a = *(const f32x4*)(S8 + (size_t)row * 8), b = *(const f32x4*)(S8 + (size_t)row * 8 + 4);
    return 1.0f / sqrtf((((a[0] + a[1]) + (a[2] + a[3])) + ((b[0] + b[1]) + (b[2] + b[3]))) * (1.0f / 512.0f) + 1e-6f); }
typedef float f32x2t __attribute__((ext_vector_type(2)));
struct MidRatio { static constexpr bool ON = true; const PG8_LAS f32x2t* T;
    __device__ __forceinline__ void load(const Unit& u, int wr, int fr, int fq, float (&f)[2][4]) const {
#pragma unroll
        for (int ai = 0; ai < 2; ++ai)
#pragma unroll
            for (int m = 0; m < 4; ++m) f[ai][m] = T[u.idx * 256 + wr * 64 + fr + ai * HALF + m * 16].x;
    }
    __device__ __forceinline__ void load_final(const Unit& u, int wr, int fr, int fq, float (&f)[2][4]) const {
#pragma unroll
        for (int ai = 0; ai < 2; ++ai)
#pragma unroll
            for (int m = 0; m < 4; ++m) f[ai][m] = T[u.idx * 256 + wr * 64 + fr + ai * HALF + m * 16].y;
    }
};
__device__ __forceinline__ f32x4 row_ssq_load(const float* SSQ, int row, int fq) { return *(const f32x4*)(SSQ + (size_t)row * 16 + 4 * fq); }
__device__ __forceinline__ float row_rstd_fin(const f32x4 p) {
    float s = (p[0] + p[1]) + (p[2] + p[3]); s += __shfl_xor(s, 16); s += __shfl_xor(s, 32);
    return 1.0f / sqrtf(s * (1.0f / 1024.0f) + 1e-6f);
}
template <bool SCALE> struct EpiBf16 {
    static constexpr bool PERM = true, AFTER_DRAIN = false;
    bf16_t* O; int ldc; const float* SSQ;
    __device__ __forceinline__ void operator()(const f32x4 (&acc)[2][2][4][2], const Unit& u, int wr, int wc, int fr, int fq) const {
        const int row0 = u.pm * BM + wr * 64 + fr; const int col0 = u.pn * BM + wc * 32 + 8 * fq;
        f32x4 sq[2][4];
        if (SCALE) {
#pragma unroll
            for (int ai = 0; ai < 2; ++ai)
#pragma unroll
                for (int m = 0; m < 4; ++m) sq[ai][m] = row_ssq_load(SSQ, row0 + ai * HALF + m * 16, fq);
        }
#pragma unroll
        for (int ai = 0; ai < 2; ++ai)
#pragma unroll
            for (int m = 0; m < 4; ++m) { const int row = row0 + ai * HALF + m * 16; bf16_t* rowp = O + (size_t)row * ldc + col0;
                const float rs = SCALE ? row_rstd_fin(sq[ai][m]) : 1.0f;
#pragma unroll
                for (int bj = 0; bj < 2; ++bj) { const f32x4 v0 = acc[ai][bj][m][0] * rs, v1 = acc[ai][bj][m][1] * rs;
                    u32x4 w; w.x = cvt_pk_bf16(v0[0], v0[1]); w.y = cvt_pk_bf16(v0[2], v0[3]); w.z = cvt_pk_bf16(v1[0], v1[1]); w.w = cvt_pk_bf16(v1[2], v1[3]);
                    *(u32x4*)(rowp + bj * HALF) = w; } }
    }
};
__device__ __forceinline__ float silu_f(float x) { return x * __builtin_amdgcn_rcpf(1.0f + __builtin_amdgcn_exp2f(-1.44269504089f * x)); }
template <int SCALE, bool OUT8 = (SCALE == 2)> struct EpiSwiGLU {
    static constexpr bool PERM = true, AFTER_DRAIN = false;
    bf16_t* H; int ldh; const float* SSQ; const int* rowtok;
    __device__ __forceinline__ void operator()(const f32x4 (&acc)[2][2][4][2], const Unit& u, int wr, int wc, int fr, int fq) const {
        const int row0 = u.pm * BM + wr * 64 + fr; const int col0 = u.pn * HALF + wc * 32 + 8 * fq;
        f32x4 sq[2][4]; float rsv[2][4];
#pragma unroll
        for (int ai = 0; ai < 2; ++ai)
#pragma unroll
            for (int m = 0; m < 4; ++m) { if (SCALE == 2) rsv[ai][m] = SSQ[row0 + ai * HALF + m * 16]; else sq[ai][m] = row_ssq_load(SSQ, row0 + ai * HALF + m * 16, fq); }
#pragma unroll
        for (int ai = 0; ai < 2; ++ai)
#pragma unroll
            for (int m = 0; m < 4; ++m) { const int row = row0 + ai * HALF + m * 16; bf16_t* rowp = H + (size_t)row * ldh + col0;
                const float rs = (SCALE == 2) ? rsv[ai][m] : row_rstd_fin(sq[ai][m]);
                const f32x4 g0 = acc[ai][0][m][0] * rs, g1 = acc[ai][0][m][1] * rs, u0 = acc[ai][1][m][0] * rs, u1 = acc[ai][1][m][1] * rs;
                if constexpr (OUT8) {
                    const float h0 = 8.f * silu_f(g0[0]) * u0[0], h1 = 8.f * silu_f(g0[1]) * u0[1], h2 = 8.f * silu_f(g0[2]) * u0[2], h3 = 8.f * silu_f(g0[3]) * u0[3];
                    const float h4 = 8.f * silu_f(g1[0]) * u1[0], h5 = 8.f * silu_f(g1[1]) * u1[1], h6 = 8.f * silu_f(g1[2]) * u1[2], h7 = 8.f * silu_f(g1[3]) * u1[3];
                    int q0 = 0, q1 = 0; q0 = __builtin_amdgcn_cvt_pk_fp8_f32(h0, h1, q0, false); q0 = __builtin_amdgcn_cvt_pk_fp8_f32(h2, h3, q0, true); q1 = __builtin_amdgcn_cvt_pk_fp8_f32(h4, h5, q1, false); q1 = __builtin_amdgcn_cvt_pk_fp8_f32(h6, h7, q1, true);
                    typedef unsigned u32x2 __attribute__((ext_vector_type(2))); u32x2 w8; w8.x = (unsigned)q0; w8.y = (unsigned)q1;
                    *(u32x2*)((unsigned char*)H + (size_t)row * ldh + col0) = w8;
                } else {
                u32x4 w; w.x = cvt_pk_bf16(silu_f(g0[0]) * u0[0], silu_f(g0[1]) * u0[1]); w.y = cvt_pk_bf16(silu_f(g0[2]) * u0[2], silu_f(g0[3]) * u0[3]);
                w.z = cvt_pk_bf16(silu_f(g1[0]) * u1[0], silu_f(g1[1]) * u1[1]); w.w = cvt_pk_bf16(silu_f(g1[2]) * u1[2], silu_f(g1[3]) * u1[3]);
                *(u32x4*)rowp = w; } }
    }
};
struct EpiProbeSum {
    static constexpr bool PERM = true, AFTER_DRAIN = false;
    float* sink;
    __device__ __forceinline__ void operator()(const f32x4 (&acc)[2][2][4][2], const Unit& u, int wr, int wc, int fr, int fq) const {
        f32x4 s = acc[0][0][0][0];
#pragma unroll
        for (int ai = 0; ai < 2; ++ai)
#pragma unroll
            for (int bj = 0; bj < 2; ++bj)
#pragma unroll
                for (int m = 0; m < 4; ++m)
#pragma unroll
                    for (int n = 0; n < 2; ++n) s += acc[ai][bj][m][n];
        sink[(size_t)(u.pm * 16 + u.pn) * 512 + threadIdx.x] = (s[0] + s[1]) + (s[2] + s[3]);
    }
};
struct EpiResF32 {
    static constexpr bool PERM = false, AFTER_DRAIN = false;
    const float* base; float* out; int ldc;
    __device__ __forceinline__ void operator()(const f32x4 (&acc)[2][2][4][2], const Unit& u, int wr, int wc, int fr, int fq) const {
        const int row0 = u.pm * BM + wr * 64 + fr, col0 = u.pn * BM + wc * 32 + 4 * fq;
#pragma unroll
        for (int ai = 0; ai < 2; ++ai)
#pragma unroll
            for (int m = 0; m < 4; ++m) { const size_t ro = (size_t)(row0 + ai * HALF + m * 16) * ldc + col0;
#pragma unroll
                for (int bj = 0; bj < 2; ++bj)
#pragma unroll
                    for (int n = 0; n < 2; ++n) { const f32x4 b = *(const f32x4*)(base + ro + bj * HALF + n * 16); *(f32x4*)(out + ro + bj * HALF + n * 16) = acc[ai][bj][m][n] + b; } }
    }
};
struct EpiResNorm {
    static constexpr bool PERM = false, AFTER_DRAIN = false;
    const float* base; float* out; int ldc; const float* gn; bf16_t* XG; float* SSQ;
    __device__ __forceinline__ void operator()(const f32x4 (&acc)[2][2][4][2], const Unit& u, int wr, int wc, int fr, int fq) const {
        const int row0 = u.pm * BM + wr * 64 + fr, col0 = u.pn * BM + wc * 32 + 4 * fq;
        f32x4 gv[2][2];
#pragma unroll
        for (int bj = 0; bj < 2; ++bj)
#pragma unroll
            for (int n = 0; n < 2; ++n) gv[bj][n] = *(const f32x4*)(gn + col0 + bj * HALF + n * 16);
#pragma unroll
        for (int ai = 0; ai < 2; ++ai)
#pragma unroll
            for (int m = 0; m < 4; ++m) { const int row = row0 + ai * HALF + m * 16; const size_t ro = (size_t)row * ldc + col0; float ss = 0.f;
#pragma unroll
                for (int bj = 0; bj < 2; ++bj)
#pragma unroll
                    for (int n = 0; n < 2; ++n) { const f32x4 v = acc[ai][bj][m][n] + *(const f32x4*)(base + ro + bj * HALF + n * 16); *(f32x4*)(out + ro + bj * HALF + n * 16) = v;
                        ss += (v[0] * v[0] + v[1] * v[1]) + (v[2] * v[2] + v[3] * v[3]); const f32x4 xg = v * gv[bj][n];
                        typedef unsigned u32x2 __attribute__((ext_vector_type(2)));
                        u32x2 w; w.x = cvt_pk_bf16(xg[0], xg[1]); w.y = cvt_pk_bf16(xg[2], xg[3]); *(u32x2*)(XG + ro + bj * HALF + n * 16) = w; }
                ss += __shfl_xor(ss, 16); ss += __shfl_xor(ss, 32);
                if (fq == 0) SSQ[(size_t)row * 16 + u.pn * 4 + wc] = ss; }
    }
};
template <bool RS = false> struct EpiResBf16Norm {
    static constexpr bool PERM = true, AFTER_DRAIN = false;
    const bf16_t* base; bf16_t* out; int ldc; float* SSQ; unsigned char* x8; const PG8_LAS f32x2t* T = nullptr;
    __device__ __forceinline__ void operator()(const f32x4 (&acc)[2][2][4][2], const Unit& u, int wr, int wc, int fr, int fq) const {
        const int row0 = u.pm * BM + wr * 64 + fr; const int col0 = u.pn * BM + wc * 32 + 8 * fq;
#pragma unroll
        for (int ai = 0; ai < 2; ++ai) {
        u32x4 bb[2][4][2];
#pragma unroll
            for (int m = 0; m < 4; ++m)
#pragma unroll
                for (int bj = 0; bj < 2; ++bj) bb[ai][m][bj] = *(const u32x4*)(base + (size_t)(row0 + ai * HALF + m * 16) * ldc + col0 + bj * HALF);
#pragma unroll
            for (int m = 0; m < 4; ++m) { const int row = row0 + ai * HALF + m * 16; const size_t ro = (size_t)row * ldc + col0; float ss = 0.f;
                const float rsc = RS ? T[u.idx * 256 + wr * 64 + fr + ai * HALF + m * 16].y : 1.0f;
#pragma unroll
                for (int bj = 0; bj < 2; ++bj) { const u32x4 b = bb[ai][m][bj];
                    f32x4 v0 = acc[ai][bj][m][0] * rsc, v1 = acc[ai][bj][m][1] * rsc;
                    v0[0] += __uint_as_float(b.x << 16); v0[1] += __uint_as_float(b.x & 0xffff0000u); v0[2] += __uint_as_float(b.y << 16); v0[3] += __uint_as_float(b.y & 0xffff0000u);
                    v1[0] += __uint_as_float(b.z << 16); v1[1] += __uint_as_float(b.z & 0xffff0000u); v1[2] += __uint_as_float(b.w << 16); v1[3] += __uint_as_float(b.w & 0xffff0000u);
                    ss += ((v0[0] * v0[0] + v0[1] * v0[1]) + (v0[2] * v0[2] + v0[3] * v0[3])) + ((v1[0] * v1[0] + v1[1] * v1[1]) + (v1[2] * v1[2] + v1[3] * v1[3]));
                    u32x4 w; w.x = cvt_pk_bf16(v0[0], v0[1]); w.y = cvt_pk_bf16(v0[2], v0[3]); w.z = cvt_pk_bf16(v1[0], v1[1]); w.w = cvt_pk_bf16(v1[2], v1[3]);
                    *(u32x4*)(out + ro + bj * HALF) = w;
                    if (x8) { int q0 = 0, q1 = 0; q0 = __builtin_amdgcn_cvt_pk_fp8_f32(v0[0], v0[1], q0, false); q0 = __builtin_amdgcn_cvt_pk_fp8_f32(v0[2], v0[3], q0, true); q1 = __builtin_amdgcn_cvt_pk_fp8_f32(v1[0], v1[1], q1, false); q1 = __builtin_amdgcn_cvt_pk_fp8_f32(v1[2], v1[3], q1, true);
                        typedef unsigned u32x2 __attribute__((ext_vector_type(2))); u32x2 w8; w8.x = (unsigned)q0; w8.y = (unsigned)q1; *(u32x2*)(x8 + ro + bj * HALF) = w8; } }
                ss += __shfl_xor(ss, 16); ss += __shfl_xor(ss, 32);
                if (fq == 0) SSQ[(size_t)row * 16 + u.pn * 4 + wc] = ss; }
            asm volatile("" ::: "memory"); }
    }
};
template <bool FIRST> struct EpiMoeDown {
    static constexpr bool PERM = false, AFTER_DRAIN = false;
    const int* rowtok; const float* roww; float* out; int ldc; const bf16_t* xb;
    __device__ __forceinline__ void operator()(const f32x4 (&acc)[2][2][4][2], const Unit& u, int wr, int wc, int fr, int fq) const {
        const int row0 = u.pm * BM + wr * 64 + fr, col0 = u.pn * BM + wc * 32 + 4 * fq;
        int tk[2][4]; float wk[2][4];
#pragma unroll
        for (int ai = 0; ai < 2; ++ai)
#pragma unroll
            for (int m = 0; m < 4; ++m) { tk[ai][m] = rowtok[row0 + ai * HALF + m * 16]; wk[ai][m] = roww[row0 + ai * HALF + m * 16]; }
#pragma unroll
        for (int ai = 0; ai < 2; ++ai)
#pragma unroll
            for (int m = 0; m < 4; ++m) { const int tok = tk[ai][m]; const float w = wk[ai][m];
                if (tok >= 0) { float* op = out + (size_t)tok * ldc + col0; const bf16_t* bp = xb + (size_t)tok * ldc + col0;
#pragma unroll
                    for (int bj = 0; bj < 2; ++bj)
#pragma unroll
                        for (int n = 0; n < 2; ++n) { f32x4 b;
                            if (FIRST) { typedef unsigned u32x2 __attribute__((ext_vector_type(2))); const u32x2 q = *(const u32x2*)(bp + bj * HALF + n * 16);
                                b[0] = __uint_as_float(q.x << 16); b[1] = __uint_as_float(q.x & 0xffff0000u); b[2] = __uint_as_float(q.y << 16); b[3] = __uint_as_float(q.y & 0xffff0000u); }
                            else b = *(const f32x4*)(op + bj * HALF + n * 16);
                            *(f32x4*)(op + bj * HALF + n * 16) = acc[ai][bj][m][n] * w + b; } } }
    }
};

template <class Epi, class Sched, bool ALIGN_EPI = false, bool SP2 = false, bool FP8 = false, int FP8_ASCALE = 0x7f7f7f7f  , class Mid = NoMid>
__device__ __forceinline__ void gemm_phase(PG8_LAS unsigned char* lds, const Gemm g, const Sched& S, const Epi& E, const Mid& Mi = Mid()) {
    const int tid = threadIdx.x, wid = __builtin_amdgcn_readfirstlane(tid >> 6), lane = tid & 63, wr = wid >> 2, wc = wid & 3, fr = lane & 15, fq = lane >> 4;
    const int K = g.K, nt = K / BK, lda = g.lda ? g.lda : K, ldb = g.ldb ? g.ldb : K;
    unsigned voffA[2], voffB[2];
#pragma unroll
    for (int i = 0; i < 2; ++i) { int R, C; stage_rc(tid * 16 + i * 8192, R, C); const int Rb = Epi::PERM ? ((R & ~31) + perm32(R & 31)) : R;
        voffA[i] = (unsigned)(R * lda + C) * 2u; voffB[i] = (unsigned)(Rb * ldb + C) * 2u; }
    const size_t kstep = (size_t)(BK * 2);
    const size_t hstepA = (size_t)HALF * lda * 2, hstepB = (size_t)HALF * ldb * 2;
    const size_t tstepA = 2 * hstepA, tstepB = 2 * hstepB;
    const unsigned ldsw = (unsigned)wid * 1024u;
    const int aoff = lds_byte(wr * 64 + fr, fq * 8), boff = lds_byte(wc * 32 + fr, fq * 8);
    const int aoffL = lds_byte(wr * 64 + fr, fq * 16), aoffH = lds_byte(wr * 64 + fr, fq * 16 + 8), boffL = lds_byte(wc * 32 + fr, fq * 16), boffH = lds_byte(wc * 32 + fr, fq * 16 + 8);
    typedef int pg8_i4 __attribute__((ext_vector_type(4))); typedef int pg8_i8 __attribute__((ext_vector_type(8)));
#define PG8_SA(b, h) (((b) * 2 + (h)) * HTB)
#define PG8_SB(b, h) ((4 + (b) * 2 + (h)) * HTB)
#define PG8_STAGE(bufoff, gbase, voff) do { _Pragma("unroll") for (int _i = 0; _i < 2; ++_i) \
        __builtin_amdgcn_global_load_lds((const unsigned*)((const char*)(gbase) + (voff)[_i]), (PG8_LAS unsigned*)(lds + (bufoff) + ldsw + _i * 8192), 16, 0, 0); } while (0)
#define PG8_LDA(dst, b, h) do { if constexpr (FP8) { _Pragma("unroll") for (int m = 0; m < 4; ++m) { const pg8_i4 _lo = *(const PG8_LAS pg8_i4*)(lds + PG8_SA(b, h) + aoffL + m * 2048), _hi = *(const PG8_LAS pg8_i4*)(lds + PG8_SA(b, h) + aoffH + m * 2048); \
            dst##8[m] = __builtin_shufflevector(_lo, _hi, 0, 1, 2, 3, 4, 5, 6, 7); } } \
        else { _Pragma("unroll") for (int m = 0; m < 4; ++m) _Pragma("unroll") for (int k = 0; k < 2; ++k) dst[m][k] = *(const PG8_LAS bf16x8*)(lds + PG8_SA(b, h) + aoff + m * 2048 + k * 1024); } } while (0)
#define PG8_LDB(dst, b, h) do { if constexpr (FP8) { _Pragma("unroll") for (int n = 0; n < 2; ++n) { const pg8_i4 _lo = *(const PG8_LAS pg8_i4*)(lds + PG8_SB(b, h) + boffL + n * 2048), _hi = *(const PG8_LAS pg8_i4*)(lds + PG8_SB(b, h) + boffH + n * 2048); \
            dst##8[n] = __builtin_shufflevector(_lo, _hi, 0, 1, 2, 3, 4, 5, 6, 7); } } \
        else { _Pragma("unroll") for (int n = 0; n < 2; ++n) _Pragma("unroll") for (int k = 0; k < 2; ++k) dst[n][k] = *(const PG8_LAS bf16x8*)(lds + PG8_SB(b, h) + boff + n * 2048 + k * 1024); } } while (0)
#define PG8_MMA(ai, bj, At, Bt) do { __builtin_amdgcn_s_setprio(1); _Pragma("unroll") for (int m = 0; m < 4; ++m) _Pragma("unroll") for (int n = 0; n < 2; ++n) { \
        if constexpr (FP8) asm volatile("v_mfma_scale_f32_16x16x128_f8f6f4 %0, %1, %2, %0, %3, %4 op_sel_hi:[0,0,0]" : "+v"(acc[ai][bj][m][n]) : "v"(Bt##8[n]), "v"(At##8[m]), "v"(0x79797979), "v"(FP8_ASCALE)); \
        else { _Pragma("unroll") for (int k = 0; k < 2; ++k) acc[ai][bj][m][n] = __builtin_amdgcn_mfma_f32_16x16x32_bf16(Bt[n][k], At[m][k], acc[ai][bj][m][n], 0, 0, 0); } } \
        __builtin_amdgcn_s_setprio(0); } while (0)
#define PG8_WAIT_V(n) asm volatile("s_waitcnt vmcnt(" #n ")" ::: "memory")
#define PG8_WAIT_L(n) asm volatile("s_waitcnt lgkmcnt(" #n ")" ::: "memory")
#define PG8_BAR __builtin_amdgcn_s_barrier()
#define PG8_SCHED __builtin_amdgcn_sched_barrier(0)
    Unit cur, nxt; int ui = 0;
    if (!S.next(0, cur)) return;
    cur.idx = 0;
    f32x4 acc[2][2][4][2];
#pragma unroll
    for (int a = 0; a < 2; ++a)
#pragma unroll
        for (int b = 0; b < 2; ++b)
#pragma unroll
            for (int m = 0; m < 4; ++m)
#pragma unroll
                for (int n = 0; n < 2; ++n) acc[a][b][m][n] = (f32x4){0.f, 0.f, 0.f, 0.f};
    bf16x8 At[4][2], B0[2][2], B1[2][2];
    pg8_i8 At8[4], B08[2], B18[2];
    const char* cA = (const char*)g.A + (size_t)cur.pm * tstepA; const char* cB = (const char*)g.Bt + S.b_off(cur) + (size_t)cur.pn * tstepB;
    S.a_ready(cur);
    if constexpr (SP2) {
        PG8_STAGE(PG8_SB(0, 0), cB, voffB); PG8_STAGE(PG8_SB(0, 1), cB + hstepB, voffB); PG8_STAGE(PG8_SA(0, 0), cA, voffA); PG8_STAGE(PG8_SA(0, 1), cA + hstepA, voffA);
        if (wr == 1) PG8_BAR;
        PG8_WAIT_V(2); PG8_BAR;
        PG8_STAGE(PG8_SB(1, 0), cB + kstep, voffB); PG8_STAGE(PG8_SA(1, 0), cA + kstep, voffA); PG8_STAGE(PG8_SB(1, 1), cB + hstepB + kstep, voffB);
        PG8_WAIT_V(6); PG8_BAR;
    } else {
        PG8_STAGE(PG8_SB(0, 0), cB, voffB); PG8_STAGE(PG8_SA(0, 0), cA, voffA); PG8_STAGE(PG8_SB(0, 1), cB + hstepB, voffB); PG8_STAGE(PG8_SA(0, 1), cA + hstepA, voffA);
        if (wr == 1) PG8_BAR;
        PG8_WAIT_V(4); PG8_BAR;
        PG8_STAGE(PG8_SB(1, 0), cB + kstep, voffB); PG8_STAGE(PG8_SA(1, 0), cA + kstep, voffA); PG8_STAGE(PG8_SB(1, 1), cB + hstepB + kstep, voffB);
        PG8_WAIT_V(6); PG8_BAR;
    }
    for (;;) {
        const bool has_next = S.next(ui + 1, nxt); nxt.idx = ui + 1;
        const char* nA = has_next ? (const char*)g.A + (size_t)nxt.pm * tstepA : cA; const char* nB = has_next ? (const char*)g.Bt + S.b_off(nxt) + (size_t)nxt.pn * tstepB : cB;
#pragma unroll 1
        for (int t = 0; t < nt; t += 2) {
            const bool last = (t == nt - 2);
            const char* a1 = cA + (size_t)(t + 1) * kstep;
            const char* a2 = last ? nA : cA + (size_t)(t + 2) * kstep; const char* b2 = last ? nB : cB + (size_t)(t + 2) * kstep;
            const char* a3 = a2 + kstep; const char* b3 = b2 + kstep;
            if (last && has_next) S.a_ready(nxt);
            if constexpr (SP2) {
            PG8_LDB(B0, 0, 0); PG8_LDB(B1, 0, 1); PG8_SCHED; PG8_LDA(At, 0, 0); PG8_STAGE(PG8_SA(1, 1), a1 + hstepA, voffA);
            PG8_WAIT_V(8); PG8_WAIT_L(0); PG8_BAR; PG8_MMA(0, 0, At, B0); PG8_MMA(0, 1, At, B1); PG8_BAR; PG8_SCHED;
            PG8_LDA(At, 0, 1); PG8_STAGE(PG8_SB(0, 0), b2, voffB); PG8_STAGE(PG8_SB(0, 1), b2 + hstepB, voffB); PG8_STAGE(PG8_SA(0, 0), a2, voffA);
            PG8_WAIT_V(8); PG8_WAIT_L(0); PG8_BAR; PG8_MMA(1, 0, At, B0); PG8_MMA(1, 1, At, B1); PG8_BAR; PG8_SCHED;
            PG8_LDB(B0, 1, 0); PG8_LDB(B1, 1, 1); PG8_SCHED; PG8_LDA(At, 1, 0); PG8_STAGE(PG8_SA(0, 1), a2 + hstepA, voffA);
            PG8_WAIT_V(8); PG8_WAIT_L(0); PG8_BAR; PG8_MMA(0, 0, At, B0); PG8_MMA(0, 1, At, B1); PG8_BAR; PG8_SCHED;
            PG8_LDA(At, 1, 1); PG8_STAGE(PG8_SB(1, 0), b3, voffB); PG8_STAGE(PG8_SB(1, 1), b3 + hstepB, voffB); PG8_STAGE(PG8_SA(1, 0), a3, voffA);
            PG8_WAIT_V(8); PG8_WAIT_L(0); PG8_BAR; PG8_MMA(1, 0, At, B0); PG8_MMA(1, 1, At, B1); PG8_BAR; PG8_SCHED;
            } else {
            PG8_LDB(B0, 0, 0); PG8_SCHED; PG8_LDA(At, 0, 0); PG8_STAGE(PG8_SA(1, 1), a1 + hstepA, voffA);
            PG8_WAIT_L(8); PG8_BAR; PG8_WAIT_L(0); PG8_MMA(0, 0, At, B0); PG8_BAR; PG8_SCHED;
            PG8_LDB(B1, 0, 1); PG8_STAGE(PG8_SB(0, 0), b2, voffB);
            PG8_BAR; PG8_WAIT_L(0); PG8_MMA(0, 1, At, B1); PG8_BAR;
            PG8_LDA(At, 0, 1); PG8_STAGE(PG8_SA(0, 0), a2, voffA);
            PG8_BAR; PG8_WAIT_L(0); PG8_MMA(1, 0, At, B0); PG8_BAR; PG8_SCHED;
            PG8_STAGE(PG8_SB(0, 1), b2 + hstepB, voffB);
            PG8_WAIT_V(6); PG8_BAR; PG8_MMA(1, 1, At, B1); PG8_BAR;
            PG8_LDB(B0, 1, 0); PG8_SCHED; PG8_LDA(At, 1, 0); PG8_STAGE(PG8_SA(0, 1), a2 + hstepA, voffA);
            PG8_WAIT_L(8); PG8_BAR; PG8_WAIT_L(0); PG8_MMA(0, 0, At, B0); PG8_BAR; PG8_SCHED;
            PG8_LDB(B1, 1, 1); PG8_STAGE(PG8_SB(1, 0), b3, voffB);
            PG8_BAR; PG8_WAIT_L(0); PG8_MMA(0, 1, At, B1); PG8_BAR;
            PG8_LDA(At, 1, 1); PG8_STAGE(PG8_SA(1, 0), a3, voffA);
            PG8_BAR; PG8_WAIT_L(0); PG8_MMA(1, 0, At, B0); PG8_BAR; PG8_SCHED;
            PG8_STAGE(PG8_SB(1, 1), b3 + hstepB, voffB);
            PG8_WAIT_V(6); PG8_BAR; PG8_MMA(1, 1, At, B1); PG8_BAR;
            }
            if constexpr (Mid::ON) { if (t == nt / 2 - 2) { float mfac[2][4]; Mi.load(cur, wr, fr, fq, mfac);
#pragma unroll
                for (int a = 0; a < 2; ++a)
#pragma unroll
                    for (int b = 0; b < 2; ++b)
#pragma unroll
                        for (int m = 0; m < 4; ++m)
#pragma unroll
                            for (int n = 0; n < 2; ++n) acc[a][b][m][n] *= mfac[a][m]; } }
        }
        if constexpr (ALIGN_EPI) { if (wr == 0) PG8_BAR; }
        if constexpr (!Epi::AFTER_DRAIN) { E(acc, cur, wr, wc, fr, fq); S.done(cur); }
        if (!has_next) break;
#pragma unroll
        for (int a = 0; a < 2; ++a)
#pragma unroll
            for (int b = 0; b < 2; ++b)
#pragma unroll
                for (int m = 0; m < 4; ++m)
#pragma unroll
                    for (int n = 0; n < 2; ++n) acc[a][b][m][n] = (f32x4){0.f, 0.f, 0.f, 0.f};
        cur = nxt; cA = nA; cB = nB; ++ui;
        if constexpr (ALIGN_EPI) { if (wr == 1) PG8_BAR; }
    }
    PG8_WAIT_V(0);
    if constexpr (!ALIGN_EPI) { if (wr == 0) PG8_BAR; }
    PG8_BAR;
    if constexpr (Epi::AFTER_DRAIN) { E.fused(acc, cur, wr, wc, fr, fq, lds, wid, lane); S.done(cur); }
#undef PG8_SA
#undef PG8_SB
#undef PG8_STAGE
#undef PG8_LDA
#undef PG8_LDB
#undef PG8_MMA
#undef PG8_WAIT_V
#undef PG8_WAIT_L
#undef PG8_BAR
#undef PG8_SCHED
}
}

constexpr int NWAVES = 8, NTHR = 512;
constexpr int D = 1024, BATCH = 4, SEQ = 8192, M = BATCH * SEQ, DEPTH = 2;
constexpr int D_LRU = 512, HD = 64, NH = 8, NG = 2, HPG = 4;
constexpr int NPROJ = 2560, D_IN = 2328;
constexpr int C_LX = 0, C_LG = 512, C_Q = 1024, C_KC = 1536, C_VC = 1664, C_KS = 1792, C_VS = 1920, C_KW = 2048, C_VW = 2176, C_GT = 2304;
constexpr int FF = 2816, NE = 8, NGU = 2 * FF;
constexpr int NCMP = 511, NCMPP = 512, NSELB = 128, LCH = 64, NCHUNK = SEQ / LCH;
constexpr int MOE_ROWS = M + NE * 256, MOE_PANELS = MOE_ROWS / 256;
constexpr float RMS_EPS = 1e-6f;

constexpr size_t MiB = 1u << 20;
constexpr size_t WS_CTL = 0, CTL_ZERO_BYTES = 1 * MiB;
constexpr size_t WS_TAB = 1 * MiB;
constexpr size_t WS_KC = 2 * MiB, WS_VC = 2 * MiB + 512 * 1024;
constexpr size_t WS_AGGA = 3 * MiB, WS_AGGH = 4 * MiB, WS_HIN = 5 * MiB;
constexpr size_t WS_TOPE = 6 * MiB, WS_TOPW = 6 * MiB + 512 * 1024, WS_POS = 7 * MiB, WS_ROWTOK = 7 * MiB + 512 * 1024, WS_ROWW = 8 * MiB, WS_META = 8 * MiB + 512 * 1024, WS_ROWRS = 8 * MiB + 640 * 1024  , WS_RSTD = 13 * MiB  , WS_SSQ = 9 * MiB  , WS_SSQL = 11 * MiB, WS_SSQA = 12 * MiB  ;
constexpr size_t WS_WIN = 16 * MiB, WS_WOUT = 26 * MiB, WS_FGU = 30 * MiB, WS_FD = 41 * MiB, WS_MGU = 47 * MiB, WS_MD = 135 * MiB, WS_CW1 = 179 * MiB;
constexpr size_t WS_HN = 184 * MiB, WS_PROJ = 248 * MiB, WS_HID = 248 * MiB, WS_QN = 408 * MiB, WS_KSN = 440 * MiB, WS_KWN = 448 * MiB, WS_VST = 456 * MiB, WS_VWT = 464 * MiB, WS_MIX = 440 * MiB  , WS_FIN = 472 * MiB  , WS_XBUF = 440 * MiB, WS_END = 508 * MiB;
static_assert(WS_WIN + (size_t)DEPTH * NPROJ * D * 2 <= WS_WOUT && WS_FGU + (size_t)NGU * D * 2 <= WS_FD && WS_FD + (size_t)D * FF * 2 <= WS_MGU, "ws map 1");
static_assert(WS_MGU + (size_t)NE * NGU * D * 2 <= WS_MD && WS_MD + (size_t)NE * D * FF * 2 <= WS_CW1 && WS_CW1 + (size_t)4 * 128 * 2048 * 2 <= WS_HN, "ws map 2");
static_assert(WS_PROJ + (size_t)M * NPROJ * 2 <= WS_QN && WS_HID + (size_t)MOE_ROWS * FF * 2 <= WS_XBUF && WS_XBUF + (size_t)MOE_ROWS * D * 2 <= WS_END, "ws map 3");
constexpr int CW_BAR = 4096;
constexpr int CW_MOECNT = 16384;
constexpr int LDS_BYTES = 163840;
constexpr int MISC_OFF = LDS_BYTES - 256;

#define GAS __attribute__((address_space(1)))
#define LAS __attribute__((address_space(3)))
typedef unsigned short bf16;
typedef unsigned v4u __attribute__((ext_vector_type(4)));
typedef unsigned v2u __attribute__((ext_vector_type(2)));
typedef float f32x4 __attribute__((ext_vector_type(4)));
typedef short abf16x8 __attribute__((ext_vector_type(8)));
typedef float f32x16 __attribute__((ext_vector_type(16)));
#define LDS_WAIT() asm volatile("s_waitcnt lgkmcnt(0)" ::: "memory")
__device__ __forceinline__ unsigned f2bf(float f) { unsigned u = __builtin_bit_cast(unsigned, f); return (u + 0x7fffu + ((u >> 16) & 1u)) >> 16; }
__device__ __forceinline__ unsigned pk2(float lo, float hi) { return f2bf(lo) | (f2bf(hi) << 16); }
__device__ __forceinline__ float bf2f(bf16 v) { return __uint_as_float((unsigned)v << 16); }
__device__ __forceinline__ float bflo(unsigned w) { return __uint_as_float(w << 16); }
__device__ __forceinline__ float bfhi(unsigned w) { return __uint_as_float(w & 0xffff0000u); }
__device__ __forceinline__ float gelu_tanh(float x) { const float u = 0.7978845608028654f * (x + 0.044715f * x * x * x); const float e = __expf(2.0f * u); const float th = 1.0f - 2.0f / (e + 1.0f); return 0.5f * x * (1.0f + th); }
__device__ __forceinline__ float sigmoid_f(float x) { return 1.0f / (1.0f + __expf(-x)); }
__device__ __forceinline__ float wave_sum(float v) {
#pragma unroll
    for (int o = 1; o < 64; o <<= 1) v += __shfl_xor(v, o);
    return v;
}
__device__ const unsigned char T5_BUCKET[128] = {0, 1, 2, 3, 4, 5, 6, 7, 8, 9, 10, 11, 12, 13, 14, 15, 16, 16, 16, 17, 17, 18, 18, 18, 19, 19, 19, 20, 20, 20, 20, 21, 21, 21, 21, 22, 22, 22, 22, 22, 23, 23, 23, 23, 23, 23, 24, 24, 24, 24, 24, 24, 25, 25, 25, 25, 25, 25, 25, 26, 26, 26, 26, 26, 26, 26, 26, 27, 27, 27, 27, 27, 27, 27, 27, 27, 27, 28, 28, 28, 28, 28, 28, 28, 28, 28, 28, 29, 29, 29, 29, 29, 29, 29, 29, 29, 29, 29, 29, 30, 30, 30, 30, 30, 30, 30, 30, 30, 30, 30, 30, 30, 30, 31, 31, 31, 31, 31, 31, 31, 31, 31, 31, 31, 31, 31, 31, 31};

#define XB_TMO      128
#define XB_XCNT(j)  (256  + 64 * (j))
#define XB_XSUB(j)  (1280 + 64 * (j))
#define XB_XGEN(j)  (2304 + 64 * (j))
#define XB_TOP      3328
#define XB_TOPGEN   3392
#define XCD_BAR_WORDS 3456
#define XB_SPIN_CAP (1u << 18)

__device__ __forceinline__ unsigned xb_ld(unsigned* p)              { return __hip_atomic_load(p, __ATOMIC_RELAXED, __HIP_MEMORY_SCOPE_AGENT); }
__device__ __forceinline__ unsigned xb_add(unsigned* p, unsigned v) { return __hip_atomic_fetch_add(p, v, __ATOMIC_RELAXED, __HIP_MEMORY_SCOPE_AGENT); }
__device__ __forceinline__ unsigned xb_xcc_id() { return (unsigned)__builtin_amdgcn_s_getreg((3 << 11) | 20) & 0xFu; }
#define XB_SPIN(cond, bar) do { unsigned _sp = 0; while (cond) { __builtin_amdgcn_s_sleep(1); \
    if ((++_sp & 255u) == 0u) { if (xb_ld(&(bar)[XB_TMO])) break; if (_sp > XB_SPIN_CAP) { atomicAdd(&(bar)[XB_TMO], 1u); break; } } } } while (0)

struct XcdBarrier {
    unsigned* bar; unsigned x;
    volatile LAS unsigned* st;
};

__device__ __forceinline__ XcdBarrier xcd_barrier_post(unsigned* bar, volatile LAS unsigned* st) {
    XcdBarrier b; b.bar = bar; b.x = xb_xcc_id(); b.st = st;
    if (threadIdx.x == 0) (void)xb_add(&bar[XB_XCNT(b.x)], 1u);
    return b;
}
__device__ __forceinline__ void xcd_barrier_complete(unsigned* bar, unsigned x, unsigned& nloc, unsigned& nx) {
    const unsigned G = gridDim.x * gridDim.y * gridDim.z;
    unsigned sum, cnt, mine, sp = 0u;
    for (;;) {
        sum = 0u; cnt = 0u; mine = 0u;
#pragma unroll
        for (unsigned j = 0; j < 16; ++j) { const unsigned c = xb_ld(&bar[XB_XCNT(j)]); sum += c; cnt += (c > 0u) ? 1u : 0u; mine = (j == x) ? c : mine; }
        if (sum == G) break;
        __builtin_amdgcn_s_sleep(1);
        if ((++sp & 255u) == 0u) { if (xb_ld(&bar[XB_TMO])) break; if (sp > XB_SPIN_CAP) { atomicAdd(&bar[XB_TMO], 1u); break; } }
    }
    nloc = mine > 0u ? mine : 1u; nx = cnt > 0u ? cnt : 1u;
}

__device__ __forceinline__ void xcd_barrier(const XcdBarrier& b) {
    asm volatile("s_waitcnt vmcnt(0)" ::: "memory");
    __syncthreads();
    if (threadIdx.x == 0) {
        unsigned* bar = b.bar;
        __builtin_amdgcn_s_waitcnt(0);
        unsigned nloc = b.st[0], nx = b.st[1];
        if (nloc == 0u) { xcd_barrier_complete(bar, b.x, nloc, nx); b.st[0] = nloc; b.st[1] = nx; }
        const unsigned old = xb_add(&bar[XB_XSUB(b.x)], 1u);
        const unsigned gen = old / nloc;
        if (old + 1u == (gen + 1u) * nloc) {
            __builtin_amdgcn_fence(__ATOMIC_RELEASE, "agent");
            asm volatile("s_waitcnt vmcnt(0)" ::: "memory");
            const unsigned og = xb_add(&bar[XB_TOP], 1u);
            const unsigned tg = og / nx;
            if (og + 1u == (tg + 1u) * nx) xb_add(&bar[XB_TOPGEN], 1u);
            else XB_SPIN(xb_ld(&bar[XB_TOPGEN]) == tg, bar);
            __builtin_amdgcn_fence(__ATOMIC_ACQUIRE, "agent");
            xb_add(&bar[XB_XGEN(b.x)], 1u);
            asm volatile("s_waitcnt vmcnt(0)" ::: "memory");
        } else {
            XB_SPIN(xb_ld(&bar[XB_XGEN(b.x)]) == gen, bar);
            __builtin_amdgcn_fence(__ATOMIC_ACQUIRE, "agent");
            asm volatile("s_waitcnt vmcnt(0)" ::: "memory");
        }
    }
    __syncthreads();
}

struct Args { const float* in[27]; float* out; unsigned char* ws; int ph_lo, ph_hi, use_bar, pad; };
typedef const __attribute__((address_space(4))) Args KArgs;
__device__ __forceinline__ KArgs* kargs() { KArgs* p = (KArgs*)__builtin_amdgcn_kernarg_segment_ptr(); asm volatile("" : "+s"(p)); return p; }
#define INP(i) ((const float*)(kargs()->in[i]))
struct Ctx {
    LAS unsigned char* lds; unsigned char* ws; float* out;
    int tid, lane, wave, G, bid;
};
#define WSP(T, off) ((T*)(C.ws + (off)))

#ifndef INPROJ_FP8_MASK
#define INPROJ_FP8_MASK 2
#endif
#define INPROJ_FP8(l) (((INPROJ_FP8_MASK) >> (l)) & 1)
__device__ __forceinline__ void tr_item(const float* W, int N, bf16* WT, int ldt, int k0, int n0, int outrow0, LAS float* scr, int lane, const float* gain) {
    const int a = lane & 15, kq = lane >> 4; const int nn = n0 + 4 * a; const bool ok = nn < N;
    f32x4 v[16];
#pragma unroll
    for (int i = 0; i < 16; ++i) v[i] = ok ? *(const f32x4*)(W + (size_t)(k0 + 4 * i + kq) * N + nn) : (f32x4){0.f, 0.f, 0.f, 0.f};
#pragma unroll
    for (int i = 0; i < 16; ++i) { LAS float* d = scr + (4 * i + kq) * 65 + 4 * a; const float gk = gain ? gain[k0 + 4 * i + kq] : 1.0f; d[0] = v[i].x * gk; d[1] = v[i].y * gk; d[2] = v[i].z * gk; d[3] = v[i].w * gk; }
    LDS_WAIT(); asm volatile("" ::: "memory");
    const int c = lane & 7, nl = lane >> 3;
#pragma unroll
    for (int j = 0; j < 8; ++j) { const int n = nl + 8 * j; const LAS float* sp = scr + (8 * c) * 65 + n;
        v4u o; o.x = pk2(sp[0 * 65], sp[1 * 65]); o.y = pk2(sp[2 * 65], sp[3 * 65]); o.z = pk2(sp[4 * 65], sp[5 * 65]); o.w = pk2(sp[6 * 65], sp[7 * 65]);
        *(v4u*)(WT + (size_t)(outrow0 + n) * ldt + k0 + 8 * c) = o; }
    LDS_WAIT(); asm volatile("" ::: "memory");
}
__device__ __forceinline__ unsigned pk4_fp8(float a, float b, float c, float d) { int r = 0; r = __builtin_amdgcn_cvt_pk_fp8_f32(a, b, r, false); r = __builtin_amdgcn_cvt_pk_fp8_f32(c, d, r, true); return (unsigned)r; }
__device__ __forceinline__ void tr_item8(const float* W, int N, unsigned char* WT8, int ldt, int k0, int n0, int outrow0, LAS float* scr, int lane, const float* gain) {
    const int a = lane & 15, kq = lane >> 4; const int nn = n0 + 4 * a; const bool ok = nn < N;
    f32x4 v[16];
#pragma unroll
    for (int i = 0; i < 16; ++i) v[i] = ok ? *(const f32x4*)(W + (size_t)(k0 + 4 * i + kq) * N + nn) : (f32x4){0.f, 0.f, 0.f, 0.f};
#pragma unroll
    for (int i = 0; i < 16; ++i) { LAS float* d = scr + (4 * i + kq) * 65 + 4 * a; const float gk = gain ? 64.0f * gain[k0 + 4 * i + kq] : 64.0f; d[0] = v[i].x * gk; d[1] = v[i].y * gk; d[2] = v[i].z * gk; d[3] = v[i].w * gk; }
    LDS_WAIT(); asm volatile("" ::: "memory");
    const int c = lane & 7, nl = lane >> 3;
#pragma unroll
    for (int j = 0; j < 8; ++j) { const int n = nl + 8 * j; const LAS float* sp = scr + (8 * c) * 65 + n;
        v2u o; o.x = pk4_fp8(sp[0 * 65], sp[1 * 65], sp[2 * 65], sp[3 * 65]); o.y = pk4_fp8(sp[4 * 65], sp[5 * 65], sp[6 * 65], sp[7 * 65]);
        *(v2u*)(WT8 + (size_t)(outrow0 + n) * ldt + k0 + 8 * c) = o; }
    LDS_WAIT(); asm volatile("" ::: "memory");
}
__device__ __forceinline__ void tr_matrix(Ctx& C, const float* W, int K, int N, int NP, bf16* WT, int gu, int& cursor, const float* gain = nullptr, bool fp8 = false) {
    LAS float* scr = (LAS float*)(C.lds + C.wave * 16640);
    const int gw = C.bid * NWAVES + C.wave, NGW = C.G * NWAVES;
    const int nblk = NP / 64, nitems = (K / 64) * nblk;
    int first = (gw - (cursor % NGW) + NGW) % NGW;
    for (int it = first; it < nitems; it += NGW) {
        const int kb = it / nblk, nb = it % nblk, k0 = 64 * kb, n0 = 64 * nb;
        int orow = n0;
        if (gu) orow = (n0 / 128) * 256 + (n0 % 128) + (gu == 2 ? 128 : 0);
        if (fp8) tr_item8(W, N, (unsigned char*)WT, K, k0, n0, orow, scr, C.lane, gain); else tr_item(W, N, WT, K, k0, n0, orow, scr, C.lane, gain);
    }
    cursor += nitems;
}
__device__ __forceinline__ void rms_row_to_bf16(const float* xrow, const float* g, bf16* orow, int lane) {
    const f32x4* xr = (const f32x4*)xrow + lane; const f32x4* gr = (const f32x4*)g + lane;
    f32x4 v[4]; float s = 0.f;
#pragma unroll
    for (int j = 0; j < 4; ++j) { v[j] = xr[64 * j]; s += (v[j].x * v[j].x + v[j].y * v[j].y) + (v[j].z * v[j].z + v[j].w * v[j].w); }
    const float rstd = 1.0f / sqrtf(wave_sum(s) * (1.f / D) + RMS_EPS);
    unsigned long long* o8 = (unsigned long long*)orow + lane;
#pragma unroll
    for (int j = 0; j < 4; ++j) { const f32x4 gg = gr[64 * j]; o8[64 * j] = (unsigned long long)pk2(v[j].x * rstd * gg.x, v[j].y * rstd * gg.y) | ((unsigned long long)pk2(v[j].z * rstd * gg.z, v[j].w * rstd * gg.w) << 32); }
}
__device__ __forceinline__ void phase_norm(Ctx& C, const float* src, const float* g) {
    const int gw = C.bid * NWAVES + C.wave, NGW = C.G * NWAVES; bf16* HN = WSP(bf16, WS_HN);
    for (int m = gw; m < M; m += NGW) rms_row_to_bf16(src + (size_t)m * D, g, HN + (size_t)m * D, C.lane);
}
__device__ __forceinline__ void phase_prologue(Ctx& C) {
    const float* const out_norm_g = INP(17);
    const float* const norm2_g = INP(19);
    const float* const x = INP(0);
    const float* const rel_bias = INP(1);
    const float* const norm1_g = INP(2);
    const float* const w_in = INP(3);
    const float* const cmp_pos = INP(13);
    const float* const cmp_w1 = INP(14);
    const float* const w_out = INP(18);
    const float* const ffn_w_gate = INP(20);
    const float* const ffn_w_up = INP(21);
    const float* const ffn_w_down = INP(22);
    const float* const moe_w_gate = INP(24);
    const float* const moe_w_up = INP(25);
    const float* const moe_w_down = INP(26);
    int cur = 0;
    for (int l = 0; l < DEPTH; ++l) {
        tr_matrix(C, w_in + (size_t)l * D * D_IN, D, D_IN, NPROJ, WSP(bf16, WS_WIN) + (size_t)l * NPROJ * D, 0, cur, norm1_g + l * D, INPROJ_FP8(l));
        tr_matrix(C, w_out + (size_t)l * D * D, D, D, D, WSP(bf16, WS_WOUT) + (size_t)l * D * D, 0, cur, out_norm_g + l * D);
        for (int k = 0; k < 2; ++k) tr_matrix(C, cmp_w1 + (size_t)(l * 2 + k) * 2048 * 128, 2048, 128, 128, WSP(bf16, WS_CW1) + (size_t)(l * 2 + k) * 128 * 2048, 0, cur);
    }
    tr_matrix(C, ffn_w_gate, D, FF, FF, WSP(bf16, WS_FGU), 1, cur, norm2_g, true);
    tr_matrix(C, ffn_w_up, D, FF, FF, WSP(bf16, WS_FGU), 2, cur, norm2_g, true);
    tr_matrix(C, ffn_w_down, FF, D, D, WSP(bf16, WS_FD), 0, cur, nullptr, true);
    for (int e = 0; e < NE; ++e) {
        tr_matrix(C, moe_w_gate + (size_t)e * D * FF, D, FF, FF, (bf16*)(WSP(unsigned char, WS_MGU) + (size_t)e * NGU * D), 1, cur, norm2_g + D, true);
        tr_matrix(C, moe_w_up + (size_t)e * D * FF, D, FF, FF, (bf16*)(WSP(unsigned char, WS_MGU) + (size_t)e * NGU * D), 2, cur, norm2_g + D, true);
        tr_matrix(C, moe_w_down + (size_t)e * FF * D, FF, D, D, (bf16*)(WSP(unsigned char, WS_MD) + (size_t)e * D * FF), 0, cur, nullptr, true);
    }
    float* BT = WSP(float, WS_TAB); float* CB = WSP(float, WS_TAB + 8192);
    const int gt = C.bid * NTHR + C.tid, NGT = C.G * NTHR;
    for (int i = gt; i < NH * 128; i += NGT) { const int h = i >> 7, dd = i & 127; BT[i] = rel_bias[(int)T5_BUCKET[dd] * NH + h]; }
    if (gt < NH) { float mx = -3.0e38f; for (int bk = 0; bk < 32; ++bk) mx = fmaxf(mx, rel_bias[bk * NH + gt]); BT[NH * 128 + gt] = mx; }
    { const int gw = C.bid * NWAVES + C.wave, NGW = C.G * NWAVES;
      for (int i = gw; i < DEPTH * 2 * 128; i += NGW) { const int lk = i >> 7, c = i & 127; const float* pos = cmp_pos + (size_t)lk * 2048; const float* w1 = cmp_w1 + (size_t)lk * 2048 * 128 + c;
        float s = 0.f;
#pragma unroll 8
        for (int k = C.lane; k < 2048; k += 64) s += pos[k] * w1[(size_t)k * 128];
        s = wave_sum(s); if (C.lane == 0) CB[i] = s; } }
    int* RT = WSP(int, WS_ROWTOK); float* RW = WSP(float, WS_ROWW);
    for (int i = gt; i < 2 * MOE_ROWS; i += NGT) { RT[i] = -1; RW[i] = 0.f; WSP(float, WS_ROWRS)[i] = 0.f; }
    { const int gw = C.bid * NWAVES + C.wave, NGW = C.G * NWAVES; bf16* XB = WSP(bf16, WS_HN); float* SSQ = WSP(float, WS_SSQ);
      for (int m0 = gw; m0 < M; m0 += 2 * NGW) {
          f32x4 v[2][4];
#pragma unroll
          for (int r = 0; r < 2; ++r) { const int m = m0 + r * NGW; const f32x4* xr = (const f32x4*)(x + (size_t)(m < M ? m : 0) * D) + C.lane;
#pragma unroll
              for (int j = 0; j < 4; ++j) v[r][j] = xr[64 * j]; }
#pragma unroll
          for (int r = 0; r < 2; ++r) { const int m = m0 + r * NGW; if (m >= M) break;
              float s2 = 0.f;
#pragma unroll
              for (int j = 0; j < 4; ++j) s2 += (v[r][j].x * v[r][j].x + v[r][j].y * v[r][j].y) + (v[r][j].z * v[r][j].z + v[r][j].w * v[r][j].w);
              s2 = wave_sum(s2);
              unsigned long long* o8 = (unsigned long long*)(XB + (size_t)m * D) + C.lane;
#pragma unroll
              for (int j = 0; j < 4; ++j) o8[64 * j] = (unsigned long long)pk2(v[r][j].x, v[r][j].y) | ((unsigned long long)pk2(v[r][j].z, v[r][j].w) << 32);
              if (C.lane < 16) SSQ[(size_t)m * 16 + C.lane] = (C.lane == 0) ? s2 : 0.f; } } }
}

__device__ __forceinline__ void prep_qknorm(Ctx& C, int l) {
    const float* const q_norm_g = INP(11);
    const float* const k_norm_g = INP(12);
    const int gw = C.bid * NWAVES + C.wave, NGW = C.G * NWAVES, lane = C.lane;
    const bf16* PROJ = WSP(bf16, WS_PROJ); bf16* QN = WSP(bf16, WS_QN); bf16* KSN = WSP(bf16, WS_KSN); bf16* KWN = WSP(bf16, WS_KWN);
    float qg[8], kg[8];
#pragma unroll
    for (int j = 0; j < 8; ++j) { qg[j] = 0.125f * q_norm_g[l * HD + (8 * lane) % 64 + j]; kg[j] = k_norm_g[l * HD + (8 * lane) % 64 + j]; }
    for (int m0 = gw; m0 < M; m0 += 4 * NGW) {
        v4u wq[4], wk[4];
        const int l32 = lane & 31; const int colk = (l32 < 16) ? (C_KS + 8 * l32) : (C_KW + 8 * (l32 - 16));
#pragma unroll
        for (int r = 0; r < 4; ++r) { const int m = m0 + r * NGW; const bf16* p = PROJ + (size_t)(m < M ? m : 0) * NPROJ; wq[r] = *(const v4u*)(p + C_Q + 8 * lane); wk[r] = *(const v4u*)(p + colk); }
#pragma unroll
        for (int r = 0; r < 4; ++r) {
            const int m = m0 + r * NGW; if (m >= M) break;
            const int b = m / SEQ, t = m % SEQ;
            {
                const v4u w = wq[r];
                float v[8] = {bflo(w.x), bfhi(w.x), bflo(w.y), bfhi(w.y), bflo(w.z), bfhi(w.z), bflo(w.w), bfhi(w.w)};
                float ss = 0.f;
#pragma unroll
                for (int j = 0; j < 8; ++j) ss += v[j] * v[j];
                ss += __shfl_xor(ss, 1); ss += __shfl_xor(ss, 2); ss += __shfl_xor(ss, 4);
                const float rstd = 1.0f / sqrtf(ss * (1.f / 64.f) + RMS_EPS);
                v4u o; o.x = pk2(v[0] * rstd * qg[0], v[1] * rstd * qg[1]); o.y = pk2(v[2] * rstd * qg[2], v[3] * rstd * qg[3]); o.z = pk2(v[4] * rstd * qg[4], v[5] * rstd * qg[5]); o.w = pk2(v[6] * rstd * qg[6], v[7] * rstd * qg[7]);
                *(v4u*)(QN + (size_t)m * 512 + 8 * lane) = o;
            }
            {
                const v4u w = wk[r];
                float v[8] = {bflo(w.x), bfhi(w.x), bflo(w.y), bfhi(w.y), bflo(w.z), bfhi(w.z), bflo(w.w), bfhi(w.w)};
                float ss = 0.f;
#pragma unroll
                for (int j = 0; j < 8; ++j) ss += v[j] * v[j];
                ss += __shfl_xor(ss, 1); ss += __shfl_xor(ss, 2); ss += __shfl_xor(ss, 4);
                const float rstd = 1.0f / sqrtf(ss * (1.f / 64.f) + RMS_EPS);
                v4u o; o.x = pk2(v[0] * rstd * kg[0], v[1] * rstd * kg[1]); o.y = pk2(v[2] * rstd * kg[2], v[3] * rstd * kg[3]); o.z = pk2(v[4] * rstd * kg[4], v[5] * rstd * kg[5]); o.w = pk2(v[6] * rstd * kg[6], v[7] * rstd * kg[7]);
                const int g = (l32 >> 3) & 1, dd = 8 * (l32 & 7);
                if (lane < 16) *(v4u*)(KSN + ((size_t)(b * NG + g) * SEQ + t) * HD + dd) = o;
                else if (lane < 32) *(v4u*)(KWN + ((size_t)(b * NG + g) * SEQ + t) * HD + dd) = o;
            }
        }
    }
    {
        bf16* VST = WSP(bf16, WS_VST); bf16* VWT = WSP(bf16, WS_VWT);
        const int mi = C.wave & 3, dh = C.wave >> 2, g = mi & 1; const int col = ((mi >> 1) ? C_VW : C_VS) + g * HD + dh * 32; bf16* dstm = (mi >> 1) ? VWT : VST;
        for (int it = C.bid; it < BATCH * (SEQ / 64); it += C.G) {
            const int b = it / (SEQ / 64), t0 = (it % (SEQ / 64)) * 64;
            const v4u* src = (const v4u*)(PROJ + (size_t)(b * SEQ + t0 + lane) * NPROJ + col);
            bf16* dst = dstm + ((size_t)(b * NG + g) * HD + dh * 32) * SEQ + t0 + lane;
#pragma unroll
            for (int c = 0; c < 4; ++c) { const v4u w = src[c];
                dst[(size_t)(8 * c + 0) * SEQ] = (bf16)(w.x & 0xffffu); dst[(size_t)(8 * c + 1) * SEQ] = (bf16)(w.x >> 16); dst[(size_t)(8 * c + 2) * SEQ] = (bf16)(w.y & 0xffffu); dst[(size_t)(8 * c + 3) * SEQ] = (bf16)(w.y >> 16);
                dst[(size_t)(8 * c + 4) * SEQ] = (bf16)(w.z & 0xffffu); dst[(size_t)(8 * c + 5) * SEQ] = (bf16)(w.z >> 16); dst[(size_t)(8 * c + 6) * SEQ] = (bf16)(w.w & 0xffffu); dst[(size_t)(8 * c + 7) * SEQ] = (bf16)(w.w >> 16); }
        }
    }
}
constexpr int CMP_HP = 136;
__device__ __forceinline__ void prep_compress(Ctx& C, int l) {
    const float* const k_norm_g = INP(12);
    const float* const cmp_w2 = INP(15);
    const bf16* PROJ = WSP(bf16, WS_PROJ); const float* CB = WSP(float, WS_TAB + 8192); const bf16* W1T = WSP(bf16, WS_CW1);
    LAS float* RED = (LAS float*)C.lds;
    LAS bf16* HL = (LAS bf16*)(C.lds + 16384);
    const int lane = C.lane, w = C.wave, mc = w & 3, kh = w >> 2, cl = lane & 31, hh = lane >> 5;
    for (int it = C.bid; it < 16 * 16; it += C.G) {
        const int rt = it & 15, kind = (it >> 4) & 1, g = (it >> 5) & 1, b = it >> 6, bg = b * NG + g, n0 = 32 * rt;
        const int col0 = (kind ? C_VC : C_KC) + g * HD;
        f32x16 acc;
#pragma unroll
        for (int i = 0; i < 16; ++i) acc[i] = 0.f;
        {
            const bf16* ap = W1T + ((size_t)(l * 2 + kind) * 128 + 32 * mc + cl) * 2048 + 1024 * kh + 8 * hh;
            const bf16* xb = PROJ + (size_t)b * SEQ * NPROJ + col0 + 8 * hh; const int tau0 = 16 * (n0 + cl) + 16 * kh;
#pragma unroll 2
            for (int q = 0; q < 16; ++q) {
                int tau = tau0 + q; tau = tau < SEQ ? tau : SEQ - 1;
                const bf16* xp = xb + (size_t)tau * NPROJ;
                abf16x8 af[4], bfr[4];
#pragma unroll
                for (int j = 0; j < 4; ++j) { af[j] = *(const abf16x8*)(ap + 64 * q + 16 * j); bfr[j] = *(const abf16x8*)(xp + 16 * j); }
#pragma unroll
                for (int j = 0; j < 4; ++j) acc = __builtin_amdgcn_mfma_f32_32x32x16_bf16(af[j], bfr[j], acc, 0, 0, 0);
            }
        }
        if (kh == 1) {
#pragma unroll
            for (int i = 0; i < 16; ++i) RED[(mc * 16 + i) * 64 + lane] = acc[i];
        }
        __syncthreads();
        if (kh == 0) {
#pragma unroll
            for (int i = 0; i < 16; ++i) { const int c = 32 * mc + (i & 3) + 8 * (i >> 2) + 4 * hh;
                const float s = acc[i] + RED[(mc * 16 + i) * 64 + lane] + CB[(l * 2 + kind) * 128 + c];
                HL[cl * CMP_HP + c] = (bf16)f2bf(gelu_tanh(s)); }
        }
        __syncthreads();
        if (w == 0) {
            f32x16 o[2];
#pragma unroll
            for (int i = 0; i < 16; ++i) { o[0][i] = 0.f; o[1][i] = 0.f; }
            const float* w2 = cmp_w2 + (size_t)(l * 2 + kind) * 128 * 64;
#pragma unroll
            for (int s = 0; s < 8; ++s) {
                const abf16x8 hb = *(const LAS abf16x8*)(HL + cl * CMP_HP + 16 * s + 8 * hh);
#pragma unroll
                for (int mt = 0; mt < 2; ++mt) { const float* p = w2 + (size_t)(16 * s + 8 * hh) * 64 + 32 * mt + cl;
                    v4u a; a.x = pk2(p[0], p[64]); a.y = pk2(p[128], p[192]); a.z = pk2(p[256], p[320]); a.w = pk2(p[384], p[448]);
                    o[mt] = __builtin_amdgcn_mfma_f32_32x32x16_bf16(__builtin_bit_cast(abf16x8, a), hb, o[mt], 0, 0, 0); }
            }
            const int n = n0 + cl; const bool okn = n < NCMP;
            if (kind == 0) {
                float ss = 0.f;
#pragma unroll
                for (int i = 0; i < 16; ++i) ss += o[0][i] * o[0][i] + o[1][i] * o[1][i];
                ss += __shfl_xor(ss, 32);
                const float rstd = 1.0f / sqrtf(ss * (1.f / 64.f) + RMS_EPS);
                bf16* dst = WSP(bf16, WS_KC) + ((size_t)bg * NCMPP + n) * HD;
#pragma unroll
                for (int mt = 0; mt < 2; ++mt)
#pragma unroll
                    for (int q4 = 0; q4 < 4; ++q4) { const int d0 = 32 * mt + 8 * q4 + 4 * hh; const float* kg = k_norm_g + l * HD + d0;
                        v2u ov; ov.x = okn ? pk2(o[mt][4 * q4] * rstd * kg[0], o[mt][4 * q4 + 1] * rstd * kg[1]) : 0u; ov.y = okn ? pk2(o[mt][4 * q4 + 2] * rstd * kg[2], o[mt][4 * q4 + 3] * rstd * kg[3]) : 0u;
                        *(v2u*)(dst + d0) = ov; }
            } else {
                bf16* dst = WSP(bf16, WS_VC) + (size_t)bg * HD * NCMPP + n;
#pragma unroll
                for (int mt = 0; mt < 2; ++mt)
#pragma unroll
                    for (int i = 0; i < 16; ++i) { const int dd = 32 * mt + (i & 3) + 8 * (i >> 2) + 4 * hh; dst[(size_t)dd * NCMPP] = okn ? (bf16)f2bf(o[mt][i]) : (bf16)0; }
            }
        }
    }
    __syncthreads();
}
__device__ __forceinline__ void mixnorm_row(const bf16* PROJ, bf16* MIX, const float (&g1)[8], const float (&g2)[8], size_t m, int lane) {
    const bf16* p = PROJ + m * NPROJ;
    const v4u w1 = *(const v4u*)(p + C_LG + 8 * lane), w2 = *(const v4u*)(p + C_Q + 8 * lane);
    float a[8] = {bflo(w1.x), bfhi(w1.x), bflo(w1.y), bfhi(w1.y), bflo(w1.z), bfhi(w1.z), bflo(w1.w), bfhi(w1.w)};
    float c[8] = {bflo(w2.x), bfhi(w2.x), bflo(w2.y), bfhi(w2.y), bflo(w2.z), bfhi(w2.z), bflo(w2.w), bfhi(w2.w)};
    float sa = 0.f, sc = 0.f;
#pragma unroll
    for (int j = 0; j < 8; ++j) { sa += a[j] * a[j]; sc += c[j] * c[j]; }
    const float ra = 1.0f / sqrtf(wave_sum(sa) * (1.f / 512.f) + RMS_EPS), rc = 1.0f / sqrtf(wave_sum(sc) * (1.f / 512.f) + RMS_EPS);
    v4u o1, o2;
    o1.x = pk2(a[0] * ra * g1[0], a[1] * ra * g1[1]); o1.y = pk2(a[2] * ra * g1[2], a[3] * ra * g1[3]); o1.z = pk2(a[4] * ra * g1[4], a[5] * ra * g1[5]); o1.w = pk2(a[6] * ra * g1[6], a[7] * ra * g1[7]);
    o2.x = pk2(c[0] * rc * g2[0], c[1] * rc * g2[1]); o2.y = pk2(c[2] * rc * g2[2], c[3] * rc * g2[3]); o2.z = pk2(c[4] * rc * g2[4], c[5] * rc * g2[5]); o2.w = pk2(c[6] * rc * g2[6], c[7] * rc * g2[7]);
    *(v4u*)(MIX + m * D + 8 * lane) = o1; *(v4u*)(MIX + m * D + 512 + 8 * lane) = o2;
}
constexpr int LRU_XC_LD = 72;
template <int PASS>
__device__ __forceinline__ void lru_chunks(Ctx& C, int l) {
    const float* const conv_w = INP(4);
    const float* const conv_b = INP(5);
    const float* const lru_wa = INP(6);
    const float* const lru_ba = INP(7);
    const float* const lru_wx = INP(8);
    const float* const lru_bx = INP(9);
    const float* const lru_lambda = INP(10);
    bf16* PROJ = WSP(bf16, WS_PROJ); float* AGGA = WSP(float, WS_AGGA); float* AGGH = WSP(float, WS_AGGH); const float* HIN = WSP(float, WS_HIN);
    const int lane = C.lane, h = C.wave, d = h * 64 + lane, hh = lane >> 5, cl = lane & 31;
    LAS bf16* XC = (LAS bf16*)(C.lds + h * (64 * LRU_XC_LD * 2));
    LAS bf16* GT = (LAS bf16*)(C.lds + 8 * (64 * LRU_XC_LD * 2) + h * (64 * LRU_XC_LD * 2));
    abf16x8 Wa[2][4], Wx[2][4];
#pragma unroll
    for (int nt = 0; nt < 2; ++nt)
#pragma unroll
        for (int ks = 0; ks < 4; ++ks) {
            const float* pa = lru_wa + ((size_t)(l * 8 + h) * 64 + 16 * ks + 8 * hh) * 64 + 32 * nt + cl; const float* px = lru_wx + ((size_t)(l * 8 + h) * 64 + 16 * ks + 8 * hh) * 64 + 32 * nt + cl;
            v4u a, x; a.x = pk2(pa[0], pa[64]); a.y = pk2(pa[128], pa[192]); a.z = pk2(pa[256], pa[320]); a.w = pk2(pa[384], pa[448]);
            x.x = pk2(px[0], px[64]); x.y = pk2(px[128], px[192]); x.z = pk2(px[256], px[320]); x.w = pk2(px[384], px[448]);
            Wa[nt][ks] = __builtin_bit_cast(abf16x8, a); Wx[nt][ks] = __builtin_bit_cast(abf16x8, x);
        }
    float ba[2], bx[2], c8[2];
#pragma unroll
    for (int nt = 0; nt < 2; ++nt) { const int ch = l * D_LRU + h * 64 + 32 * nt + cl; ba[nt] = lru_ba[ch]; bx[nt] = lru_bx[ch]; c8[nt] = -8.0f * log1pf(__expf(-lru_lambda[ch])); }
    const float cw0 = conv_w[(l * 4 + 0) * D_LRU + d], cw1 = conv_w[(l * 4 + 1) * D_LRU + d], cw2 = conv_w[(l * 4 + 2) * D_LRU + d], cw3 = conv_w[(l * 4 + 3) * D_LRU + d];
    const float cb = conv_b[l * D_LRU + d];
    for (int u = C.bid; u < BATCH * NCHUNK; u += C.G) {
        const int b = u / NCHUNK, ch = u % NCHUNK, t0 = ch * LCH;
        {
            const bf16* xp = PROJ + (size_t)(b * SEQ + t0) * NPROJ + C_LX + d;
            float xm3 = 0.f, xm2 = 0.f, xm1 = 0.f;
            if (t0 > 0) { xm3 = bf2f(xp[-3 * NPROJ]); xm2 = bf2f(xp[-2 * NPROJ]); xm1 = bf2f(xp[-1 * NPROJ]); }
#pragma unroll
            for (int t32 = 0; t32 < LCH; t32 += 32) {
                unsigned xr[32], gr[PASS == 2 ? 32 : 1];
#pragma unroll
                for (int tt = 0; tt < 32; ++tt) { xr[tt] = (unsigned)xp[(size_t)(t32 + tt) * NPROJ]; if (PASS == 2) gr[tt] = (unsigned)xp[(size_t)(t32 + tt) * NPROJ + (C_LG - C_LX)]; }
                asm volatile("" ::: "memory");
#pragma unroll
                for (int tt = 0; tt < 32; ++tt) {
                    const float x0 = __uint_as_float(xr[tt] << 16);
                    if (PASS == 2) GT[(t32 + tt) * LRU_XC_LD + lane] = (bf16)gr[tt];
                    const float xc = cw0 * xm3 + cw1 * xm2 + cw2 * xm1 + cw3 * x0 + cb;
                    xm3 = xm2; xm2 = xm1; xm1 = x0;
                    XC[(t32 + tt) * LRU_XC_LD + lane] = (bf16)f2bf(xc);
                }
                asm volatile("" ::: "memory");
            }
        }
        float st[2], ap[2];
#pragma unroll
        for (int nt = 0; nt < 2; ++nt) { st[nt] = (PASS == 2) ? HIN[(size_t)(b * NCHUNK + ch) * D_LRU + h * 64 + 32 * nt + cl] : 0.f; ap[nt] = 1.f; }
        bf16* gbase = PROJ + (size_t)(b * SEQ + t0) * NPROJ + C_LG + h * 64;
#pragma unroll 1
        for (int mt = 0; mt < 2; ++mt) {
            const int goff = (32 * mt + 4 * hh) * NPROJ + cl;
            abf16x8 af[4];
#pragma unroll
            for (int ks = 0; ks < 4; ++ks) af[ks] = *(const LAS abf16x8*)(XC + (32 * mt + cl) * LRU_XC_LD + 16 * ks + 8 * hh);
#pragma unroll
            for (int nt = 0; nt < 2; ++nt) {
                f32x16 R, I;
#pragma unroll
                for (int i = 0; i < 16; ++i) { R[i] = 0.f; I[i] = 0.f; }
#pragma unroll
                for (int ks = 0; ks < 4; ++ks) { R = __builtin_amdgcn_mfma_f32_32x32x16_bf16(af[ks], Wa[nt][ks], R, 0, 0, 0); I = __builtin_amdgcn_mfma_f32_32x32x16_bf16(af[ks], Wx[nt][ks], I, 0, 0, 0); }
                float a[16], uu[16];
#pragma unroll
                for (int i = 0; i < 16; ++i) {
                    const int tok = 32 * mt + (i & 3) + 8 * (i >> 2) + 4 * hh;
                    const float xc = bf2f(XC[tok * LRU_XC_LD + 32 * nt + cl]);
                    const float r = __builtin_amdgcn_rcpf(1.0f + __builtin_amdgcn_exp2f(-1.44269504089f * (R[i] + ba[nt])));
                    const float ig = __builtin_amdgcn_rcpf(1.0f + __builtin_amdgcn_exp2f(-1.44269504089f * (I[i] + bx[nt])));
                    const float av = __builtin_amdgcn_exp2f(1.44269504089f * c8[nt] * r);
                    a[i] = av; uu[i] = __builtin_amdgcn_sqrtf(fmaxf(1.0f - av * av, 0.f)) * (ig * xc);
                }
                float Ak[4], Uk[4], pA[4], pU[4], cin[4];
#pragma unroll
                for (int k = 0; k < 4; ++k) { Ak[k] = (a[4 * k] * a[4 * k + 1]) * (a[4 * k + 2] * a[4 * k + 3]); float v = uu[4 * k]; v = a[4 * k + 1] * v + uu[4 * k + 1]; v = a[4 * k + 2] * v + uu[4 * k + 2]; v = a[4 * k + 3] * v + uu[4 * k + 3]; Uk[k] = v; }
#pragma unroll
                for (int k = 0; k < 4; ++k) { pA[k] = __shfl_xor(Ak[k], 32); pU[k] = __shfl_xor(Uk[k], 32); }
                float s = st[nt];
#pragma unroll
                for (int k = 0; k < 4; ++k) {
                    const float A0 = hh ? pA[k] : Ak[k], U0 = hh ? pU[k] : Uk[k], A1 = hh ? Ak[k] : pA[k], U1 = hh ? Uk[k] : pU[k];
                    const float mid = A0 * s + U0;
                    cin[k] = hh ? mid : s;
                    s = A1 * mid + U1;
                    ap[nt] *= A0 * A1;
                }
                st[nt] = s;
                if (PASS == 2) {
#pragma unroll
                    for (int k = 0; k < 4; ++k) { float v = cin[k];
#pragma unroll
                        for (int j = 0; j < 4; ++j) { const int i = 4 * k + j; v = a[i] * v + uu[i];
                            const int gi = goff + (j + 8 * k) * NPROJ + 32 * nt;
                            const float gt = bf2f(GT[(32 * mt + j + 8 * k + 4 * hh) * LRU_XC_LD + 32 * nt + cl]); const bf16 yb = (bf16)f2bf(gelu_tanh(gt) * v); gbase[gi] = yb;
                            XC[(32 * mt + j + 8 * k + 4 * hh) * LRU_XC_LD + 32 * nt + cl] = yb; }
                        asm volatile("" ::: "memory"); }
                }
            }
        }
        if (PASS == 1) {
#pragma unroll
            for (int nt = 0; nt < 2; ++nt) { AGGA[(size_t)(b * NCHUNK + ch) * D_LRU + h * 64 + 32 * nt + cl] = ap[nt]; AGGH[(size_t)(b * NCHUNK + ch) * D_LRU + h * 64 + 32 * nt + cl] = st[nt]; }
        } else {
            { const LAS v4u* xr = (const LAS v4u*)(XC + lane * LRU_XC_LD); float ss = 0.f;
#pragma unroll
              for (int c8 = 0; c8 < 8; ++c8) { const v4u q = xr[c8]; ss += (bflo(q.x) * bflo(q.x) + bfhi(q.x) * bfhi(q.x)) + (bflo(q.y) * bflo(q.y) + bfhi(q.y) * bfhi(q.y)) + (bflo(q.z) * bflo(q.z) + bfhi(q.z) * bfhi(q.z)) + (bflo(q.w) * bflo(q.w) + bfhi(q.w) * bfhi(q.w)); }
              WSP(float, WS_SSQL)[((size_t)b * SEQ + t0 + lane) * 8 + h] = ss; }
        }
    }
}
__device__ __forceinline__ void lru_carry(Ctx& C) {
    const float* __restrict__ AGGA = WSP(float, WS_AGGA); const float* __restrict__ AGGH = WSP(float, WS_AGGH); float* __restrict__ HIN = WSP(float, WS_HIN);
    const int gt = C.bid * NTHR + C.tid;
    if (gt < BATCH * D_LRU) {
        const int b = gt / D_LRU, d = gt % D_LRU; float hs = 0.f;
        for (int c0 = 0; c0 < NCHUNK; c0 += 16) {
            float a[16], hh[16];
#pragma unroll
            for (int i = 0; i < 16; ++i) { a[i] = AGGA[(size_t)(b * NCHUNK + c0 + i) * D_LRU + d]; hh[i] = AGGH[(size_t)(b * NCHUNK + c0 + i) * D_LRU + d]; }
#pragma unroll
            for (int i = 0; i < 16; ++i) { HIN[(size_t)(b * NCHUNK + c0 + i) * D_LRU + d] = hs; hs = a[i] * hs + hh[i]; }
        }
    }
}

constexpr int ATT_KB = 0, ATT_VB = 32768, ATT_CK = 0, ATT_CV = 8192, ATT_IMP = 16384, ATT_IMP_LD = 132, ATT_OACC = 65536, ATT_OACC_LD = 65,
              ATT_L = ATT_OACC + 256 * ATT_OACC_LD * 4, ATT_LIST = ATT_L + 1024, ATT_CNT = ATT_LIST + 128 * 64, ATT_M2F = ATT_CNT + 512, ATT_M2R = ATT_M2F + 1024, ATT_END1 = ATT_M2R + 1024,
              ATT_BT = ATT_IMP + 256 * ATT_IMP_LD * 4, ATT_SELM = ATT_BT + 4 * 128 * 4, ATT_RL = ATT_SELM + 64 * 16, ATT_END = ATT_RL + 1024;
static_assert(ATT_END1 <= ATT_BT, "att lds overlay");
static_assert(ATT_END <= MISC_OFF, "att lds");
template <int CTRL> __device__ __forceinline__ unsigned dpp_u(unsigned v) { return (unsigned)__builtin_amdgcn_update_dpp((int)v, (int)v, CTRL, 0xF, 0xF, false); }
template <int CTRL> __device__ __forceinline__ float dpp_f(float v) { return __int_as_float(__builtin_amdgcn_update_dpp(__float_as_int(v), __float_as_int(v), CTRL, 0xF, 0xF, false)); }
__device__ __forceinline__ float quad_sum(float v) { v += dpp_f<0xB1>(v); v += dpp_f<0x4E>(v); return v; }
__device__ __forceinline__ unsigned row16_max(unsigned v) { unsigned t; t = dpp_u<0x128>(v); v = v > t ? v : t; t = dpp_u<0x124>(v); v = v > t ? v : t; t = dpp_u<0x122>(v); v = v > t ? v : t; t = dpp_u<0x121>(v); v = v > t ? v : t; return v; }
__device__ __forceinline__ unsigned row16_or(unsigned v) { v |= dpp_u<0x128>(v); v |= dpp_u<0x124>(v); v |= dpp_u<0x122>(v); v |= dpp_u<0x121>(v); return v; }

struct AttLane {
    int t, h, hl, tokl;
    unsigned koff0, voff0;
    const LAS float* btl;
};
#define BZ_PIN(b) asm volatile("" : "+v"(b[0]), "+v"(b[1]), "+v"(b[2]), "+v"(b[3]), "+v"(b[4]), "+v"(b[5]), "+v"(b[6]), "+v"(b[7]), "+v"(b[8]), "+v"(b[9]), "+v"(b[10]), "+v"(b[11]), "+v"(b[12]), "+v"(b[13]), "+v"(b[14]), "+v"(b[15]))
__device__ __forceinline__ void att_qk(const LAS unsigned char* Kb, const abf16x8 (&Qf)[4], const AttLane& A, f32x16& S0, f32x16& S1) {
    const f32x16 z = {0.f, 0.f, 0.f, 0.f, 0.f, 0.f, 0.f, 0.f, 0.f, 0.f, 0.f, 0.f, 0.f, 0.f, 0.f, 0.f};
    abf16x8 a0[4], a1[4];
#pragma unroll
    for (int ks = 0; ks < 4; ++ks) { a0[ks] = *(const LAS abf16x8*)(Kb + (A.koff0 ^ ((unsigned)(ks) << 5))); a1[ks] = *(const LAS abf16x8*)(Kb + 4096 + (A.koff0 ^ ((unsigned)(ks) << 5))); }
    S0 = __builtin_amdgcn_mfma_f32_32x32x16_bf16(a0[0], Qf[0], z, 0, 0, 0); S1 = __builtin_amdgcn_mfma_f32_32x32x16_bf16(a1[0], Qf[0], z, 0, 0, 0);
#pragma unroll
    for (int ks = 1; ks < 4; ++ks) { S0 = __builtin_amdgcn_mfma_f32_32x32x16_bf16(a0[ks], Qf[ks], S0, 0, 0, 0); S1 = __builtin_amdgcn_mfma_f32_32x32x16_bf16(a1[ks], Qf[ks], S1, 0, 0, 0); }
}
template <bool SLOW, bool WIN, int MODE>
__device__ __forceinline__ void att_sm(const f32x16& S0, const f32x16& S1, const AttLane& A, unsigned (&Pk)[2][8], float& lsum, const float m2, const int kp0, const int kstride, LAS float* improw, const int gbase, float& icar) {
    const float c1 = 1.44269504089f;
    const int dbase = A.t - kp0 - kstride * 8 * A.h;
#pragma unroll
    for (int st = 0; st < 2; ++st) {
        float p[16];
        float bz[16];
        if (SLOW) {
#pragma unroll
            for (int i = 0; i < 16; ++i) { const int dist = dbase - kstride * (32 * st + 16 * (i >> 3) + (i & 7)); bz[i] = A.btl[dist < 0 ? 0 : (dist > 127 ? 127 : dist)]; }
            BZ_PIN(bz);
        }
#pragma unroll
        for (int i = 0; i < 16; ++i) {
            const float sv = st ? S1[i] : S0[i];
            if (SLOW) {
                const int dist = dbase - kstride * (32 * st + 16 * (i >> 3) + (i & 7));
                bool valid = dist >= 0; if (WIN) valid = valid && (dist < 512);
                const float x = (sv + bz[i]) * c1 - m2;
                const float e = __builtin_amdgcn_exp2f(x);
                p[i] = valid ? e : 0.f;
            } else {
                p[i] = __builtin_amdgcn_exp2f(sv * c1 - m2);
            }
            lsum += p[i];
        }
        if (MODE >= 1) {
#pragma unroll
            for (int i = 0; i < 8; ++i) Pk[st][i] = pg8::cvt_pk_bf16(p[2 * i], p[2 * i + 1]);
        }
        if (MODE == 3) {
            float a[4], c[4];
#pragma unroll
            for (int u = 0; u < 4; ++u) { c[u] = 0.5f * p[4 * u + 3]; a[u] = (p[4 * u] + p[4 * u + 1]) + (p[4 * u + 2] + c[u]); }
            const float pc1 = __shfl_xor(c[1], 32), pc3 = __shfl_xor(c[3], 32);
            typedef float f32x2s __attribute__((ext_vector_type(2)));
            f32x2s w0, w1; w0.x = a[0] + (A.h ? pc1 : icar); w0.y = a[1] + c[0]; w1.x = a[2] + (A.h ? pc3 : pc1); w1.y = a[3] + c[2];
            icar = pc3;
            *(LAS f32x2s*)(improw + gbase + 8 * st) = w0; *(LAS f32x2s*)(improw + gbase + 8 * st + 4) = w1;
        }
        if (MODE == 2) {
#pragma unroll
            for (int u = 0; u < 4; ++u) {
                const float c = 0.5f * p[4 * u + 3];
                const float a = quad_sum((p[4 * u] + p[4 * u + 1]) + (p[4 * u + 2] + c)); const float cs = quad_sum(c);
                const int G = gbase + 8 * st + 4 * (u >> 1) + (u & 1);
                if (A.hl == 0) { (void)__builtin_amdgcn_ds_faddf(improw + G, a, 0, 0, false); if (G + 1 < NSELB) (void)__builtin_amdgcn_ds_faddf(improw + G + 1, cs, 0, 0, false); }
            }
        }
    }
}
__device__ __forceinline__ void att_pv(const LAS unsigned char* Vb, const AttLane& A, const unsigned (&Pk)[2][8], f32x16 (&O)[2]) {
#pragma unroll
    for (int s4 = 0; s4 < 4; ++s4) {
        typedef unsigned u4v __attribute__((ext_vector_type(4)));
        u4v pw; pw.x = Pk[s4 >> 1][4 * (s4 & 1) + 0]; pw.y = Pk[s4 >> 1][4 * (s4 & 1) + 1]; pw.z = Pk[s4 >> 1][4 * (s4 & 1) + 2]; pw.w = Pk[s4 >> 1][4 * (s4 & 1) + 3];
        const abf16x8 pb = __builtin_bit_cast(abf16x8, pw);
        const abf16x8 v0 = *(const LAS abf16x8*)(Vb + (A.voff0 ^ ((unsigned)(s4) << 5))); const abf16x8 v1 = *(const LAS abf16x8*)(Vb + 4096 + (A.voff0 ^ ((unsigned)(s4) << 5)));
        O[0] = __builtin_amdgcn_mfma_f32_32x32x16_bf16(v0, pb, O[0], 0, 0, 0); O[1] = __builtin_amdgcn_mfma_f32_32x32x16_bf16(v1, pb, O[1], 0, 0, 0);
    }
}
__device__ __forceinline__ void att_qk_half(const LAS unsigned char* Kb, const int st, const abf16x8 (&Qf)[4], const AttLane& A, f32x16& S) {
    const f32x16 z = {0.f, 0.f, 0.f, 0.f, 0.f, 0.f, 0.f, 0.f, 0.f, 0.f, 0.f, 0.f, 0.f, 0.f, 0.f, 0.f};
    abf16x8 a[4];
#pragma unroll
    for (int ks = 0; ks < 4; ++ks) a[ks] = *(const LAS abf16x8*)(Kb + st * 4096 + (A.koff0 ^ ((unsigned)(ks) << 5)));
    S = __builtin_amdgcn_mfma_f32_32x32x16_bf16(a[0], Qf[0], z, 0, 0, 0);
#pragma unroll
    for (int ks = 1; ks < 4; ++ks) S = __builtin_amdgcn_mfma_f32_32x32x16_bf16(a[ks], Qf[ks], S, 0, 0, 0);
}
template <bool SLOW, bool WIN>
__device__ __forceinline__ void att_sm_half(const f32x16& S, const int st, const AttLane& A, unsigned (&Pk)[8], float& lsum, const float m2, const int kp0) {
    const float c1 = 1.44269504089f;
    const int dbase = A.t - kp0 - 8 * A.h - 32 * st;
    float p[16];
    float bz[16];
    if (SLOW) {
#pragma unroll
        for (int i = 0; i < 16; ++i) { const int dist = dbase - (16 * (i >> 3) + (i & 7)); bz[i] = A.btl[dist < 0 ? 0 : (dist > 127 ? 127 : dist)]; }
        BZ_PIN(bz);
    }
#pragma unroll
    for (int i = 0; i < 16; ++i) {
        if (SLOW) {
            const int dist = dbase - (16 * (i >> 3) + (i & 7));
            const float e = __builtin_amdgcn_exp2f((S[i] + bz[i]) * c1 - m2);
            bool valid = dist >= 0; if (WIN) valid = valid && (dist < 512);
            p[i] = valid ? e : 0.f;
        } else p[i] = __builtin_amdgcn_exp2f(S[i] * c1 - m2);
        lsum += p[i];
    }
#pragma unroll
    for (int i = 0; i < 8; ++i) Pk[i] = pg8::cvt_pk_bf16(p[2 * i], p[2 * i + 1]);
}
template <bool ZERO = false>
__device__ __forceinline__ void att_pv_half(const LAS unsigned char* Vb, const int st, const AttLane& A, const unsigned (&Pk)[8], f32x16 (&O)[2]) {
    const f32x16 z = {0.f, 0.f, 0.f, 0.f, 0.f, 0.f, 0.f, 0.f, 0.f, 0.f, 0.f, 0.f, 0.f, 0.f, 0.f, 0.f};
#pragma unroll
    for (int u = 0; u < 2; ++u) {
        typedef unsigned u4v __attribute__((ext_vector_type(4)));
        u4v pw; pw.x = Pk[4 * u + 0]; pw.y = Pk[4 * u + 1]; pw.z = Pk[4 * u + 2]; pw.w = Pk[4 * u + 3];
        const abf16x8 pb = __builtin_bit_cast(abf16x8, pw);
        const abf16x8 v0 = *(const LAS abf16x8*)(Vb + (A.voff0 ^ ((unsigned)(2 * st + u) << 5))); const abf16x8 v1 = *(const LAS abf16x8*)(Vb + 4096 + (A.voff0 ^ ((unsigned)(2 * st + u) << 5)));
        O[0] = __builtin_amdgcn_mfma_f32_32x32x16_bf16(v0, pb, (ZERO && u == 0) ? z : O[0], 0, 0, 0); O[1] = __builtin_amdgcn_mfma_f32_32x32x16_bf16(v1, pb, (ZERO && u == 0) ? z : O[1], 0, 0, 0);
    }
}
template <bool SLOW, bool WIN, int MODE>
__device__ __forceinline__ void att_block(const LAS unsigned char* Kb, const LAS unsigned char* Vb, const abf16x8 (&Qf)[4], const AttLane& A, f32x16 (&O)[2], float& lsum, const float m2,
                                          const int kp0, const int kstride, LAS float* improw, const int gbase, float& icar) {
    f32x16 S0, S1; unsigned Pk[2][8];
    att_qk(Kb, Qf, A, S0, S1);
    att_sm<SLOW, WIN, MODE>(S0, S1, A, Pk, lsum, m2, kp0, kstride, improw, gbase, icar);
    if (MODE >= 1) att_pv(Vb, A, Pk, O);
}
struct AttStage { v4u k, v; };
__device__ __forceinline__ void att_fetch_k(AttStage& R, const bf16* Kg, int tid) { const int r = tid >> 3, c = tid & 7; R.k = *(const v4u*)(Kg + (size_t)r * HD + c * 8); }
__device__ __forceinline__ void att_fetch_v(AttStage& R, const bf16* VTg, int ldv, int tid) { const int r = tid >> 3, c = tid & 7; R.v = *(const v4u*)(VTg + (size_t)r * ldv + c * 8); }
__device__ __forceinline__ void att_put_k(const AttStage& R, LAS unsigned char* lds, int buf, int tid) { const int r = tid >> 3, c = tid & 7; *(LAS v4u*)(lds + ATT_KB + buf * 8192 + (r * 8 + (c ^ ((r >> 1) & 7))) * 16) = R.k; }
__device__ __forceinline__ void att_put_v(const AttStage& R, LAS unsigned char* lds, int buf, int tid) { const int r = tid >> 3, c = tid & 7; *(LAS v4u*)(lds + ATT_VB + buf * 8192 + (r * 8 + (c ^ ((r >> 1) & 7))) * 16) = R.v; }
__device__ __forceinline__ void att_put_c(const AttStage& R, LAS unsigned char* lds, int tid) { const int r = tid >> 3, c = tid & 7; const int o = (r * 8 + (c ^ ((r >> 1) & 7))) * 16;
    *(LAS v4u*)(lds + ATT_CK + o) = R.k; *(LAS v4u*)(lds + ATT_CV + o) = R.v; }
__device__ __forceinline__ void att_fetch(AttStage& R, const bf16* Kg, const bf16* VTg, int ldv, int tid) { att_fetch_k(R, Kg, tid); att_fetch_v(R, VTg, ldv, tid); }
__device__ __forceinline__ void att_put(const AttStage& R, LAS unsigned char* lds, int buf, int tid) { att_put_k(R, lds, buf, tid); att_put_v(R, lds, buf, tid); }
__device__ __forceinline__ void att_dma(const bf16* g, const int pitch, LAS unsigned char* dstw, const int tid) {
    const int r = tid >> 3, c = (tid & 7) ^ ((r >> 1) & 7);
    __builtin_amdgcn_global_load_lds((const unsigned*)(g + (size_t)r * pitch + c * 8), (LAS unsigned*)dstw, 16, 0, 0);
}
template <bool SLOW, bool WIN>
__device__ __forceinline__ void att_pipe_iter(LAS unsigned char* lds, const bf16* kg, const bf16* vg, const int i, const int j, const int jk, const int jv, const bool sel, const int wv,
                                              const abf16x8 (&Qf)[4], const AttLane& A, f32x16& S0, f32x16& S1, f32x16 (&O)[2], float& ls, const float m2, const int tid) {
    att_dma(kg + (size_t)jk * 64 * HD, HD, lds + ATT_KB + ((i + 3) & 3) * 8192 + wv * 1024, tid);
    att_dma(vg + jv * 64, SEQ, lds + ATT_VB + ((i + 2) % 3) * 8192 + wv * 1024, tid);
    const LAS unsigned char* Kc = lds + ATT_KB + (i & 3) * 8192; const LAS unsigned char* Kn = lds + ATT_KB + ((i + 1) & 3) * 8192; const LAS unsigned char* Vb = lds + ATT_VB + (i % 3) * 8192;
    if (__ballot(sel) != 0ull) {
        unsigned Pk0[8], Pk1[8];
        att_qk_half(Kc, 1, Qf, A, S1);
        att_sm_half<SLOW, WIN>(S0, 0, A, Pk0, ls, m2, 64 * j);
        __builtin_amdgcn_sched_barrier(0);
        att_qk_half(Kn, 0, Qf, A, S0);
        att_pv_half(Vb, 0, A, Pk0, O);
        att_sm_half<SLOW, WIN>(S1, 1, A, Pk1, ls, m2, 64 * j);
        att_pv_half(Vb, 1, A, Pk1, O);
    } else {
        att_qk_half(Kn, 0, Qf, A, S0);
    }
    asm volatile("s_waitcnt vmcnt(2)" ::: "memory");
    __builtin_amdgcn_s_barrier();
    asm volatile("" ::: "memory");
}
__device__ __forceinline__ void att_pipe_start(LAS unsigned char* lds, const bf16* kg, const bf16* vg, const int j0, const int j1, const int j2, const int wv, const abf16x8 (&Qf)[4], const AttLane& A, f32x16& S0, const int tid) {
    att_dma(kg + (size_t)j0 * 64 * HD, HD, lds + ATT_KB + 0 * 8192 + wv * 1024, tid); att_dma(vg + j0 * 64, SEQ, lds + ATT_VB + 0 * 8192 + wv * 1024, tid);
    att_dma(kg + (size_t)j1 * 64 * HD, HD, lds + ATT_KB + 1 * 8192 + wv * 1024, tid); att_dma(vg + j1 * 64, SEQ, lds + ATT_VB + 1 * 8192 + wv * 1024, tid);
    att_dma(kg + (size_t)j2 * 64 * HD, HD, lds + ATT_KB + 2 * 8192 + wv * 1024, tid);
    asm volatile("s_waitcnt vmcnt(0)" ::: "memory");
    __builtin_amdgcn_s_barrier();
    asm volatile("" ::: "memory");
    att_qk_half(lds + ATT_KB, 0, Qf, A, S0);
}
template <bool SLOW>
__device__ __forceinline__ void att_visit(const LAS unsigned char* Kb, const LAS unsigned char* Vb, const bf16* QNb, const int j, const int qi, const int grp, const int cnt,
                                          const LAS unsigned char* list, const LAS float* M2, LAS float* Oacc, LAS float* Lacc, const AttLane& A0, const int lane) {
    AttLane A = A0;
    const int sl = 8 * grp + ((lane & 31) >> 2); const bool valid = sl < cnt;
    const int tok = valid ? (int)list[sl] : 0; const int row = tok * 4 + A.hl;
    abf16x8 Qf[4];
#pragma unroll
    for (int ks = 0; ks < 4; ++ks) Qf[ks] = __builtin_bit_cast(abf16x8, *(const v4u*)(QNb + (size_t)tok * 512 + A.hl * HD + 16 * ks + 8 * A.h));
    const float m2 = valid ? M2[row] : 3.0e38f;
    A.t = qi * 64 + tok;
    f32x16 S0, S1, O[2]; unsigned Pk0[8], Pk1[8]; float ls = 0.f;
    att_qk_half(Kb, 0, Qf, A, S0); att_qk_half(Kb, 1, Qf, A, S1);
    att_sm_half<SLOW, false>(S0, 0, A, Pk0, ls, m2, 64 * j);
    att_pv_half<true>(Vb, 0, A, Pk0, O);
    att_sm_half<SLOW, false>(S1, 1, A, Pk1, ls, m2, 64 * j);
    att_pv_half<false>(Vb, 1, A, Pk1, O);
    ls += __shfl_xor(ls, 32);
    if (valid) {
        if (A.h == 0) (void)__hip_atomic_fetch_add((LAS int*)Lacc + row, __float2int_rn(ls * 1048576.0f), __ATOMIC_RELAXED, __HIP_MEMORY_SCOPE_WORKGROUP);
        LAS int* op = (LAS int*)Oacc + row * ATT_OACC_LD + 4 * A.h;
#pragma unroll
        for (int mt = 0; mt < 2; ++mt)
#pragma unroll
            for (int q = 0; q < 4; ++q) {
#pragma unroll
                for (int e = 0; e < 4; ++e) (void)__hip_atomic_fetch_add(op + 32 * mt + e + 8 * q, __float2int_rn(O[mt][4 * q + e] * 1048576.0f), __ATOMIC_RELAXED, __HIP_MEMORY_SCOPE_WORKGROUP);
                __builtin_amdgcn_sched_barrier(0); }
    }
}
__device__ __forceinline__ void phase_att(Ctx& C, int l) {
    const float* const gate_b = INP(16);
    const float* const k_norm_g = INP(12);
    bf16* PROJ = WSP(bf16, WS_PROJ); const bf16* QN = WSP(bf16, WS_QN); const bf16* KSN = WSP(bf16, WS_KSN); const bf16* KWN = WSP(bf16, WS_KWN);
    const bf16* VST = WSP(bf16, WS_VST); const bf16* VWT = WSP(bf16, WS_VWT); const bf16* KC = WSP(bf16, WS_KC); const bf16* VCT = WSP(bf16, WS_VC); const float* BT = WSP(float, WS_TAB);
    LAS unsigned char* lds = C.lds;
    LAS float* IMP = (LAS float*)(lds + ATT_IMP); LAS float* BTL = (LAS float*)(lds + ATT_BT); LAS unsigned* SELM = (LAS unsigned*)(lds + ATT_SELM);
    const int tid = C.tid, lane = C.lane, w = C.wave;
    const float c1 = 1.44269504089f;
    AttLane A; A.h = lane >> 5; A.hl = lane & 3; A.tokl = 8 * w + ((lane & 31) >> 2);
    { const int rho = lane & 31; const int key0 = (rho & 19) | ((rho & 4) << 1) | ((rho & 8) >> 1);
      const int fk = (key0 >> 1) & 7, fv = (rho >> 1) & 7;
#pragma unroll
      for (int s = 0; s < 1; ++s) { A.koff0 = (unsigned)(key0 * 128 + ((A.h ^ fk) << 4)); A.voff0 = (unsigned)(rho * 128 + ((A.h ^ fv) << 4)); } }
    A.btl = BTL + A.hl * 128;
    float kn; { float v = fabsf(k_norm_g[l * HD + lane]);
#pragma unroll
      for (int o = 1; o < 64; o <<= 1) v = fmaxf(v, __shfl_xor(v, o)); kn = 8.0f * 1.01f * v; }
    for (int slot = C.bid; slot < 1024; slot += C.G) {
        const int rr = slot >> 8, k32 = (slot & 255) >> 3, bg = slot & 7, b = bg >> 1, g = bg & 1;
        const int qi = (rr == 0) ? 127 - k32 : (rr == 1) ? 64 + k32 : (rr == 2) ? 63 - k32 : k32;
        const int head = g * HPG + A.hl; A.t = qi * 64 + A.tokl;
        bf16* const Pu = PROJ + ((size_t)b * SEQ + 64 * qi) * NPROJ; const bf16* const Qu = QN + ((size_t)b * SEQ + 64 * qi) * 512;
        const int pofs = A.tokl * NPROJ, qofs = A.tokl * 512 + head * HD + 8 * A.h;
        float* const finu = WSP(float, WS_FIN) + (size_t)C.bid * (512 * 32);
        __syncthreads();
        int tidq = tid; asm volatile("" : "+v"(tidq));
        BTL[tid] = BT[(g * HPG + (tid >> 7)) * 128 + (tid & 127)];
        abf16x8 Qf[4]; float qn2 = 0.f;
#pragma unroll
        for (int ks = 0; ks < 4; ++ks) { const v4u wq = *(const v4u*)(Qu + qofs + 16 * ks); Qf[ks] = __builtin_bit_cast(abf16x8, wq);
            qn2 += bflo(wq.x) * bflo(wq.x) + bfhi(wq.x) * bfhi(wq.x) + bflo(wq.y) * bflo(wq.y) + bfhi(wq.y) * bfhi(wq.y) + bflo(wq.z) * bflo(wq.z) + bfhi(wq.z) * bfhi(wq.z) + bflo(wq.w) * bflo(wq.w) + bfhi(wq.w) * bfhi(wq.w); }
        qn2 += __shfl_xor(qn2, 32);
        const float bmax = BT[NH * 128 + head];
        const float b31 = BT[head * 128 + 127];
        const float m2ref = (sqrtf(qn2) * kn + bmax) * c1;
        const float m2far = m2ref - b31 * c1;
        f32x16 O[2];
        AttStage R;
        const int nkb = (4 * qi + 3 + 63) >> 6;
        const bf16* kcg = KC + (size_t)bg * NCMPP * HD; const bf16* vcg = VCT + (size_t)bg * HD * NCMPP;
        float lc = 0.f;
#pragma unroll
        for (int i = 0; i < 16; ++i) { O[0][i] = 0.f; O[1][i] = 0.f; }
        float icar = 0.f;
        int rowq = A.tokl * 4 + A.hl; asm volatile("" : "+v"(rowq));
        LAS float* improw = IMP + rowq * ATT_IMP_LD;
        att_fetch(R, kcg, vcg, NCMPP, tidq);
        for (int kb = 0; kb < nkb; ++kb) {
            att_put_c(R, lds, tidq); __syncthreads();
            if (kb + 1 < nkb) att_fetch(R, kcg + (size_t)(kb + 1) * 64 * HD, vcg + (kb + 1) * 64, NCMPP, tidq);
            if (qi >= 16 * kb + 18) att_block<false, false, 3>(lds + ATT_CK, lds + ATT_CV, Qf, A, O, lc, m2far, 0, 0, improw, 16 * kb + 2 * A.h, icar);
            else att_block<true, false, 3>(lds + ATT_CK, lds + ATT_CV, Qf, A, O, lc, m2ref, 1024 * kb + 31, 16, improw, 16 * kb + 2 * A.h, icar);
            __syncthreads();
        }
        lc += __shfl_xor(lc, 32);
        const float rl = lc > 0.f ? 1.0f / lc : 0.f;
        if (A.h == 0) ((LAS float*)(lds + ATT_RL))[rowq] = rl;
#pragma unroll
        for (int q = 0; q < 4; ++q) { f32x4* fin = (f32x4*)(finu + tid * 32);
            const float gate0 = rl * sigmoid_f(bf2f(Pu[pofs + C_GT + 0 * NH + head]) + gate_b[l * 24 + 0 * NH + head]);
            fin[q] = (f32x4){gate0 * O[0][4 * q], gate0 * O[0][4 * q + 1], gate0 * O[0][4 * q + 2], gate0 * O[0][4 * q + 3]};
            fin[4 + q] = (f32x4){gate0 * O[1][4 * q], gate0 * O[1][4 * q + 1], gate0 * O[1][4 * q + 2], gate0 * O[1][4 * q + 3]}; }
        __builtin_amdgcn_fence(__ATOMIC_RELEASE, "wavefront"); __builtin_amdgcn_wave_barrier(); __builtin_amdgcn_fence(__ATOMIC_ACQUIRE, "wavefront"); asm volatile("" ::: "memory");
        if (qi < 16) { if ((lane & 3) == 0 && lane < 32) { LAS unsigned* sm = SELM + A.tokl * 4; sm[0] = (qi == 31) ? 0xffffffffu : ((2u << qi) - 1u); sm[1] = 0u; sm[2] = 0u; sm[3] = 0u; } }
        else {
            for (int rd = 0; rd < 2; ++rd) {
                const int tk = 8 * w + 4 * rd + (lane >> 4), l16 = lane & 15; const LAS float* ir = IMP + tk * 4 * ATT_IMP_LD;
                const LAS float* rlp = (const LAS float*)(lds + ATT_RL) + tk * 4; const float r4[4] = {rlp[0], rlp[1], rlp[2], rlp[3]};
                unsigned key[8];
#pragma unroll
                for (int k = 0; k < 8; ++k) { const int j = l16 + 16 * k;
                    const unsigned bits = __float_as_uint((r4[0] * ir[j] + r4[1] * ir[ATT_IMP_LD + j]) + (r4[2] * ir[2 * ATT_IMP_LD + j] + r4[3] * ir[3 * ATT_IMP_LD + j]));
                    key[k] = (j < qi) ? ((bits & 0xFFFFFF80u) | (unsigned)(127 - j)) : 0u; }
                for (int it = 0; it < 15; ++it) {
                    unsigned mx = key[0];
#pragma unroll
                    for (int k = 1; k < 8; ++k) mx = key[k] > mx ? key[k] : mx;
                    mx = row16_max(mx);
#pragma unroll
                    for (int k = 0; k < 8; ++k) key[k] = (key[k] == mx) ? 0u : key[k];
                }
                unsigned mw[4];
#pragma unroll
                for (int wd = 0; wd < 4; ++wd) { const int j0 = l16 + 32 * wd, j1 = j0 + 16; unsigned v = 0u;
                    if (j0 < qi && key[2 * wd] == 0u) v |= 1u << l16; if (j1 < qi && key[2 * wd + 1] == 0u) v |= 1u << (l16 + 16); mw[wd] = row16_or(v); }
#pragma unroll
                for (int wd = 0; wd < 4; ++wd) mw[wd] |= ((qi >> 5) == wd) ? (1u << (qi & 31)) : 0u;
                if (l16 == 0) { LAS unsigned* sm = SELM + tk * 4; sm[0] = mw[0]; sm[1] = mw[1]; sm[2] = mw[2]; sm[3] = mw[3]; }
            }
        }
        {
            LAS float* Oacc = (LAS float*)(lds + ATT_OACC); LAS float* Lacc = (LAS float*)(lds + ATT_L); LAS unsigned char* LIST = lds + ATT_LIST; LAS int* CNTL = (LAS int*)(lds + ATT_CNT);
            LAS float* M2F = (LAS float*)(lds + ATT_M2F); LAS float* M2R = (LAS float*)(lds + ATT_M2R);
            const bf16* kg = KSN + (size_t)bg * SEQ * HD; const bf16* vg = VST + (size_t)bg * HD * SEQ;
            const bf16* QNb = QN + ((size_t)b * SEQ + 64 * qi) * 512 + g * HPG * HD;
            const int nfast = qi >= 2 ? qi - 2 : 0, nb = qi + 1, nch = (nb + 1) >> 1;
#define SLC_SEQ(i) ((i) >= nb ? qi : ((i) < nfast ? (i) : qi - ((i) - nfast)))
            __syncthreads();
            { const unsigned mw0 = SELM[lane * 4 + 0], mw1 = SELM[lane * 4 + 1], mw2 = SELM[lane * 4 + 2], mw3 = SELM[lane * 4 + 3];
              for (int j = w; j <= qi; j += 8) {
                  const int wd = j >> 5; const unsigned mwj = wd == 0 ? mw0 : wd == 1 ? mw1 : wd == 2 ? mw2 : mw3;
                  const bool bit = (mwj >> (j & 31)) & 1u; const unsigned long long mk = __ballot(bit);
                  const unsigned rank = __builtin_amdgcn_mbcnt_hi((unsigned)(mk >> 32), __builtin_amdgcn_mbcnt_lo((unsigned)mk, 0u));
                  if (bit) LIST[j * 64 + rank] = (unsigned char)lane;
                  if (lane == 0) CNTL[j] = __popcll(mk); } }
            if (A.h == 0) { M2F[rowq] = m2far; M2R[rowq] = m2ref; }
            for (int i = tid; i < 256 * ATT_OACC_LD + 256; i += NTHR) Oacc[i] = 0.f;
            asm volatile("s_waitcnt vmcnt(0)" ::: "memory"); __syncthreads();
            const int nch4 = (nb + 3) >> 2;
            for (int c = 0; c < nch4; ++c) {
#pragma unroll
                for (int q = 0; q < 4; ++q) { const int jq = SLC_SEQ(4 * c + q);
                    att_dma(kg + (size_t)jq * 64 * HD, HD, lds + ATT_KB + q * 8192 + w * 1024, tidq); att_dma(vg + jq * 64, SEQ, lds + ATT_VB + q * 8192 + w * 1024, tidq); }
                int jb[4], cb[4], nvb[4]; int tot = 0;
#pragma unroll
                for (int q = 0; q < 4; ++q) { jb[q] = SLC_SEQ(4 * c + q); cb[q] = (4 * c + q < nb) ? CNTL[jb[q]] : 0; nvb[q] = (cb[q] + 7) >> 3; tot += nvb[q]; }
                asm volatile("s_waitcnt vmcnt(0)" ::: "memory"); __syncthreads();
                for (int v = w; v < tot; v += 8) {
                    int q = 0, vv = v;
                    if (vv >= nvb[0]) { vv -= nvb[0]; q = 1; if (vv >= nvb[1]) { vv -= nvb[1]; q = 2; if (vv >= nvb[2]) { vv -= nvb[2]; q = 3; } } }
                    const int j = q == 0 ? jb[0] : q == 1 ? jb[1] : q == 2 ? jb[2] : jb[3]; const int cn = q == 0 ? cb[0] : q == 1 ? cb[1] : q == 2 ? cb[2] : cb[3];
                    const bool slow = (4 * c + q) >= nfast;
                    const LAS unsigned char* Kb = lds + ATT_KB + q * 8192; const LAS unsigned char* Vb = lds + ATT_VB + q * 8192;
                    if (slow) att_visit<true>(Kb, Vb, QNb, j, qi, vv, cn, LIST + j * 64, M2R, Oacc, Lacc, A, lane);
                    else att_visit<false>(Kb, Vb, QNb, j, qi, vv, cn, LIST + j * 64, M2F, Oacc, Lacc, A, lane);
                }
                __syncthreads();
            }
#undef SLC_SEQ
        }
        {
#pragma unroll
            for (int i = 0; i < 16; ++i) { O[0][i] = 0.f; O[1][i] = 0.f; }
            float lw = 0.f;
            const bf16* kg = KWN + (size_t)bg * SEQ * HD; const bf16* vg = VWT + (size_t)bg * HD * SEQ;
#pragma unroll
            for (int ks = 0; ks < 4; ++ks) Qf[ks] = __builtin_bit_cast(abf16x8, *(const v4u*)(Qu + qofs + 16 * ks));
            const int f0 = qi >= 7 ? qi - 7 : 0, nfast = qi >= 3 ? qi - 3 - f0 + 1 : 0, nslow = 1 + (qi >= 1) + (qi >= 2) + (qi >= 8), nb = nfast + nslow;
#define WIN_SEQ(i) ((i) >= nb ? qi : ((i) < nfast ? f0 + (i) : (((i) - nfast) < 3 ? qi - ((i) - nfast) : qi - 8)))
#ifndef ATT_REP_WIN
#define ATT_REP_WIN 1
#endif
#pragma unroll
            for (int rep = 0; rep < ATT_REP_WIN; ++rep) {
            f32x16 S0, S1;
            att_pipe_start(lds, kg, vg, WIN_SEQ(0), WIN_SEQ(1), WIN_SEQ(2), w, Qf, A, S0, tidq);
            for (int i = 0; i < nfast; ++i) {
                att_pipe_iter<false, true>(lds, kg, vg, i, f0 + i, WIN_SEQ(i + 3), WIN_SEQ(i + 2), true, w, Qf, A, S0, S1, O, lw, m2far, tidq);
            }
            for (int i = nfast; i < nb; ++i) {
                att_pipe_iter<true, true>(lds, kg, vg, i, WIN_SEQ(i), WIN_SEQ(i + 3), WIN_SEQ(i + 2), true, w, Qf, A, S0, S1, O, lw, m2ref, tidq);
            }
            asm volatile("s_waitcnt vmcnt(0)" ::: "memory"); __syncthreads();
            }
#undef WIN_SEQ
            lw += __shfl_xor(lw, 32);
            const float gate1 = sigmoid_f(bf2f(Pu[pofs + C_GT + 1 * NH + head]) + gate_b[l * 24 + 1 * NH + head]);
            const float gate2 = sigmoid_f(bf2f(Pu[pofs + C_GT + 2 * NH + head]) + gate_b[l * 24 + 2 * NH + head]);
            const f32x4* fin = (const f32x4*)(finu + tid * 32);
            const float sc = lw > 0.f ? gate2 / lw : 0.f;
#pragma unroll
            for (int i = 0; i < 16; ++i) { O[0][i] = sc * O[0][i]; O[1][i] = sc * O[1][i]; }
#pragma unroll
            for (int q = 0; q < 4; ++q) {
                const f32x4 f0 = fin[q], f1 = fin[4 + q];
#pragma unroll
                for (int e = 0; e < 4; ++e) { O[0][4 * q + e] += f0[e]; O[1][4 * q + e] += f1[e]; }
                asm volatile("" ::: "memory"); }
            { const int row = A.tokl * 4 + A.hl; const int lsel = ((const LAS int*)(lds + ATT_L))[row]; const float s1 = lsel > 0 ? gate1 / (float)lsel : 0.f;
              const LAS int* oa = (const LAS int*)(lds + ATT_OACC) + row * ATT_OACC_LD + 4 * A.h;
#pragma unroll
              for (int mt = 0; mt < 2; ++mt)
#pragma unroll
                  for (int i = 0; i < 16; ++i) O[mt][i] += s1 * (float)oa[32 * mt + (i & 3) + 8 * (i >> 2)]; }
            bf16* op = Pu + (pofs + C_Q + head * HD + 4 * A.h);
#pragma unroll
            for (int mt = 0; mt < 2; ++mt)
#pragma unroll
                for (int q4 = 0; q4 < 4; ++q4) { v2u o; o.x = pg8::cvt_pk_bf16(O[mt][4 * q4], O[mt][4 * q4 + 1]); o.y = pg8::cvt_pk_bf16(O[mt][4 * q4 + 2], O[mt][4 * q4 + 3]); *(v2u*)(op + 32 * mt + 8 * q4) = o; }
            { float ss = 0.f;
#pragma unroll
              for (int i = 0; i < 16; ++i) ss += O[0][i] * O[0][i] + O[1][i] * O[1][i];
              ss += __shfl_xor(ss, 32);
              if (A.h == 0) WSP(float, WS_SSQA)[((size_t)b * SEQ + A.t) * 8 + head] = ss; }
        }
    }
    __syncthreads();
}
__device__ __forceinline__ void phase_norm2_router(Ctx& C, int l, int li  ) {
    const float* const norm2_g = INP(19);
    const float* const router_w = INP(23);
    const bf16* XB = WSP(bf16, WS_HN);
    int* TOPE = WSP(int, WS_TOPE); float* TOPW = WSP(float, WS_TOPW); int* POS = WSP(int, WS_POS);
    unsigned* CNT = WSP(unsigned, WS_CTL) + CW_MOECNT;
    LAS unsigned* lcnt = (LAS unsigned*)C.lds;
    const int lane = C.lane;
    float rwl[16][8];
#pragma unroll
    for (int j = 0; j < 2; ++j)
#pragma unroll
        for (int i = 0; i < 8; ++i) { const int ch = 512 * j + 8 * lane + i; const float gch = norm2_g[l * D + ch]; const float* wr = router_w + ((size_t)li * D + ch) * NE;
#pragma unroll
            for (int e = 0; e < 8; ++e) rwl[8 * j + i][e] = gch * wr[e]; }
    for (int blk = C.bid; blk < M / 128; blk += C.G) {
        __syncthreads();
        if (C.tid < 32) lcnt[C.tid] = 0u;
        __syncthreads();
        v4u nx0 = *(const v4u*)(XB + (size_t)(blk * 128 + C.wave * 16) * D + 8 * lane), nx1 = *(const v4u*)(XB + (size_t)(blk * 128 + C.wave * 16) * D + 512 + 8 * lane);
        for (int rr = 0; rr < 16; ++rr) {
            const int m = blk * 128 + C.wave * 16 + rr;
            const v4u w0v = nx0, w1v = nx1;
            if (rr + 1 < 16) { nx0 = *(const v4u*)(XB + (size_t)(m + 1) * D + 8 * lane); nx1 = *(const v4u*)(XB + (size_t)(m + 1) * D + 512 + 8 * lane); }
            const float xv[16] = {bflo(w0v.x), bfhi(w0v.x), bflo(w0v.y), bfhi(w0v.y), bflo(w0v.z), bfhi(w0v.z), bflo(w0v.w), bfhi(w0v.w),
                                  bflo(w1v.x), bfhi(w1v.x), bflo(w1v.y), bfhi(w1v.y), bflo(w1v.z), bfhi(w1v.z), bflo(w1v.w), bfhi(w1v.w)};
            float s = 0.f, lg[8];
#pragma unroll
            for (int e = 0; e < 8; ++e) lg[e] = 0.f;
#pragma unroll
            for (int i = 0; i < 16; ++i) { s += xv[i] * xv[i];
#pragma unroll
                for (int e = 0; e < 8; ++e) lg[e] += xv[i] * rwl[i][e]; }
            const float rstd = 1.0f / sqrtf(wave_sum(s) * (1.f / D) + RMS_EPS);
#pragma unroll
            for (int e = 0; e < 8; ++e) lg[e] = wave_sum(lg[e]) * rstd;
            int e0 = 0; float v0 = lg[0];
#pragma unroll
            for (int e = 1; e < 8; ++e) if (lg[e] > v0) { v0 = lg[e]; e0 = e; }
            int e1 = -1; float v1 = -3.0e38f;
#pragma unroll
            for (int e = 0; e < 8; ++e) if (e != e0 && lg[e] > v1) { v1 = lg[e]; e1 = e; }
            const float w0 = 1.0f / (1.0f + __expf(v1 - v0)), w1 = 1.0f - w0;
            if (lane == 0) {
                const unsigned p0 = atomicAdd((unsigned*)&lcnt[e0], 1u), p1 = atomicAdd((unsigned*)&lcnt[8 + e1], 1u);
                TOPE[m] = e0; TOPE[M + m] = e1; TOPW[m] = w0; TOPW[M + m] = w1; POS[m] = (int)p0; POS[M + m] = (int)p1; WSP(float, WS_RSTD)[m] = rstd;
            }
        }
        __syncthreads();
        if (C.tid < 16) lcnt[16 + C.tid] = atomicAdd(&CNT[C.tid], lcnt[C.tid]);
        __syncthreads();
        if (C.tid < 128) { const int m = blk * 128 + C.tid; POS[m] += (int)lcnt[16 + TOPE[m]]; POS[M + m] += (int)lcnt[24 + TOPE[M + m]]; }
    }
    __syncthreads();
}
__device__ __forceinline__ void phase_route2(Ctx& C) {
    const unsigned* CNT = WSP(unsigned, WS_CTL) + CW_MOECNT; int* META = WSP(int, WS_META);
    const int* TOPE = WSP(int, WS_TOPE); const float* TOPW = WSP(float, WS_TOPW); const int* POS = WSP(int, WS_POS);
    int* RT = WSP(int, WS_ROWTOK); float* RW = WSP(float, WS_ROWW);
    LAS int* off = (LAS int*)C.lds;
    __syncthreads();
    if (C.tid < 2) { int o = 0; for (int e = 0; e < NE; ++e) { off[C.tid * 9 + e] = o; o += (int)((CNT[C.tid * 8 + e] + 255u) & ~255u); } off[C.tid * 9 + 8] = o; }
    __syncthreads();
    if (C.bid == 0) {
        if (C.tid < 2) { for (int e = 0; e < 9; ++e) META[C.tid * 512 + e] = (e < 8) ? off[C.tid * 9 + e] : off[C.tid * 9 + 8] / 256; }
        if (C.tid < 2 * MOE_PANELS) { const int r = C.tid / MOE_PANELS, p = C.tid % MOE_PANELS; int e = 0; for (int k = 1; k < NE; ++k) if (p * 256 >= off[r * 9 + k]) e = k; META[r * 512 + 16 + p] = e; }
    }
    const int gt = C.bid * NTHR + C.tid, NGT = C.G * NTHR;
    for (int i = gt; i < 2 * M; i += NGT) { const int r = i / M; const int m = i % M; const int row = off[r * 9 + TOPE[i]] + POS[i]; RT[r * MOE_ROWS + row] = m; RW[r * MOE_ROWS + row] = TOPW[i]; WSP(float, WS_ROWRS)[r * MOE_ROWS + row] = WSP(float, WS_RSTD)[m]; }
    __syncthreads();
}
__device__ __forceinline__ void moe_scatter(Ctx& C, int r) {
    const unsigned* CNT = WSP(unsigned, WS_CTL) + CW_MOECNT; const int* TOPE = WSP(int, WS_TOPE) + r * M; const int* POS = WSP(int, WS_POS) + r * M;
    const bf16* XBs = WSP(bf16, WS_HN); unsigned char* XBUF = WSP(unsigned char, WS_XBUF);
    const int gw = C.bid * NWAVES + C.wave, NGW = C.G * NWAVES, lane = C.lane;
    int off[9]; { int o = 0;
#pragma unroll
        for (int e = 0; e < NE; ++e) { off[e] = o; o += (int)((CNT[r * 8 + e] + 255u) & ~255u); } off[8] = o; }
    for (int m0 = gw * 4; m0 < M; m0 += NGW * 4) {
        v4u a[4], b[4]; int row[4];
#pragma unroll
        for (int q = 0; q < 4; ++q) { const int m = m0 + q; const int e = TOPE[m]; int o = off[0];
#pragma unroll
            for (int k = 1; k < NE; ++k) o = (e == k) ? off[k] : o;
            row[q] = o + POS[m]; const v4u* s = (const v4u*)(XBs + (size_t)m * D); a[q] = s[2 * lane]; b[q] = s[2 * lane + 1]; }
#pragma unroll
        for (int q = 0; q < 4; ++q) { v4u o;
            o.x = pk4_fp8(bflo(a[q].x), bfhi(a[q].x), bflo(a[q].y), bfhi(a[q].y)); o.y = pk4_fp8(bflo(a[q].z), bfhi(a[q].z), bflo(a[q].w), bfhi(a[q].w));
            o.z = pk4_fp8(bflo(b[q].x), bfhi(b[q].x), bflo(b[q].y), bfhi(b[q].y)); o.w = pk4_fp8(bflo(b[q].z), bfhi(b[q].z), bflo(b[q].w), bfhi(b[q].w));
            ((v4u*)(XBUF + (size_t)row[q] * D))[lane] = o; }
    }
#pragma unroll
    for (int e = 0; e < NE; ++e) { const int p0 = off[e] + (int)CNT[r * 8 + e], p1 = off[e + 1];
        for (int row = p0 + gw; row < p1; row += NGW) ((v4u*)(XBUF + (size_t)row * D))[lane] = (v4u){0u, 0u, 0u, 0u}; }
}


#ifndef DUP_MASK
#define DUP_MASK 0
#endif
#define DUPRUN(bit, ...) do { __VA_ARGS__; if constexpr ((DUP_MASK >> (bit)) & 1) { xcd_barrier(bar); __VA_ARGS__; } } while (0)
#define IN(k) (lo <= (k) && (k) < hi)
#define SEAM(k) do { if (IN(k) && IN((k) + 1)) xcd_barrier(bar); } while (0)
template <int R>
__device__ __forceinline__ void moe_rank(Ctx& C, const XcdBarrier& bar, int lo, int hi, PG8_LAS unsigned char* glds) {
    constexpr int r = R; constexpr int pr = 15 + 2 * R;
    const int* META = WSP(int, WS_META) + r * 512;
    if (IN(pr)) {
        const int npan = META[8];
        pg8::Gemm g{WSP(pg8::bf16_t, WS_XBUF), WSP(pg8::bf16_t, WS_MGU), MOE_ROWS, NGU, D / 2}; pg8::StaticOrder S; S.init(npan, NGU / 256, C.G, C.bid); S.pexp = META + 16; S.estride = (size_t)NGU * D;
        pg8::EpiSwiGLU<2> E{WSP(pg8::bf16_t, WS_HID), FF, WSP(float, WS_ROWRS) + r * MOE_ROWS, nullptr};
        DUPRUN(10, pg8::gemm_phase<pg8::EpiSwiGLU<2>, pg8::StaticOrder, true, true, true>(glds, g, S, E));
    } SEAM(pr);
    if (IN(pr + 1)) {
        const int npan = META[8];
        pg8::Gemm g{WSP(pg8::bf16_t, WS_HID), WSP(pg8::bf16_t, WS_MD), MOE_ROWS, D, FF / 2}; pg8::StaticOrder S; S.init(npan, D / 256, C.G, C.bid); S.pexp = META + 16; S.estride = (size_t)D * FF;
        pg8::EpiMoeDown<R == 0> E{WSP(int, WS_ROWTOK) + r * MOE_ROWS, WSP(float, WS_ROWW) + r * MOE_ROWS, C.out, D, WSP(pg8::bf16_t, WS_HN)};
        pg8::gemm_phase<pg8::EpiMoeDown<R == 0>, pg8::StaticOrder, true, true, true, 0x7c7c7c7c>(glds, g, S, E);
        if constexpr (R == 0) moe_scatter(C, 1);
    } SEAM(pr + 1);
}
template <int L>
__device__ __forceinline__ void layer_phases(Ctx& C, const XcdBarrier& bar, int lo, int hi, PG8_LAS unsigned char* glds) {
    constexpr int l = L; constexpr int pb = (L == 0) ? 1 : 8;
    if (IN(pb + 0)) {
        pg8::StaticOrder S; S.init(M / 256, NPROJ / 256, C.G, C.bid);
        pg8::EpiBf16<true> E{WSP(pg8::bf16_t, WS_PROJ), NPROJ, WSP(float, WS_SSQ)};
        if constexpr (INPROJ_FP8(L)) { pg8::Gemm g{WSP(pg8::bf16_t, WS_QN), WSP(pg8::bf16_t, WS_WIN) + (size_t)l * NPROJ * D, M, NPROJ, D / 2};
            pg8::gemm_phase<pg8::EpiBf16<true>, pg8::StaticOrder, true, true, true>(glds, g, S, E); }
        else { pg8::Gemm g{WSP(pg8::bf16_t, WS_HN), WSP(pg8::bf16_t, WS_WIN) + (size_t)l * NPROJ * D, M, NPROJ, D};
        DUPRUN(1, pg8::gemm_phase<pg8::EpiBf16<true>, pg8::StaticOrder, true, true>(glds, g, S, E)); }
    } SEAM(pb + 0);
    if (IN(pb + 1)) { DUPRUN(2, prep_qknorm(C, l)); DUPRUN(3, prep_compress(C, l)); DUPRUN(4, lru_chunks<1>(C, l)); } SEAM(pb + 1);
    if (IN(pb + 2)) { lru_carry(C); DUPRUN(5, phase_att(C, l)); } SEAM(pb + 2);
    if (IN(pb + 3)) { lru_chunks<2>(C, l); } SEAM(pb + 3);
    if (IN(pb + 4)) {
        pg8::Gemm g{WSP(pg8::bf16_t, WS_PROJ) + C_LG, WSP(pg8::bf16_t, WS_WOUT) + (size_t)l * D * D, M, D, D, NPROJ, 0}; pg8::StaticOrder S; S.init(M / 256, D / 256, C.G, C.bid);
        PG8_LAS pg8::f32x2t* T = (PG8_LAS pg8::f32x2t*)(glds + 131072 + 1024);
        { pg8::Unit uu; for (int i = 0; S.next(i, uu) && i < 4; ++i) if (C.tid < 256) { const int row = uu.pm * 256 + C.tid;
              const float rl = pg8::rstd512(WSP(float, WS_SSQL), row), ra = pg8::rstd512(WSP(float, WS_SSQA), row); T[i * 256 + C.tid] = (pg8::f32x2t){rl / ra, ra}; }
          __syncthreads(); }
        const pg8::MidRatio Mi{T};
        pg8::EpiResBf16Norm<true> E{WSP(pg8::bf16_t, WS_HN), WSP(pg8::bf16_t, WS_HN), D, WSP(float, WS_SSQ), (l == 0) ? WSP(unsigned char, WS_QN) : nullptr, T};
        pg8::gemm_phase<pg8::EpiResBf16Norm<true>, pg8::StaticOrder, true, true, false, 0x7f7f7f7f, pg8::MidRatio>(glds, g, S, E, Mi);
    } SEAM(pb + 4);
    if constexpr (L == 0) {
        if (IN(6)) {
            pg8::Gemm g{WSP(pg8::bf16_t, WS_QN), WSP(pg8::bf16_t, WS_FGU), M, NGU, D / 2}; pg8::StaticOrder S; S.init(M / 256, NGU / 256, C.G, C.bid);
            pg8::EpiSwiGLU<1, true> E{WSP(pg8::bf16_t, WS_HID), FF, WSP(float, WS_SSQ), nullptr};
            DUPRUN(9, pg8::gemm_phase<pg8::EpiSwiGLU<1, true>, pg8::StaticOrder, true, true, true>(glds, g, S, E));
        } SEAM(6);
        if (IN(7)) {
            pg8::Gemm g{WSP(pg8::bf16_t, WS_HID), WSP(pg8::bf16_t, WS_FD), M, D, FF / 2}; pg8::StaticOrder S; S.init(M / 256, D / 256, C.G, C.bid);
            pg8::EpiResBf16Norm<false> E{WSP(pg8::bf16_t, WS_HN), WSP(pg8::bf16_t, WS_HN), D, WSP(float, WS_SSQ), INPROJ_FP8(1) ? WSP(unsigned char, WS_QN) : nullptr};
            if constexpr ((DUP_MASK >> 13) & 1) { pg8::EpiProbeSum EP{WSP(float, WS_MIX)}; pg8::gemm_phase<pg8::EpiProbeSum, pg8::StaticOrder, true, true>(glds, g, S, EP); xcd_barrier(bar); }
            pg8::gemm_phase<pg8::EpiResBf16Norm<false>, pg8::StaticOrder, true, true, true, 0x7c7c7c7c>(glds, g, S, E);
        } SEAM(7);
    } else {
        if (IN(13)) { phase_norm2_router(C, l, 0); } SEAM(13);
        if (IN(14)) { phase_route2(C); moe_scatter(C, 0); } SEAM(14);
        moe_rank<0>(C, bar, lo, hi, glds); moe_rank<1>(C, bar, lo, hi, glds);
    }
}
#undef IN
#undef SEAM
__global__ void __launch_bounds__(NTHR, 2) fwd(Args args) {
    extern __shared__ __attribute__((aligned(16))) unsigned char lds[];
    Ctx C;
    C.lds = (LAS unsigned char*)lds; C.ws = args.ws; C.out = args.out;
    C.tid = threadIdx.x; C.lane = C.tid & 63; C.wave = __builtin_amdgcn_readfirstlane(C.tid >> 6); C.G = gridDim.x; C.bid = blockIdx.x;
    volatile LAS unsigned* MISC = (volatile LAS unsigned*)(C.lds + MISC_OFF);
    if (C.tid < 64) ((LAS unsigned*)(C.lds + MISC_OFF))[C.tid] = 0u;
    __syncthreads();
    XcdBarrier bar; bar.bar = WSP(unsigned, WS_CTL) + CW_BAR; bar.x = 0; bar.st = nullptr;
    if (args.use_bar) bar = xcd_barrier_post(WSP(unsigned, WS_CTL) + CW_BAR, MISC + 8);
    const int lo = args.ph_lo, hi = args.ph_hi;
#define IN(k) (lo <= (k) && (k) < hi)
#define SEAM(k) do { if (IN(k) && IN((k) + 1)) xcd_barrier(bar); } while (0)
    PG8_LAS unsigned char* glds = (PG8_LAS unsigned char*)lds;

        if (IN(0)) { DUPRUN(0, phase_prologue(C)); } SEAM(0);
    layer_phases<0>(C, bar, lo, hi, glds);
    layer_phases<1>(C, bar, lo, hi, glds);
#undef IN
#undef SEAM
}

constexpr int N_PHASES = 19;
extern "C" void kernel_launch(void* const* d_in, const int* in_sizes, int n_in, void* d_out, int out_size, void* d_ws, size_t ws_size, hipStream_t stream) {
    static int grid = 0;
    if (grid == 0) {
        if (n_in != 27 || in_sizes[0] != M * D || out_size != M * D || ws_size < WS_END) { fprintf(stderr, "kernel_launch: unexpected shapes (n_in %d, in0 %d, out %d, ws %zu); nothing launched\n", n_in, n_in > 0 ? in_sizes[0] : -1, out_size, ws_size); grid = -1; return; }
        int dev = 0, cus = 0;
        if (hipGetDevice(&dev) != hipSuccess || hipDeviceGetAttribute(&cus, hipDeviceAttributeMultiprocessorCount, dev) != hipSuccess) { grid = -1; return; }
        if (hipFuncSetAttribute((const void*)fwd, hipFuncAttributeMaxDynamicSharedMemorySize, LDS_BYTES) != hipSuccess) { fprintf(stderr, "kernel_launch: hipFuncSetAttribute failed\n"); grid = -1; return; }
        int per_cu = 0;
        if (hipOccupancyMaxActiveBlocksPerMultiprocessor(&per_cu, (const void*)fwd, NTHR, LDS_BYTES) != hipSuccess || per_cu < 1) fprintf(stderr, "kernel_launch: occupancy query says %d\n", per_cu);
        (void)hipGetLastError();
        grid = cus;
    }
    if (grid < 0) return;
    if (hipMemsetAsync((char*)d_ws + WS_CTL, 0, CTL_ZERO_BYTES, stream) != hipSuccess) return;
    Args a{};
    for (int i = 0; i < 27; ++i) a.in[i] = (const float*)d_in[i];
    a.out = (float*)d_out; a.ws = (unsigned char*)d_ws; a.pad = 0;
#ifndef MK_SPLIT
#define MK_SPLIT 0
#endif
#if MK_SPLIT
    for (int p = 0; p < N_PHASES; ++p) { a.ph_lo = p; a.ph_hi = p + 1; a.use_bar = 0; hipLaunchKernelGGL(fwd, dim3(grid), dim3(NTHR), LDS_BYTES, stream, a); }
#else
    a.ph_lo = 0; a.ph_hi = N_PHASES; a.use_bar = 1; hipLaunchKernelGGL(fwd, dim3(grid), dim3(NTHR), LDS_BYTES, stream, a);
#endif
}
```

```cpp
#include <hip/hip_runtime.h>
#include <cstdio>
#include <cstdint>

namespace pg8 {
#define PG8_LAS __attribute__((address_space(3)))
typedef unsigned short bf16_t;
typedef short bf16x8 __attribute__((ext_vector_type(8)));
typedef float f32x4 __attribute__((ext_vector_type(4)));
typedef unsigned u32x4 __attribute__((ext_vector_type(4)));
constexpr int BM = 256, BK = 64, HALF = 128, HTB = HALF * BK * 2  , STAGE_BYTES = 8 * HTB, NXCD = 8, WGM = 8;

__host__ __device__ __forceinline__ int lds_byte(int r, int c) { const int st = (r >> 4) * 2 + (c >> 5), rr = r & 15, cc = c & 31, ob = rr * 64 + cc * 2; return st * 1024 + (ob ^ (((ob >> 9) & 1) << 5)); }
__host__ __device__ __forceinline__ void stage_rc(int b, int& R, int& C) { const int st = b / 1024, sb = b % 1024, swz = sb ^ (((sb >> 9) & 1) << 5); R = (st >> 1) * 16 + swz / 64; C = (st & 1) * 32 + (swz % 64) / 2; }
__host__ __device__ __forceinline__ int perm32(int rho) { const int n = rho >> 4, i = rho & 15; return 8 * (i >> 2) + 4 * n + (i & 3); }

struct Unit { int pm, pn; int idx = 0; };
struct Gemm { const bf16_t* A; const bf16_t* Bt; int M, N, K; int lda = 0, ldb = 0; };

struct StaticOrder {
    int nM, nN, nwg, G, c;
    const int* pexp; size_t estride;
    __host__ __device__ void init(int nM_, int nN_, int G_, int c_) { nM = nM_; nN = nN_; nwg = nM * nN; G = G_; c = c_; pexp = nullptr; estride = 0; }
    __host__ __device__ bool next(int i, Unit& u) const {
        const long L = (long)i * G + c; if (L >= nwg) return false;
        int wgid = (int)L; { const int q = nwg / NXCD, r = nwg % NXCD, xcd = wgid % NXCD, off = wgid / NXCD; wgid = (xcd < r ? xcd * (q + 1) : r * (q + 1) + (xcd - r) * q) + off; }
        const int nig = WGM * nN, gid = wgid / nig, fm = gid * WGM, gsz = (nM - fm) < WGM ? (nM - fm) : WGM;
        u.pm = fm + ((wgid % nig) % gsz); u.pn = (wgid % nig) / gsz; return true;
    }
    __device__ __forceinline__ size_t b_off(const Unit& u) const { return pexp ? (size_t)pexp[u.pm] * estride : (size_t)0; }
    __device__ __forceinline__ void a_ready(const Unit&) const {}
    __device__ __forceinline__ void done(const Unit&) const {}
};

__device__ __forceinline__ unsigned cvt_pk_bf16(float lo, float hi) { unsigned r; asm volatile("v_cvt_pk_bf16_f32 %0, %1, %2" : "=v"(r) : "v"(lo), "v"(hi)); return r; }

struct NoMid { static constexpr bool ON = false; };
__device__ __forceinline__ float rstd512(const float* S8, int row) { const f32x4 a = *(const f32x4*)(S8 + (size_t)row * 8), b = *(const f32x4*)(S8 + (size_t)row * 8 + 4);
    return 1.0f / sqrtf((((a[0] + a[1]) + (a[2] + a[3])) + ((b[0] + b[1]) + (b[2] + b[3]))) * (1.0f / 512.0f) + 1e-6f); }
typedef float f32x2t __attribute__((ext_vector_type(2)));
struct MidRatio { static constexpr bool ON = true; const PG8_LAS f32x2t* T;
    __device__ __forceinline__ void load(const Unit& u, int wr, int fr, int fq, float (&f)[2][4]) const {
#pragma unroll
        for (int ai = 0; ai < 2; ++ai)
#pragma unroll
            for (int m = 0; m < 4; ++m) f[ai][m] = T[u.idx * 256 + wr * 64 + fr + ai * HALF + m * 16].x;
    }
    __device__ __forceinline__ void load_final(const Unit& u, int wr, int fr, int fq, float (&f)[2][4]) const {
#pragma unroll
        for (int ai = 0; ai < 2; ++ai)
#pragma unroll
            for (int m = 0; m < 4; ++m) f[ai][m] = T[u.idx * 256 + wr * 64 + fr + ai * HALF + m * 16].y;
    }
};
__device__ __forceinline__ f32x4 row_ssq_load(const float* SSQ, int row, int fq) { return *(const f32x4*)(SSQ + (size_t)row * 16 + 4 * fq); }
__device__ __forceinline__ float row_rstd_fin(const f32x4 p) {
    float s = (p[0] + p[1]) + (p[2] + p[3]); s += __shfl_xor(s, 16); s += __shfl_xor(s, 32);
    return 1.0f / sqrtf(s * (1.0f / 1024.0f) + 1e-6f);
}
template <bool SCALE> struct EpiBf16 {
    static constexpr bool PERM = true, AFTER_DRAIN = false;
    bf16_t* O; int ldc; const float* SSQ;
    __device__ __forceinline__ void operator()(const f32x4 (&acc)[2][2][4][2], const Unit& u, int wr, int wc, int fr, int fq) const {
        const int row0 = u.pm * BM + wr * 64 + fr; const int col0 = u.pn * BM + wc * 32 + 8 * fq;
        f32x4 sq[2][4];
        if (SCALE) {
#pragma unroll
            for (int ai = 0; ai < 2; ++ai)
#pragma unroll
                for (int m = 0; m < 4; ++m) sq[ai][m] = row_ssq_load(SSQ, row0 + ai * HALF + m * 16, fq);
        }
#pragma unroll
        for (int ai = 0; ai < 2; ++ai)
#pragma unroll
            for (int m = 0; m < 4; ++m) { const int row = row0 + ai * HALF + m * 16; bf16_t* rowp = O + (size_t)row * ldc + col0;
                const float rs = SCALE ? row_rstd_fin(sq[ai][m]) : 1.0f;
#pragma unroll
                for (int bj = 0; bj < 2; ++bj) { const f32x4 v0 = acc[ai][bj][m][0] * rs, v1 = acc[ai][bj][m][1] * rs;
                    u32x4 w; w.x = cvt_pk_bf16(v0[0], v0[1]); w.y = cvt_pk_bf16(v0[2], v0[3]); w.z = cvt_pk_bf16(v1[0], v1[1]); w.w = cvt_pk_bf16(v1[2], v1[3]);
                    *(u32x4*)(rowp + bj * HALF) = w; } }
    }
};
__device__ __forceinline__ float silu_f(float x) { return x * __builtin_amdgcn_rcpf(1.0f + __builtin_amdgcn_exp2f(-1.44269504089f * x)); }
template <int SCALE, bool OUT8 = (SCALE == 2)> struct EpiSwiGLU {
    static constexpr bool PERM = true, AFTER_DRAIN = false;
    bf16_t* H; int ldh; const float* SSQ; const int* rowtok;
    __device__ __forceinline__ void operator()(const f32x4 (&acc)[2][2][4][2], const Unit& u, int wr, int wc, int fr, int fq) const {
        const int row0 = u.pm * BM + wr * 64 + fr; const int col0 = u.pn * HALF + wc * 32 + 8 * fq;
        f32x4 sq[2][4]; float rsv[2][4];
#pragma unroll
        for (int ai = 0; ai < 2; ++ai)
#pragma unroll
            for (int m = 0; m < 4; ++m) { if (SCALE == 2) rsv[ai][m] = SSQ[row0 + ai * HALF + m * 16]; else sq[ai][m] = row_ssq_load(SSQ, row0 + ai * HALF + m * 16, fq); }
#pragma unroll
        for (int ai = 0; ai < 2; ++ai)
#pragma unroll
            for (int m = 0; m < 4; ++m) { const int row = row0 + ai * HALF + m * 16; bf16_t* rowp = H + (size_t)row * ldh + col0;
                const float rs = (SCALE == 2) ? rsv[ai][m] : row_rstd_fin(sq[ai][m]);
                const f32x4 g0 = acc[ai][0][m][0] * rs, g1 = acc[ai][0][m][1] * rs, u0 = acc[ai][1][m][0] * rs, u1 = acc[ai][1][m][1] * rs;
                if constexpr (OUT8) {
                    const float h0 = 8.f * silu_f(g0[0]) * u0[0], h1 = 8.f * silu_f(g0[1]) * u0[1], h2 = 8.f * silu_f(g0[2]) * u0[2], h3 = 8.f * silu_f(g0[3]) * u0[3];
                    const float h4 = 8.f * silu_f(g1[0]) * u1[0], h5 = 8.f * silu_f(g1[1]) * u1[1], h6 = 8.f * silu_f(g1[2]) * u1[2], h7 = 8.f * silu_f(g1[3]) * u1[3];
                    int q0 = 0, q1 = 0; q0 = __builtin_amdgcn_cvt_pk_fp8_f32(h0, h1, q0, false); q0 = __builtin_amdgcn_cvt_pk_fp8_f32(h2, h3, q0, true); q1 = __builtin_amdgcn_cvt_pk_fp8_f32(h4, h5, q1, false); q1 = __builtin_amdgcn_cvt_pk_fp8_f32(h6, h7, q1, true);
                    typedef unsigned u32x2 __attribute__((ext_vector_type(2))); u32x2 w8; w8.x = (unsigned)q0; w8.y = (unsigned)q1;
                    *(u32x2*)((unsigned char*)H + (size_t)row * ldh + col0) = w8;
                } else {
                u32x4 w; w.x = cvt_pk_bf16(silu_f(g0[0]) * u0[0], silu_f(g0[1]) * u0[1]); w.y = cvt_pk_bf16(silu_f(g0[2]) * u0[2], silu_f(g0[3]) * u0[3]);
                w.z = cvt_pk_bf16(silu_f(g1[0]) * u1[0], silu_f(g1[1]) * u1[1]); w.w = cvt_pk_bf16(silu_f(g1[2]) * u1[2], silu_f(g1[3]) * u1[3]);
                *(u32x4*)rowp = w; } }
    }
};
struct EpiProbeSum {
    static constexpr bool PERM = true, AFTER_DRAIN = false;
    float* sink;
    __device__ __forceinline__ void operator()(const f32x4 (&acc)[2][2][4][2], const Unit& u, int wr, int wc, int fr, int fq) const {
        f32x4 s = acc[0][0][0][0];
#pragma unroll
        for (int ai = 0; ai < 2; ++ai)
#pragma unroll
            for (int bj = 0; bj < 2; ++bj)
#pragma unroll
                for (int m = 0; m < 4; ++m)
#pragma unroll
                    for (int n = 0; n < 2; ++n) s += acc[ai][bj][m][n];
        sink[(size_t)(u.pm * 16 + u.pn) * 512 + threadIdx.x] = (s[0] + s[1]) + (s[2] + s[3]);
    }
};
struct EpiResF32 {
    static constexpr bool PERM = false, AFTER_DRAIN = false;
    const float* base; float* out; int ldc;
    __device__ __forceinline__ void operator()(const f32x4 (&acc)[2][2][4][2], const Unit& u, int wr, int wc, int fr, int fq) const {
        const int row0 = u.pm * BM + wr * 64 + fr, col0 = u.pn * BM + wc * 32 + 4 * fq;
#pragma unroll
        for (int ai = 0; ai < 2; ++ai)
#pragma unroll
            for (int m = 0; m < 4; ++m) { const size_t ro = (size_t)(row0 + ai * HALF + m * 16) * ldc + col0;
#pragma unroll
                for (int bj = 0; bj < 2; ++bj)
#pragma unroll
                    for (int n = 0; n < 2; ++n) { const f32x4 b = *(const f32x4*)(base + ro + bj * HALF + n * 16); *(f32x4*)(out + ro + bj * HALF + n * 16) = acc[ai][bj][m][n] + b; } }
    }
};
struct EpiResNorm {
    static constexpr bool PERM = false, AFTER_DRAIN = false;
    const float* base; float* out; int ldc; const float* gn; bf16_t* XG; float* SSQ;
    __device__ __forceinline__ void operator()(const f32x4 (&acc)[2][2][4][2], const Unit& u, int wr, int wc, int fr, int fq) const {
        const int row0 = u.pm * BM + wr * 64 + fr, col0 = u.pn * BM + wc * 32 + 4 * fq;
        f32x4 gv[2][2];
#pragma unroll
        for (int bj = 0; bj < 2; ++bj)
#pragma unroll
            for (int n = 0; n < 2; ++n) gv[bj][n] = *(const f32x4*)(gn + col0 + bj * HALF + n * 16);
#pragma unroll
        for (int ai = 0; ai < 2; ++ai)
#pragma unroll
            for (int m = 0; m < 4; ++m) { const int row = row0 + ai * HALF + m * 16; const size_t ro = (size_t)row * ldc + col0; float ss = 0.f;
#pragma unroll
                for (int bj = 0; bj < 2; ++bj)
#pragma unroll
                    for (int n = 0; n < 2; ++n) { const f32x4 v = acc[ai][bj][m][n] + *(const f32x4*)(base + ro + bj * HALF + n * 16); *(f32x4*)(out + ro + bj * HALF + n * 16) = v;
                        ss += (v[0] * v[0] + v[1] * v[1]) + (v[2] * v[2] + v[3] * v[3]); const f32x4 xg = v * gv[bj][n];
                        typedef unsigned u32x2 __attribute__((ext_vector_type(2)));
                        u32x2 w; w.x = cvt_pk_bf16(xg[0], xg[1]); w.y = cvt_pk_bf16(xg[2], xg[3]); *(u32x2*)(XG + ro + bj * HALF + n * 16) = w; }
                ss += __shfl_xor(ss, 16); ss += __shfl_xor(ss, 32);
                if (fq == 0) SSQ[(size_t)row * 16 + u.pn * 4 + wc] = ss; }
    }
};
template <bool RS = false> struct EpiResBf16Norm {
    static constexpr bool PERM = true, AFTER_DRAIN = false;
    const bf16_t* base; bf16_t* out; int ldc; float* SSQ; unsigned char* x8; const PG8_LAS f32x2t* T = nullptr;
    __device__ __forceinline__ void operator()(const f32x4 (&acc)[2][2][4][2], const Unit& u, int wr, int wc, int fr, int fq) const {
        const int row0 = u.pm * BM + wr * 64 + fr; const int col0 = u.pn * BM + wc * 32 + 8 * fq;
#pragma unroll
        for (int ai = 0; ai < 2; ++ai) {
        u32x4 bb[2][4][2];
#pragma unroll
            for (int m = 0; m < 4; ++m)
#pragma unroll
                for (int bj = 0; bj < 2; ++bj) bb[ai][m][bj] = *(const u32x4*)(base + (size_t)(row0 + ai * HALF + m * 16) * ldc + col0 + bj * HALF);
#pragma unroll
            for (int m = 0; m < 4; ++m) { const int row = row0 + ai * HALF + m * 16; const size_t ro = (size_t)row * ldc + col0; float ss = 0.f;
                const float rsc = RS ? T[u.idx * 256 + wr * 64 + fr + ai * HALF + m * 16].y : 1.0f;
#pragma unroll
                for (int bj = 0; bj < 2; ++bj) { const u32x4 b = bb[ai][m][bj];
                    f32x4 v0 = acc[ai][bj][m][0] * rsc, v1 = acc[ai][bj][m][1] * rsc;
                    v0[0] += __uint_as_float(b.x << 16); v0[1] += __uint_as_float(b.x & 0xffff0000u); v0[2] += __uint_as_float(b.y << 16); v0[3] += __uint_as_float(b.y & 0xffff0000u);
                    v1[0] += __uint_as_float(b.z << 16); v1[1] += __uint_as_float(b.z & 0xffff0000u); v1[2] += __uint_as_float(b.w << 16); v1[3] += __uint_as_float(b.w & 0xffff0000u);
                    ss += ((v0[0] * v0[0] + v0[1] * v0[1]) + (v0[2] * v0[2] + v0[3] * v0[3])) + ((v1[0] * v1[0] + v1[1] * v1[1]) + (v1[2] * v1[2] + v1[3] * v1[3]));
                    u32x4 w; w.x = cvt_pk_bf16(v0[0], v0[1]); w.y = cvt_pk_bf16(v0[2], v0[3]); w.z = cvt_pk_bf16(v1[0], v1[1]); w.w = cvt_pk_bf16(v1[2], v1[3]);
                    *(u32x4*)(out + ro + bj * HALF) = w;
                    if (x8) { int q0 = 0, q1 = 0; q0 = __builtin_amdgcn_cvt_pk_fp8_f32(v0[0], v0[1], q0, false); q0 = __builtin_amdgcn_cvt_pk_fp8_f32(v0[2], v0[3], q0, true); q1 = __builtin_amdgcn_cvt_pk_fp8_f32(v1[0], v1[1], q1, false); q1 = __builtin_amdgcn_cvt_pk_fp8_f32(v1[2], v1[3], q1, true);
                        typedef unsigned u32x2 __attribute__((ext_vector_type(2))); u32x2 w8; w8.x = (unsigned)q0; w8.y = (unsigned)q1; *(u32x2*)(x8 + ro + bj * HALF) = w8; } }
                ss += __shfl_xor(ss, 16); ss += __shfl_xor(ss, 32);
                if (fq == 0) SSQ[(size_t)row * 16 + u.pn * 4 + wc] = ss; }
            asm volatile("" ::: "memory"); }
    }
};
template <bool FIRST> struct EpiMoeDown {
    static constexpr bool PERM = false, AFTER_DRAIN = false;
    const int* rowtok; const float* roww; float* out; int ldc; const bf16_t* xb;
    __device__ __forceinline__ void operator()(const f32x4 (&acc)[2][2][4][2], const Unit& u, int wr, int wc, int fr, int fq) const {
        const int row0 = u.pm * BM + wr * 64 + fr, col0 = u.pn * BM + wc * 32 + 4 * fq;
        int tk[2][4]; float wk[2][4];
#pragma unroll
        for (int ai = 0; ai < 2; ++ai)
#pragma unroll
            for (int m = 0; m < 4; ++m) { tk[ai][m] = rowtok[row0 + ai * HALF + m * 16]; wk[ai][m] = roww[row0 + ai * HALF + m * 16]; }
#pragma unroll
        for (int ai = 0; ai < 2; ++ai)
#pragma unroll
            for (int m = 0; m < 4; ++m) { const int tok = tk[ai][m]; const float w = wk[ai][m];
                if (tok >= 0) { float* op = out + (size_t)tok * ldc + col0; const bf16_t* bp = xb + (size_t)tok * ldc + col0;
#pragma unroll
                    for (int bj = 0; bj < 2; ++bj)
#pragma unroll
                        for (int n = 0; n < 2; ++n) { f32x4 b;
                            if (FIRST) { typedef unsigned u32x2 __attribute__((ext_vector_type(2))); const u32x2 q = *(const u32x2*)(bp + bj * HALF + n * 16);
                                b[0] = __uint_as_float(q.x << 16); b[1] = __uint_as_float(q.x & 0xffff0000u); b[2] = __uint_as_float(q.y << 16); b[3] = __uint_as_float(q.y & 0xffff0000u); }
                            else b = *(const f32x4*)(op + bj * HALF + n * 16);
                            *(f32x4*)(op + bj * HALF + n * 16) = acc[ai][bj][m][n] * w + b; } } }
    }
};

template <class Epi, class Sched, bool ALIGN_EPI = false, bool SP2 = false, bool FP8 = false, int FP8_ASCALE = 0x7f7f7f7f  , class Mid = NoMid>
__device__ __forceinline__ void gemm_phase(PG8_LAS unsigned char* lds, const Gemm g, const Sched& S, const Epi& E, const Mid& Mi = Mid()) {
    const int tid = threadIdx.x, wid = __builtin_amdgcn_readfirstlane(tid >> 6), lane = tid & 63, wr = wid >> 2, wc = wid & 3, fr = lane & 15, fq = lane >> 4;
    const int K = g.K, nt = K / BK, lda = g.lda ? g.lda : K, ldb = g.ldb ? g.ldb : K;
    unsigned voffA[2], voffB[2];
#pragma unroll
    for (int i = 0; i < 2; ++i) { int R, C; stage_rc(tid * 16 + i * 8192, R, C); const int Rb = Epi::PERM ? ((R & ~31) + perm32(R & 31)) : R;
        voffA[i] = (unsigned)(R * lda + C) * 2u; voffB[i] = (unsigned)(Rb * ldb + C) * 2u; }
    const size_t kstep = (size_t)(BK * 2);
    const size_t hstepA = (size_t)HALF * lda * 2, hstepB = (size_t)HALF * ldb * 2;
    const size_t tstepA = 2 * hstepA, tstepB = 2 * hstepB;
    const unsigned ldsw = (unsigned)wid * 1024u;
    const int aoff = lds_byte(wr * 64 + fr, fq * 8), boff = lds_byte(wc * 32 + fr, fq * 8);
    const int aoffL = lds_byte(wr * 64 + fr, fq * 16), aoffH = lds_byte(wr * 64 + fr, fq * 16 + 8), boffL = lds_byte(wc * 32 + fr, fq * 16), boffH = lds_byte(wc * 32 + fr, fq * 16 + 8);
    typedef int pg8_i4 __attribute__((ext_vector_type(4))); typedef int pg8_i8 __attribute__((ext_vector_type(8)));
#define PG8_SA(b, h) (((b) * 2 + (h)) * HTB)
#define PG8_SB(b, h) ((4 + (b) * 2 + (h)) * HTB)
#define PG8_STAGE(bufoff, gbase, voff) do { _Pragma("unroll") for (int _i = 0; _i < 2; ++_i) \
        __builtin_amdgcn_global_load_lds((const unsigned*)((const char*)(gbase) + (voff)[_i]), (PG8_LAS unsigned*)(lds + (bufoff) + ldsw + _i * 8192), 16, 0, 0); } while (0)
#define PG8_LDA(dst, b, h) do { if constexpr (FP8) { _Pragma("unroll") for (int m = 0; m < 4; ++m) { const pg8_i4 _lo = *(const PG8_LAS pg8_i4*)(lds + PG8_SA(b, h) + aoffL + m * 2048), _hi = *(const PG8_LAS pg8_i4*)(lds + PG8_SA(b, h) + aoffH + m * 2048); \
            dst##8[m] = __builtin_shufflevector(_lo, _hi, 0, 1, 2, 3, 4, 5, 6, 7); } } \
        else { _Pragma("unroll") for (int m = 0; m < 4; ++m) _Pragma("unroll") for (int k = 0; k < 2; ++k) dst[m][k] = *(const PG8_LAS bf16x8*)(lds + PG8_SA(b, h) + aoff + m * 2048 + k * 1024); } } while (0)
#define PG8_LDB(dst, b, h) do { if constexpr (FP8) { _Pragma("unroll") for (int n = 0; n < 2; ++n) { const pg8_i4 _lo = *(const PG8_LAS pg8_i4*)(lds + PG8_SB(b, h) + boffL + n * 2048), _hi = *(const PG8_LAS pg8_i4*)(lds + PG8_SB(b, h) + boffH + n * 2048); \
            dst##8[n] = __builtin_shufflevector(_lo, _hi, 0, 1, 2, 3, 4, 5, 6, 7); } } \
        else { _Pragma("unroll") for (int n = 0; n < 2; ++n) _Pragma("unroll") for (int k = 0; k < 2; ++k) dst[n][k] = *(const PG8_LAS bf16x8*)(lds + PG8_SB(b, h) + boff + n * 2048 + k * 1024); } } while (0)
#define PG8_MMA(ai, bj, At, Bt) do { __builtin_amdgcn_s_setprio(1); _Pragma("unroll") for (int m = 0; m < 4; ++m) _Pragma("unroll") for (int n = 0; n < 2; ++n) { \
        if constexpr (FP8) asm volatile("v_mfma_scale_f32_16x16x128_f8f6f4 %0, %1, %2, %0, %3, %4 op_sel_hi:[0,0,0]" : "+v"(acc[ai][bj][m][n]) : "v"(Bt##8[n]), "v"(At##8[m]), "v"(0x79797979), "v"(FP8_ASCALE)); \
        else { _Pragma("unroll") for (int k = 0; k < 2; ++k) acc[ai][bj][m][n] = __builtin_amdgcn_mfma_f32_16x16x32_bf16(Bt[n][k], At[m][k], acc[ai][bj][m][n], 0, 0, 0); } } \
        __builtin_amdgcn_s_setprio(0); } while (0)
#define PG8_WAIT_V(n) asm volatile("s_waitcnt vmcnt(" #n ")" ::: "memory")
#define PG8_WAIT_L(n) asm volatile("s_waitcnt lgkmcnt(" #n ")" ::: "memory")
#define PG8_BAR __builtin_amdgcn_s_barrier()
#define PG8_SCHED __builtin_amdgcn_sched_barrier(0)
    Unit cur, nxt; int ui = 0;
    if (!S.next(0, cur)) return;
    cur.idx = 0;
    f32x4 acc[2][2][4][2];
#pragma unroll
    for (int a = 0; a < 2; ++a)
#pragma unroll
        for (int b = 0; b < 2; ++b)
#pragma unroll
            for (int m = 0; m < 4; ++m)
#pragma unroll
                for (int n = 0; n < 2; ++n) acc[a][b][m][n] = (f32x4){0.f, 0.f, 0.f, 0.f};
    bf16x8 At[4][2], B0[2][2], B1[2][2];
    pg8_i8 At8[4], B08[2], B18[2];
    const char* cA = (const char*)g.A + (size_t)cur.pm * tstepA; const char* cB = (const char*)g.Bt + S.b_off(cur) + (size_t)cur.pn * tstepB;
    S.a_ready(cur);
    if constexpr (SP2) {
        PG8_STAGE(PG8_SB(0, 0), cB, voffB); PG8_STAGE(PG8_SB(0, 1), cB + hstepB, voffB); PG8_STAGE(PG8_SA(0, 0), cA, voffA); PG8_STAGE(PG8_SA(0, 1), cA + hstepA, voffA);
        if (wr == 1) PG8_BAR;
        PG8_WAIT_V(2); PG8_BAR;
        PG8_STAGE(PG8_SB(1, 0), cB + kstep, voffB); PG8_STAGE(PG8_SA(1, 0), cA + kstep, voffA); PG8_STAGE(PG8_SB(1, 1), cB + hstepB + kstep, voffB);
        PG8_WAIT_V(6); PG8_BAR;
    } else {
        PG8_STAGE(PG8_SB(0, 0), cB, voffB); PG8_STAGE(PG8_SA(0, 0), cA, voffA); PG8_STAGE(PG8_SB(0, 1), cB + hstepB, voffB); PG8_STAGE(PG8_SA(0, 1), cA + hstepA, voffA);
        if (wr == 1) PG8_BAR;
        PG8_WAIT_V(4); PG8_BAR;
        PG8_STAGE(PG8_SB(1, 0), cB + kstep, voffB); PG8_STAGE(PG8_SA(1, 0), cA + kstep, voffA); PG8_STAGE(PG8_SB(1, 1), cB + hstepB + kstep, voffB);
        PG8_WAIT_V(6); PG8_BAR;
    }
    for (;;) {
        const bool has_next = S.next(ui + 1, nxt); nxt.idx = ui + 1;
        const char* nA = has_next ? (const char*)g.A + (size_t)nxt.pm * tstepA : cA; const char* nB = has_next ? (const char*)g.Bt + S.b_off(nxt) + (size_t)nxt.pn * tstepB : cB;
#pragma unroll 1
        for (int t = 0; t < nt; t += 2) {
            const bool last = (t == nt - 2);
            const char* a1 = cA + (size_t)(t + 1) * kstep;
            const char* a2 = last ? nA : cA + (size_t)(t + 2) * kstep; const char* b2 = last ? nB : cB + (size_t)(t + 2) * kstep;
            const char* a3 = a2 + kstep; const char* b3 = b2 + kstep;
            if (last && has_next) S.a_ready(nxt);
            if constexpr (SP2) {
            PG8_LDB(B0, 0, 0); PG8_LDB(B1, 0, 1); PG8_SCHED; PG8_LDA(At, 0, 0); PG8_STAGE(PG8_SA(1, 1), a1 + hstepA, voffA);
            PG8_WAIT_V(8); PG8_WAIT_L(0); PG8_BAR; PG8_MMA(0, 0, At, B0); PG8_MMA(0, 1, At, B1); PG8_BAR; PG8_SCHED;
            PG8_LDA(At, 0, 1); PG8_STAGE(PG8_SB(0, 0), b2, voffB); PG8_STAGE(PG8_SB(0, 1), b2 + hstepB, voffB); PG8_STAGE(PG8_SA(0, 0), a2, voffA);
            PG8_WAIT_V(8); PG8_WAIT_L(0); PG8_BAR; PG8_MMA(1, 0, At, B0); PG8_MMA(1, 1, At, B1); PG8_BAR; PG8_SCHED;
            PG8_LDB(B0, 1, 0); PG8_LDB(B1, 1, 1); PG8_SCHED; PG8_LDA(At, 1, 0); PG8_STAGE(PG8_SA(0, 1), a2 + hstepA, voffA);
            PG8_WAIT_V(8); PG8_WAIT_L(0); PG8_BAR; PG8_MMA(0, 0, At, B0); PG8_MMA(0, 1, At, B1); PG8_BAR; PG8_SCHED;
            PG8_LDA(At, 1, 1); PG8_STAGE(PG8_SB(1, 0), b3, voffB); PG8_STAGE(PG8_SB(1, 1), b3 + hstepB, voffB); PG8_STAGE(PG8_SA(1, 0), a3, voffA);
            PG8_WAIT_V(8); PG8_WAIT_L(0); PG8_BAR; PG8_MMA(1, 0, At, B0); PG8_MMA(1, 1, At, B1); PG8_BAR; PG8_SCHED;
            } else {
            PG8_LDB(B0, 0, 0); PG8_SCHED; PG8_LDA(At, 0, 0); PG8_STAGE(PG8_SA(1, 1), a1 + hstepA, voffA);
            PG8_WAIT_L(8); PG8_BAR; PG8_WAIT_L(0); PG8_MMA(0, 0, At, B0); PG8_BAR; PG8_SCHED;
            PG8_LDB(B1, 0, 1); PG8_STAGE(PG8_SB(0, 0), b2, voffB);
            PG8_BAR; PG8_WAIT_L(0); PG8_MMA(0, 1, At, B1); PG8_BAR;
            PG8_LDA(At, 0, 1); PG8_STAGE(PG8_SA(0, 0), a2, voffA);
            PG8_BAR; PG8_WAIT_L(0); PG8_MMA(1, 0, At, B0); PG8_BAR; PG8_SCHED;
            PG8_STAGE(PG8_SB(0, 1), b2 + hstepB, voffB);
            PG8_WAIT_V(6); PG8_BAR; PG8_MMA(1, 1, At, B1); PG8_BAR;
            PG8_LDB(B0, 1, 0); PG8_SCHED; PG8_LDA(At, 1, 0); PG8_STAGE(PG8_SA(0, 1), a2 + hstepA, voffA);
            PG8_WAIT_L(8); PG8_BAR; PG8_WAIT_L(0); PG8_MMA(0, 0, At, B0); PG8_BAR; PG8_SCHED;
            PG8_LDB(B1, 1, 1); PG8_STAGE(PG8_SB(1, 0), b3, voffB);
            PG8_BAR; PG8_WAIT_L(0); PG8_MMA(0, 1, At, B1); PG8_BAR;
            PG8_LDA(At, 1, 1); PG8_STAGE(PG8_SA(1, 0), a3, voffA);
            PG8_BAR; PG8_WAIT_L(0); PG8_MMA(1, 0, At, B0); PG8_BAR; PG8_SCHED;
            PG8_STAGE(PG8_SB(1, 1), b3 + hstepB, voffB);
            PG8_WAIT_V(6); PG8_BAR; PG8_MMA(1, 1, At, B1); PG8_BAR;
            }
            if constexpr (Mid::ON) { if (t == nt / 2 - 2) { float mfac[2][4]; Mi.load(cur, wr, fr, fq, mfac);
#pragma unroll
                for (int a = 0; a < 2; ++a)
#pragma unroll
                    for (int b = 0; b < 2; ++b)
#pragma unroll
                        for (int m = 0; m < 4; ++m)
#pragma unroll
                            for (int n = 0; n < 2; ++n) acc[a][b][m][n] *= mfac[a][m]; } }
        }
        if constexpr (ALIGN_EPI) { if (wr == 0) PG8_BAR; }
        if constexpr (!Epi::AFTER_DRAIN) { E(acc, cur, wr, wc, fr, fq); S.done(cur); }
        if (!has_next) break;
#pragma unroll
        for (int a = 0; a < 2; ++a)
#pragma unroll
            for (int b = 0; b < 2; ++b)
#pragma unroll
                for (int m = 0; m < 4; ++m)
#pragma unroll
                    for (int n = 0; n < 2; ++n) acc[a][b][m][n] = (f32x4){0.f, 0.f, 0.f, 0.f};
        cur = nxt; cA = nA; cB = nB; ++ui;
        if constexpr (ALIGN_EPI) { if (wr == 1) PG8_BAR; }
    }
    PG8_WAIT_V(0);
    if constexpr (!ALIGN_EPI) { if (wr == 0) PG8_BAR; }
    PG8_BAR;
    if constexpr (Epi::AFTER_DRAIN) { E.fused(acc, cur, wr, wc, fr, fq, lds, wid, lane); S.done(cur); }
#undef PG8_SA
#undef PG8_SB
#undef PG8_STAGE
#undef PG8_LDA
#undef PG8_LDB
#undef PG8_MMA
#undef PG8_WAIT_V
#undef PG8_WAIT_L
#undef PG8_BAR
#undef PG8_SCHED
}
}

constexpr int NWAVES = 8, NTHR = 512;
constexpr int D = 1024, BATCH = 4, SEQ = 8192, M = BATCH * SEQ, DEPTH = 2;
constexpr int D_LRU = 512, HD = 64, NH = 8, NG = 2, HPG = 4;
constexpr int NPROJ = 2560, D_IN = 2328;
constexpr int C_LX = 0, C_LG = 512, C_Q = 1024, C_KC = 1536, C_VC = 1664, C_KS = 1792, C_VS = 1920, C_KW = 2048, C_VW = 2176, C_GT = 2304;
constexpr int FF = 2816, NE = 8, NGU = 2 * FF;
constexpr int NCMP = 511, NCMPP = 512, NSELB = 128, LCH = 64, NCHUNK = SEQ / LCH;
constexpr int MOE_ROWS = M + NE * 256, MOE_PANELS = MOE_ROWS / 256;
constexpr float RMS_EPS = 1e-6f;

constexpr size_t MiB = 1u << 20;
constexpr size_t WS_CTL = 0, CTL_ZERO_BYTES = 1 * MiB;
constexpr size_t WS_TAB = 1 * MiB;
constexpr size_t WS_KC = 2 * MiB, WS_VC = 2 * MiB + 512 * 1024;
constexpr size_t WS_AGGA = 3 * MiB, WS_AGGH = 4 * MiB, WS_HIN = 5 * MiB;
constexpr size_t WS_TOPE = 6 * MiB, WS_TOPW = 6 * MiB + 512 * 1024, WS_POS = 7 * MiB, WS_ROWTOK = 7 * MiB + 512 * 1024, WS_ROWW = 8 * MiB, WS_META = 8 * MiB + 512 * 1024, WS_ROWRS = 8 * MiB + 640 * 1024  , WS_RSTD = 13 * MiB  , WS_SSQ = 9 * MiB  , WS_SSQL = 11 * MiB, WS_SSQA = 12 * MiB  ;
constexpr size_t WS_WIN = 16 * MiB, WS_WOUT = 26 * MiB, WS_FGU = 30 * MiB, WS_FD = 41 * MiB, WS_MGU = 47 * MiB, WS_MD = 135 * MiB, WS_CW1 = 179 * MiB;
constexpr size_t WS_HN = 184 * MiB, WS_PROJ = 248 * MiB, WS_HID = 248 * MiB, WS_QN = 408 * MiB, WS_KSN = 440 * MiB, WS_KWN = 448 * MiB, WS_VST = 456 * MiB, WS_VWT = 464 * MiB, WS_MIX = 440 * MiB  , WS_FIN = 472 * MiB  , WS_XBUF = 440 * MiB, WS_END = 508 * MiB;
static_assert(WS_WIN + (size_t)DEPTH * NPROJ * D * 2 <= WS_WOUT && WS_FGU + (size_t)NGU * D * 2 <= WS_FD && WS_FD + (size_t)D * FF * 2 <= WS_MGU, "ws map 1");
static_assert(WS_MGU + (size_t)NE * NGU * D * 2 <= WS_MD && WS_MD + (size_t)NE * D * FF * 2 <= WS_CW1 && WS_CW1 + (size_t)4 * 128 * 2048 * 2 <= WS_HN, "ws map 2");
static_assert(WS_PROJ + (size_t)M * NPROJ * 2 <= WS_QN && WS_HID + (size_t)MOE_ROWS * FF * 2 <= WS_XBUF && WS_XBUF + (size_t)MOE_ROWS * D * 2 <= WS_END, "ws map 3");
constexpr int CW_BAR = 4096;
constexpr int CW_MOECNT = 16384;
constexpr int LDS_BYTES = 163840;
constexpr int MISC_OFF = LDS_BYTES - 256;

#define GAS __attribute__((address_space(1)))
#define LAS __attribute__((address_space(3)))
typedef unsigned short bf16;
typedef unsigned v4u __attribute__((ext_vector_type(4)));
typedef unsigned v2u __attribute__((ext_vector_type(2)));
typedef float f32x4 __attribute__((ext_vector_type(4)));
typedef short abf16x8 __attribute__((ext_vector_type(8)));
typedef float f32x16 __attribute__((ext_vector_type(16)));
#define LDS_WAIT() asm volatile("s_waitcnt lgkmcnt(0)" ::: "memory")
__device__ __forceinline__ unsigned f2bf(float f) { unsigned u = __builtin_bit_cast(unsigned, f); return (u + 0x7fffu + ((u >> 16) & 1u)) >> 16; }
__device__ __forceinline__ unsigned pk2(float lo, float hi) { return f2bf(lo) | (f2bf(hi) << 16); }
__device__ __forceinline__ float bf2f(bf16 v) { return __uint_as_float((unsigned)v << 16); }
__device__ __forceinline__ float bflo(unsigned w) { return __uint_as_float(w << 16); }
__device__ __forceinline__ float bfhi(unsigned w) { return __uint_as_float(w & 0xffff0000u); }
__device__ __forceinline__ float gelu_tanh(float x) { const float u = 0.7978845608028654f * (x + 0.044715f * x * x * x); const float e = __expf(2.0f * u); const float th = 1.0f - 2.0f / (e + 1.0f); return 0.5f * x * (1.0f + th); }
__device__ __forceinline__ float sigmoid_f(float x) { return 1.0f / (1.0f + __expf(-x)); }
__device__ __forceinline__ float wave_sum(float v) {
#pragma unroll
    for (int o = 1; o < 64; o <<= 1) v += __shfl_xor(v, o);
    return v;
}
__device__ const unsigned char T5_BUCKET[128] = {0, 1, 2, 3, 4, 5, 6, 7, 8, 9, 10, 11, 12, 13, 14, 15, 16, 16, 16, 17, 17, 18, 18, 18, 19, 19, 19, 20, 20, 20, 20, 21, 21, 21, 21, 22, 22, 22, 22, 22, 23, 23, 23, 23, 23, 23, 24, 24, 24, 24, 24, 24, 25, 25, 25, 25, 25, 25, 25, 26, 26, 26, 26, 26, 26, 26, 26, 27, 27, 27, 27, 27, 27, 27, 27, 27, 27, 28, 28, 28, 28, 28, 28, 28, 28, 28, 28, 29, 29, 29, 29, 29, 29, 29, 29, 29, 29, 29, 29, 30, 30, 30, 30, 30, 30, 30, 30, 30, 30, 30, 30, 30, 30, 31, 31, 31, 31, 31, 31, 31, 31, 31, 31, 31, 31, 31, 31, 31};

#define XB_TMO      128
#define XB_XCNT(j)  (256  + 64 * (j))
#define XB_XSUB(j)  (1280 + 64 * (j))
#define XB_XGEN(j)  (2304 + 64 * (j))
#define XB_TOP      3328
#define XB_TOPGEN   3392
#define XCD_BAR_WORDS 3456
#define XB_SPIN_CAP (1u << 18)

__device__ __forceinline__ unsigned xb_ld(unsigned* p)              { return __hip_atomic_load(p, __ATOMIC_RELAXED, __HIP_MEMORY_SCOPE_AGENT); }
__device__ __forceinline__ unsigned xb_add(unsigned* p, unsigned v) { return __hip_atomic_fetch_add(p, v, __ATOMIC_RELAXED, __HIP_MEMORY_SCOPE_AGENT); }
__device__ __forceinline__ unsigned xb_xcc_id() { return (unsigned)__builtin_amdgcn_s_getreg((3 << 11) | 20) & 0xFu; }
#define XB_SPIN(cond, bar) do { unsigned _sp = 0; while (cond) { __builtin_amdgcn_s_sleep(1); \
    if ((++_sp & 255u) == 0u) { if (xb_ld(&(bar)[XB_TMO])) break; if (_sp > XB_SPIN_CAP) { atomicAdd(&(bar)[XB_TMO], 1u); break; } } } } while (0)

struct XcdBarrier {
    unsigned* bar; unsigned x;
    volatile LAS unsigned* st;
};

__device__ __forceinline__ XcdBarrier xcd_barrier_post(unsigned* bar, volatile LAS unsigned* st) {
    XcdBarrier b; b.bar = bar; b.x = xb_xcc_id(); b.st = st;
    if (threadIdx.x == 0) (void)xb_add(&bar[XB_XCNT(b.x)], 1u);
    return b;
}
__device__ __forceinline__ void xcd_barrier_complete(unsigned* bar, unsigned x, unsigned& nloc, unsigned& nx) {
    const unsigned G = gridDim.x * gridDim.y * gridDim.z;
    unsigned sum, cnt, mine, sp = 0u;
    for (;;) {
        sum = 0u; cnt = 0u; mine = 0u;
#pragma unroll
        for (unsigned j = 0; j < 16; ++j) { const unsigned c = xb_ld(&bar[XB_XCNT(j)]); sum += c; cnt += (c > 0u) ? 1u : 0u; mine = (j == x) ? c : mine; }
        if (sum == G) break;
        __builtin_amdgcn_s_sleep(1);
        if ((++sp & 255u) == 0u) { if (xb_ld(&bar[XB_TMO])) break; if (sp > XB_SPIN_CAP) { atomicAdd(&bar[XB_TMO], 1u); break; } }
    }
    nloc = mine > 0u ? mine : 1u; nx = cnt > 0u ? cnt : 1u;
}

__device__ __forceinline__ void xcd_barrier(const XcdBarrier& b) {
    asm volatile("s_waitcnt vmcnt(0)" ::: "memory");
    __syncthreads();
    if (threadIdx.x == 0) {
        unsigned* bar = b.bar;
        __builtin_amdgcn_s_waitcnt(0);
        unsigned nloc = b.st[0], nx = b.st[1];
        if (nloc == 0u) { xcd_barrier_complete(bar, b.x, nloc, nx); b.st[0] = nloc; b.st[1] = nx; }
        const unsigned old = xb_add(&bar[XB_XSUB(b.x)], 1u);
        const unsigned gen = old / nloc;
        if (old + 1u == (gen + 1u) * nloc) {
            __builtin_amdgcn_fence(__ATOMIC_RELEASE, "agent");
            asm volatile("s_waitcnt vmcnt(0)" ::: "memory");
            const unsigned og = xb_add(&bar[XB_TOP], 1u);
            const unsigned tg = og / nx;
            if (og + 1u == (tg + 1u) * nx) xb_add(&bar[XB_TOPGEN], 1u);
            else XB_SPIN(xb_ld(&bar[XB_TOPGEN]) == tg, bar);
            __builtin_amdgcn_fence(__ATOMIC_ACQUIRE, "agent");
            xb_add(&bar[XB_XGEN(b.x)], 1u);
            asm volatile("s_waitcnt vmcnt(0)" ::: "memory");
        } else {
            XB_SPIN(xb_ld(&bar[XB_XGEN(b.x)]) == gen, bar);
            __builtin_amdgcn_fence(__ATOMIC_ACQUIRE, "agent");
            asm volatile("s_waitcnt vmcnt(0)" ::: "memory");
        }
    }
    __syncthreads();
}

struct Args { const float* in[27]; float* out; unsigned char* ws; int ph_lo, ph_hi, use_bar, pad; };
typedef const __attribute__((address_space(4))) Args KArgs;
__device__ __forceinline__ KArgs* kargs() { KArgs* p = (KArgs*)__builtin_amdgcn_kernarg_segment_ptr(); asm volatile("" : "+s"(p)); return p; }
#define INP(i) ((const float*)(kargs()->in[i]))
struct Ctx {
    LAS unsigned char* lds; unsigned char* ws; float* out;
    int tid, lane, wave, G, bid;
};
#define WSP(T, off) ((T*)(C.ws + (off)))

#ifndef INPROJ_FP8_MASK
#define INPROJ_FP8_MASK 2
#endif
#define INPROJ_FP8(l) (((INPROJ_FP8_MASK) >> (l)) & 1)
__device__ __forceinline__ void tr_item(const float* W, int N, bf16* WT, int ldt, int k0, int n0, int outrow0, LAS float* scr, int lane, const float* gain) {
    const int a = lane & 15, kq = lane >> 4; const int nn = n0 + 4 * a; const bool ok = nn < N;
    f32x4 v[16];
#pragma unroll
    for (int i = 0; i < 16; ++i) v[i] = ok ? *(const f32x4*)(W + (size_t)(k0 + 4 * i + kq) * N + nn) : (f32x4){0.f, 0.f, 0.f, 0.f};
#pragma unroll
    for (int i = 0; i < 16; ++i) { LAS float* d = scr + (4 * i + kq) * 65 + 4 * a; const float gk = gain ? gain[k0 + 4 * i + kq] : 1.0f; d[0] = v[i].x * gk; d[1] = v[i].y * gk; d[2] = v[i].z * gk; d[3] = v[i].w * gk; }
    LDS_WAIT(); asm volatile("" ::: "memory");
    const int c = lane & 7, nl = lane >> 3;
#pragma unroll
    for (int j = 0; j < 8; ++j) { const int n = nl + 8 * j; const LAS float* sp = scr + (8 * c) * 65 + n;
        v4u o; o.x = pk2(sp[0 * 65], sp[1 * 65]); o.y = pk2(sp[2 * 65], sp[3 * 65]); o.z = pk2(sp[4 * 65], sp[5 * 65]); o.w = pk2(sp[6 * 65], sp[7 * 65]);
        *(v4u*)(WT + (size_t)(outrow0 + n) * ldt + k0 + 8 * c) = o; }
    LDS_WAIT(); asm volatile("" ::: "memory");
}
__device__ __forceinline__ unsigned pk4_fp8(float a, float b, float c, float d) { int r = 0; r = __builtin_amdgcn_cvt_pk_fp8_f32(a, b, r, false); r = __builtin_amdgcn_cvt_pk_fp8_f32(c, d, r, true); return (unsigned)r; }
__device__ __forceinline__ void tr_item8(const float* W, int N, unsigned char* WT8, int ldt, int k0, int n0, int outrow0, LAS float* scr, int lane, const float* gain) {
    const int a = lane & 15, kq = lane >> 4; const int nn = n0 + 4 * a; const bool ok = nn < N;
    f32x4 v[16];
#pragma unroll
    for (int i = 0; i < 16; ++i) v[i] = ok ? *(const f32x4*)(W + (size_t)(k0 + 4 * i + kq) * N + nn) : (f32x4){0.f, 0.f, 0.f, 0.f};
#pragma unroll
    for (int i = 0; i < 16; ++i) { LAS float* d = scr + (4 * i + kq) * 65 + 4 * a; const float gk = gain ? 64.0f * gain[k0 + 4 * i + kq] : 64.0f; d[0] = v[i].x * gk; d[1] = v[i].y * gk; d[2] = v[i].z * gk; d[3] = v[i].w * gk; }
    LDS_WAIT(); asm volatile("" ::: "memory");
    const int c = lane & 7, nl = lane >> 3;
#pragma unroll
    for (int j = 0; j < 8; ++j) { const int n = nl + 8 * j; const LAS float* sp = scr + (8 * c) * 65 + n;
        v2u o; o.x = pk4_fp8(sp[0 * 65], sp[1 * 65], sp[2 * 65], sp[3 * 65]); o.y = pk4_fp8(sp[4 * 65], sp[5 * 65], sp[6 * 65], sp[7 * 65]);
        *(v2u*)(WT8 + (size_t)(outrow0 + n) * ldt + k0 + 8 * c) = o; }
    LDS_WAIT(); asm volatile("" ::: "memory");
}
__device__ __forceinline__ void tr_matrix(Ctx& C, const float* W, int K, int N, int NP, bf16* WT, int gu, int& cursor, const float* gain = nullptr, bool fp8 = false) {
    LAS float* scr = (LAS float*)(C.lds + C.wave * 16640);
    const int gw = C.bid * NWAVES + C.wave, NGW = C.G * NWAVES;
    const int nblk = NP / 64, nitems = (K / 64) * nblk;
    int first = (gw - (cursor % NGW) + NGW) % NGW;
    for (int it = first; it < nitems; it += NGW) {
        const int kb = it / nblk, nb = it % nblk, k0 = 64 * kb, n0 = 64 * nb;
        int orow = n0;
        if (gu) orow = (n0 / 128) * 256 + (n0 % 128) + (gu == 2 ? 128 : 0);
        if (fp8) tr_item8(W, N, (unsigned char*)WT, K, k0, n0, orow, scr, C.lane, gain); else tr_item(W, N, WT, K, k0, n0, orow, scr, C.lane, gain);
    }
    cursor += nitems;
}
__device__ __forceinline__ void rms_row_to_bf16(const float* xrow, const float* g, bf16* orow, int lane) {
    const f32x4* xr = (const f32x4*)xrow + lane; const f32x4* gr = (const f32x4*)g + lane;
    f32x4 v[4]; float s = 0.f;
#pragma unroll
    for (int j = 0; j < 4; ++j) { v[j] = xr[64 * j]; s += (v[j].x * v[j].x + v[j].y * v[j].y) + (v[j].z * v[j].z + v[j].w * v[j].w); }
    const float rstd = 1.0f / sqrtf(wave_sum(s) * (1.f / D) + RMS_EPS);
    unsigned long long* o8 = (unsigned long long*)orow + lane;
#pragma unroll
    for (int j = 0; j < 4; ++j) { const f32x4 gg = gr[64 * j]; o8[64 * j] = (unsigned long long)pk2(v[j].x * rstd * gg.x, v[j].y * rstd * gg.y) | ((unsigned long long)pk2(v[j].z * rstd * gg.z, v[j].w * rstd * gg.w) << 32); }
}
__device__ __forceinline__ void phase_norm(Ctx& C, const float* src, const float* g) {
    const int gw = C.bid * NWAVES + C.wave, NGW = C.G * NWAVES; bf16* HN = WSP(bf16, WS_HN);
    for (int m = gw; m < M; m += NGW) rms_row_to_bf16(src + (size_t)m * D, g, HN + (size_t)m * D, C.lane);
}
__device__ __forceinline__ void phase_prologue(Ctx& C) {
    const float* const out_norm_g = INP(17);
    const float* const norm2_g = INP(19);
    const float* const x = INP(0);
    const float* const rel_bias = INP(1);
    const float* const norm1_g = INP(2);
    const float* const w_in = INP(3);
    const float* const cmp_pos = INP(13);
    const float* const cmp_w1 = INP(14);
    const float* const w_out = INP(18);
    const float* const ffn_w_gate = INP(20);
    const float* const ffn_w_up = INP(21);
    const float* const ffn_w_down = INP(22);
    const float* const moe_w_gate = INP(24);
    const float* const moe_w_up = INP(25);
    const float* const moe_w_down = INP(26);
    int cur = 0;
    for (int l = 0; l < DEPTH; ++l) {
        tr_matrix(C, w_in + (size_t)l * D * D_IN, D, D_IN, NPROJ, WSP(bf16, WS_WIN) + (size_t)l * NPROJ * D, 0, cur, norm1_g + l * D, INPROJ_FP8(l));
        tr_matrix(C, w_out + (size_t)l * D * D, D, D, D, WSP(bf16, WS_WOUT) + (size_t)l * D * D, 0, cur, out_norm_g + l * D);
        for (int k = 0; k < 2; ++k) tr_matrix(C, cmp_w1 + (size_t)(l * 2 + k) * 2048 * 128, 2048, 128, 128, WSP(bf16, WS_CW1) + (size_t)(l * 2 + k) * 128 * 2048, 0, cur);
    }
    tr_matrix(C, ffn_w_gate, D, FF, FF, WSP(bf16, WS_FGU), 1, cur, norm2_g, true);
    tr_matrix(C, ffn_w_up, D, FF, FF, WSP(bf16, WS_FGU), 2, cur, norm2_g, true);
    tr_matrix(C, ffn_w_down, FF, D, D, WSP(bf16, WS_FD), 0, cur, nullptr, true);
    for (int e = 0; e < NE; ++e) {
        tr_matrix(C, moe_w_gate + (size_t)e * D * FF, D, FF, FF, (bf16*)(WSP(unsigned char, WS_MGU) + (size_t)e * NGU * D), 1, cur, norm2_g + D, true);
        tr_matrix(C, moe_w_up + (size_t)e * D * FF, D, FF, FF, (bf16*)(WSP(unsigned char, WS_MGU) + (size_t)e * NGU * D), 2, cur, norm2_g + D, true);
        tr_matrix(C, moe_w_down + (size_t)e * FF * D, FF, D, D, (bf16*)(WSP(unsigned char, WS_MD) + (size_t)e * D * FF), 0, cur, nullptr, true);
    }
    float* BT = WSP(float, WS_TAB); float* CB = WSP(float, WS_TAB + 8192);
    const int gt = C.bid * NTHR + C.tid, NGT = C.G * NTHR;
    for (int i = gt; i < NH * 128; i += NGT) { const int h = i >> 7, dd = i & 127; BT[i] = rel_bias[(int)T5_BUCKET[dd] * NH + h]; }
    if (gt < NH) { float mx = -3.0e38f; for (int bk = 0; bk < 32; ++bk) mx = fmaxf(mx, rel_bias[bk * NH + gt]); BT[NH * 128 + gt] = mx; }
    { const int gw = C.bid * NWAVES + C.wave, NGW = C.G * NWAVES;
      for (int i = gw; i < DEPTH * 2 * 128; i += NGW) { const int lk = i >> 7, c = i & 127; const float* pos = cmp_pos + (size_t)lk * 2048; const float* w1 = cmp_w1 + (size_t)lk * 2048 * 128 + c;
        float s = 0.f;
#pragma unroll 8
        for (int k = C.lane; k < 2048; k += 64) s += pos[k] * w1[(size_t)k * 128];
        s = wave_sum(s); if (C.lane == 0) CB[i] = s; } }
    { const float* const lwa = INP(6); const float* const lwx = INP(8); v4u* LWF = (v4u*)WSP(unsigned char, WS_TAB + 65536);
      for (int i = gt; i < DEPTH * 8 * 2 * 4 * 64; i += NGT) { const int ln = i & 63, ks = (i >> 6) & 3, nt = (i >> 8) & 1, lh = i >> 9, cl2 = ln & 31, hh2 = ln >> 5;
          const size_t o = ((size_t)lh * 64 + 16 * ks + 8 * hh2) * 64 + 32 * nt + cl2; const float* pa = lwa + o; const float* px = lwx + o;
          v4u a, x; a.x = pk2(pa[0], pa[64]); a.y = pk2(pa[128], pa[192]); a.z = pk2(pa[256], pa[320]); a.w = pk2(pa[384], pa[448]);
          x.x = pk2(px[0], px[64]); x.y = pk2(px[128], px[192]); x.z = pk2(px[256], px[320]); x.w = pk2(px[384], px[448]);
          LWF[2 * i] = a; LWF[2 * i + 1] = x; } }
    int* RT = WSP(int, WS_ROWTOK); float* RW = WSP(float, WS_ROWW);
    for (int i = gt; i < 2 * MOE_ROWS; i += NGT) { RT[i] = -1; RW[i] = 0.f; WSP(float, WS_ROWRS)[i] = 0.f; }
    { const int gw = C.bid * NWAVES + C.wave, NGW = C.G * NWAVES; bf16* XB = WSP(bf16, WS_HN); float* SSQ = WSP(float, WS_SSQ);
      for (int m0 = gw; m0 < M; m0 += 2 * NGW) {
          f32x4 v[2][4];
#pragma unroll
          for (int r = 0; r < 2; ++r) { const int m = m0 + r * NGW; const f32x4* xr = (const f32x4*)(x + (size_t)(m < M ? m : 0) * D) + C.lane;
#pragma unroll
              for (int j = 0; j < 4; ++j) v[r][j] = xr[64 * j]; }
#pragma unroll
          for (int r = 0; r < 2; ++r) { const int m = m0 + r * NGW; if (m >= M) break;
              float s2 = 0.f;
#pragma unroll
              for (int j = 0; j < 4; ++j) s2 += (v[r][j].x * v[r][j].x + v[r][j].y * v[r][j].y) + (v[r][j].z * v[r][j].z + v[r][j].w * v[r][j].w);
              s2 = wave_sum(s2);
              unsigned long long* o8 = (unsigned long long*)(XB + (size_t)m * D) + C.lane;
#pragma unroll
              for (int j = 0; j < 4; ++j) o8[64 * j] = (unsigned long long)pk2(v[r][j].x, v[r][j].y) | ((unsigned long long)pk2(v[r][j].z, v[r][j].w) << 32);
              if (C.lane < 16) SSQ[(size_t)m * 16 + C.lane] = (C.lane == 0) ? s2 : 0.f; } } }
}

__device__ __forceinline__ void prep_qknorm(Ctx& C, int l) {
    const float* const q_norm_g = INP(11);
    const float* const k_norm_g = INP(12);
    const int gw = C.bid * NWAVES + C.wave, NGW = C.G * NWAVES, lane = C.lane;
    const bf16* PROJ = WSP(bf16, WS_PROJ); bf16* QN = WSP(bf16, WS_QN); bf16* KSN = WSP(bf16, WS_KSN); bf16* KWN = WSP(bf16, WS_KWN);
    float qg[8], kg[8];
#pragma unroll
    for (int j = 0; j < 8; ++j) { qg[j] = 0.125f * q_norm_g[l * HD + (8 * lane) % 64 + j]; kg[j] = k_norm_g[l * HD + (8 * lane) % 64 + j]; }
    for (int m0 = gw; m0 < M; m0 += 4 * NGW) {
        v4u wq[4], wk[4];
        const int l32 = lane & 31; const int colk = (l32 < 16) ? (C_KS + 8 * l32) : (C_KW + 8 * (l32 - 16));
#pragma unroll
        for (int r = 0; r < 4; ++r) { const int m = m0 + r * NGW; const bf16* p = PROJ + (size_t)(m < M ? m : 0) * NPROJ; wq[r] = *(const v4u*)(p + C_Q + 8 * lane); wk[r] = *(const v4u*)(p + colk); }
#pragma unroll
        for (int r = 0; r < 4; ++r) {
            const int m = m0 + r * NGW; if (m >= M) break;
            const int b = m / SEQ, t = m % SEQ;
            {
                const v4u w = wq[r];
                float v[8] = {bflo(w.x), bfhi(w.x), bflo(w.y), bfhi(w.y), bflo(w.z), bfhi(w.z), bflo(w.w), bfhi(w.w)};
                float ss = 0.f;
#pragma unroll
                for (int j = 0; j < 8; ++j) ss += v[j] * v[j];
                ss += __shfl_xor(ss, 1); ss += __shfl_xor(ss, 2); ss += __shfl_xor(ss, 4);
                const float rstd = 1.0f / sqrtf(ss * (1.f / 64.f) + RMS_EPS);
                v4u o; o.x = pk2(v[0] * rstd * qg[0], v[1] * rstd * qg[1]); o.y = pk2(v[2] * rstd * qg[2], v[3] * rstd * qg[3]); o.z = pk2(v[4] * rstd * qg[4], v[5] * rstd * qg[5]); o.w = pk2(v[6] * rstd * qg[6], v[7] * rstd * qg[7]);
                *(v4u*)(QN + (size_t)m * 512 + 8 * lane) = o;
            }
            {
                const v4u w = wk[r];
                float v[8] = {bflo(w.x), bfhi(w.x), bflo(w.y), bfhi(w.y), bflo(w.z), bfhi(w.z), bflo(w.w), bfhi(w.w)};
                float ss = 0.f;
#pragma unroll
                for (int j = 0; j < 8; ++j) ss += v[j] * v[j];
                ss += __shfl_xor(ss, 1); ss += __shfl_xor(ss, 2); ss += __shfl_xor(ss, 4);
                const float rstd = 1.0f / sqrtf(ss * (1.f / 64.f) + RMS_EPS);
                v4u o; o.x = pk2(v[0] * rstd * kg[0], v[1] * rstd * kg[1]); o.y = pk2(v[2] * rstd * kg[2], v[3] * rstd * kg[3]); o.z = pk2(v[4] * rstd * kg[4], v[5] * rstd * kg[5]); o.w = pk2(v[6] * rstd * kg[6], v[7] * rstd * kg[7]);
                const int g = (l32 >> 3) & 1, dd = 8 * (l32 & 7);
                if (lane < 16) *(v4u*)(KSN + ((size_t)(b * NG + g) * SEQ + t) * HD + dd) = o;
                else if (lane < 32) *(v4u*)(KWN + ((size_t)(b * NG + g) * SEQ + t) * HD + dd) = o;
            }
        }
    }
    {
        bf16* VST = WSP(bf16, WS_VST); bf16* VWT = WSP(bf16, WS_VWT);
        const int mi = C.wave & 3, dh = C.wave >> 2, g = mi & 1; const int col = ((mi >> 1) ? C_VW : C_VS) + g * HD + dh * 32; bf16* dstm = (mi >> 1) ? VWT : VST;
        for (int it = C.bid; it < BATCH * (SEQ / 64); it += C.G) {
            const int b = it / (SEQ / 64), t0 = (it % (SEQ / 64)) * 64;
            const v4u* src = (const v4u*)(PROJ + (size_t)(b * SEQ + t0 + lane) * NPROJ + col);
            bf16* dst = dstm + ((size_t)(b * NG + g) * HD + dh * 32) * SEQ + t0 + lane;
#pragma unroll
            for (int c = 0; c < 4; ++c) { const v4u w = src[c];
                dst[(size_t)(8 * c + 0) * SEQ] = (bf16)(w.x & 0xffffu); dst[(size_t)(8 * c + 1) * SEQ] = (bf16)(w.x >> 16); dst[(size_t)(8 * c + 2) * SEQ] = (bf16)(w.y & 0xffffu); dst[(size_t)(8 * c + 3) * SEQ] = (bf16)(w.y >> 16);
                dst[(size_t)(8 * c + 4) * SEQ] = (bf16)(w.z & 0xffffu); dst[(size_t)(8 * c + 5) * SEQ] = (bf16)(w.z >> 16); dst[(size_t)(8 * c + 6) * SEQ] = (bf16)(w.w & 0xffffu); dst[(size_t)(8 * c + 7) * SEQ] = (bf16)(w.w >> 16); }
        }
    }
}
constexpr int CMP_HP = 136;
__device__ __forceinline__ void prep_compress(Ctx& C, int l) {
    const float* const k_norm_g = INP(12);
    const float* const cmp_w2 = INP(15);
    const bf16* PROJ = WSP(bf16, WS_PROJ); const float* CB = WSP(float, WS_TAB + 8192); const bf16* W1T = WSP(bf16, WS_CW1);
    LAS float* RED = (LAS float*)C.lds;
    LAS bf16* HL = (LAS bf16*)(C.lds + 16384);
    const int lane = C.lane, w = C.wave, mc = w & 3, kh = w >> 2, cl = lane & 31, hh = lane >> 5;
    for (int it = C.bid; it < 16 * 16; it += C.G) {
        const int rt = it & 15, kind = (it >> 4) & 1, g = (it >> 5) & 1, b = it >> 6, bg = b * NG + g, n0 = 32 * rt;
        const int col0 = (kind ? C_VC : C_KC) + g * HD;
        f32x16 acc;
#pragma unroll
        for (int i = 0; i < 16; ++i) acc[i] = 0.f;
        {
            const bf16* ap = W1T + ((size_t)(l * 2 + kind) * 128 + 32 * mc + cl) * 2048 + 1024 * kh + 8 * hh;
            const bf16* xb = PROJ + (size_t)b * SEQ * NPROJ + col0 + 8 * hh; const int tau0 = 16 * (n0 + cl) + 16 * kh;
#pragma unroll 2
            for (int q = 0; q < 16; ++q) {
                int tau = tau0 + q; tau = tau < SEQ ? tau : SEQ - 1;
                const bf16* xp = xb + (size_t)tau * NPROJ;
                abf16x8 af[4], bfr[4];
#pragma unroll
                for (int j = 0; j < 4; ++j) { af[j] = *(const abf16x8*)(ap + 64 * q + 16 * j); bfr[j] = *(const abf16x8*)(xp + 16 * j); }
#pragma unroll
                for (int j = 0; j < 4; ++j) acc = __builtin_amdgcn_mfma_f32_32x32x16_bf16(af[j], bfr[j], acc, 0, 0, 0);
            }
        }
        if (kh == 1) {
#pragma unroll
            for (int i = 0; i < 16; ++i) RED[(mc * 16 + i) * 64 + lane] = acc[i];
        }
        __syncthreads();
        if (kh == 0) {
#pragma unroll
            for (int i = 0; i < 16; ++i) { const int c = 32 * mc + (i & 3) + 8 * (i >> 2) + 4 * hh;
                const float s = acc[i] + RED[(mc * 16 + i) * 64 + lane] + CB[(l * 2 + kind) * 128 + c];
                HL[cl * CMP_HP + c] = (bf16)f2bf(gelu_tanh(s)); }
        }
        __syncthreads();
        if (w == 0) {
            f32x16 o[2];
#pragma unroll
            for (int i = 0; i < 16; ++i) { o[0][i] = 0.f; o[1][i] = 0.f; }
            const float* w2 = cmp_w2 + (size_t)(l * 2 + kind) * 128 * 64;
#pragma unroll
            for (int s = 0; s < 8; ++s) {
                const abf16x8 hb = *(const LAS abf16x8*)(HL + cl * CMP_HP + 16 * s + 8 * hh);
#pragma unroll
                for (int mt = 0; mt < 2; ++mt) { const float* p = w2 + (size_t)(16 * s + 8 * hh) * 64 + 32 * mt + cl;
                    v4u a; a.x = pk2(p[0], p[64]); a.y = pk2(p[128], p[192]); a.z = pk2(p[256], p[320]); a.w = pk2(p[384], p[448]);
                    o[mt] = __builtin_amdgcn_mfma_f32_32x32x16_bf16(__builtin_bit_cast(abf16x8, a), hb, o[mt], 0, 0, 0); }
            }
            const int n = n0 + cl; const bool okn = n < NCMP;
            if (kind == 0) {
                float ss = 0.f;
#pragma unroll
                for (int i = 0; i < 16; ++i) ss += o[0][i] * o[0][i] + o[1][i] * o[1][i];
                ss += __shfl_xor(ss, 32);
                const float rstd = 1.0f / sqrtf(ss * (1.f / 64.f) + RMS_EPS);
                bf16* dst = WSP(bf16, WS_KC) + ((size_t)bg * NCMPP + n) * HD;
#pragma unroll
                for (int mt = 0; mt < 2; ++mt)
#pragma unroll
                    for (int q4 = 0; q4 < 4; ++q4) { const int d0 = 32 * mt + 8 * q4 + 4 * hh; const float* kg = k_norm_g + l * HD + d0;
                        v2u ov; ov.x = okn ? pk2(o[mt][4 * q4] * rstd * kg[0], o[mt][4 * q4 + 1] * rstd * kg[1]) : 0u; ov.y = okn ? pk2(o[mt][4 * q4 + 2] * rstd * kg[2], o[mt][4 * q4 + 3] * rstd * kg[3]) : 0u;
                        *(v2u*)(dst + d0) = ov; }
            } else {
                bf16* dst = WSP(bf16, WS_VC) + (size_t)bg * HD * NCMPP + n;
#pragma unroll
                for (int mt = 0; mt < 2; ++mt)
#pragma unroll
                    for (int i = 0; i < 16; ++i) { const int dd = 32 * mt + (i & 3) + 8 * (i >> 2) + 4 * hh; dst[(size_t)dd * NCMPP] = okn ? (bf16)f2bf(o[mt][i]) : (bf16)0; }
            }
        }
    }
    __syncthreads();
}
__device__ __forceinline__ void mixnorm_row(const bf16* PROJ, bf16* MIX, const float (&g1)[8], const float (&g2)[8], size_t m, int lane) {
    const bf16* p = PROJ + m * NPROJ;
    const v4u w1 = *(const v4u*)(p + C_LG + 8 * lane), w2 = *(const v4u*)(p + C_Q + 8 * lane);
    float a[8] = {bflo(w1.x), bfhi(w1.x), bflo(w1.y), bfhi(w1.y), bflo(w1.z), bfhi(w1.z), bflo(w1.w), bfhi(w1.w)};
    float c[8] = {bflo(w2.x), bfhi(w2.x), bflo(w2.y), bfhi(w2.y), bflo(w2.z), bfhi(w2.z), bflo(w2.w), bfhi(w2.w)};
    float sa = 0.f, sc = 0.f;
#pragma unroll
    for (int j = 0; j < 8; ++j) { sa += a[j] * a[j]; sc += c[j] * c[j]; }
    const float ra = 1.0f / sqrtf(wave_sum(sa) * (1.f / 512.f) + RMS_EPS), rc = 1.0f / sqrtf(wave_sum(sc) * (1.f / 512.f) + RMS_EPS);
    v4u o1, o2;
    o1.x = pk2(a[0] * ra * g1[0], a[1] * ra * g1[1]); o1.y = pk2(a[2] * ra * g1[2], a[3] * ra * g1[3]); o1.z = pk2(a[4] * ra * g1[4], a[5] * ra * g1[5]); o1.w = pk2(a[6] * ra * g1[6], a[7] * ra * g1[7]);
    o2.x = pk2(c[0] * rc * g2[0], c[1] * rc * g2[1]); o2.y = pk2(c[2] * rc * g2[2], c[3] * rc * g2[3]); o2.z = pk2(c[4] * rc * g2[4], c[5] * rc * g2[5]); o2.w = pk2(c[6] * rc * g2[6], c[7] * rc * g2[7]);
    *(v4u*)(MIX + m * D + 8 * lane) = o1; *(v4u*)(MIX + m * D + 512 + 8 * lane) = o2;
}
constexpr int LRU_XC_LD = 72;
template <int PASS>
__device__ __forceinline__ void lru_chunks(Ctx& C, int l) {
    const float* const conv_w = INP(4);
    const float* const conv_b = INP(5);
    const float* const lru_wa = INP(6);
    const float* const lru_ba = INP(7);
    const float* const lru_wx = INP(8);
    const float* const lru_bx = INP(9);
    const float* const lru_lambda = INP(10);
    bf16* PROJ = WSP(bf16, WS_PROJ); float* AGGA = WSP(float, WS_AGGA); float* AGGH = WSP(float, WS_AGGH); const float* HIN = WSP(float, WS_HIN);
    const int lane = C.lane, h = C.wave, d = h * 64 + lane, hh = lane >> 5, cl = lane & 31;
    LAS bf16* XC = (LAS bf16*)(C.lds + h * (64 * LRU_XC_LD * 2));
    LAS bf16* GT = (LAS bf16*)(C.lds + 8 * (64 * LRU_XC_LD * 2) + h * (64 * LRU_XC_LD * 2));
    abf16x8 Wa[2][4], Wx[2][4];
    { const v4u* LWF = (const v4u*)WSP(unsigned char, WS_TAB + 65536);
#pragma unroll
      for (int nt = 0; nt < 2; ++nt)
#pragma unroll
        for (int ks = 0; ks < 4; ++ks) { const int e = ((((l * 8 + h) * 2 + nt) * 4 + ks) * 64 + lane) * 2; Wa[nt][ks] = __builtin_bit_cast(abf16x8, LWF[e]); Wx[nt][ks] = __builtin_bit_cast(abf16x8, LWF[e + 1]); } }
    float ba[2], bx[2], c8[2];
#pragma unroll
    for (int nt = 0; nt < 2; ++nt) { const int ch = l * D_LRU + h * 64 + 32 * nt + cl; ba[nt] = lru_ba[ch]; bx[nt] = lru_bx[ch]; c8[nt] = -8.0f * log1pf(__expf(-lru_lambda[ch])); }
    const float cw0 = conv_w[(l * 4 + 0) * D_LRU + d], cw1 = conv_w[(l * 4 + 1) * D_LRU + d], cw2 = conv_w[(l * 4 + 2) * D_LRU + d], cw3 = conv_w[(l * 4 + 3) * D_LRU + d];
    const float cb = conv_b[l * D_LRU + d];
    for (int u = C.bid; u < BATCH * NCHUNK; u += C.G) {
        const int b = u / NCHUNK, ch = u % NCHUNK, t0 = ch * LCH;
        {
            const bf16* xp = PROJ + (size_t)(b * SEQ + t0) * NPROJ + C_LX + d;
            float xm3 = 0.f, xm2 = 0.f, xm1 = 0.f;
            if (t0 > 0) { xm3 = bf2f(xp[-3 * NPROJ]); xm2 = bf2f(xp[-2 * NPROJ]); xm1 = bf2f(xp[-1 * NPROJ]); }
#pragma unroll
            for (int t32 = 0; t32 < LCH; t32 += 32) {
                unsigned xr[32], gr[PASS == 2 ? 32 : 1];
#pragma unroll
                for (int tt = 0; tt < 32; ++tt) { xr[tt] = (unsigned)xp[(size_t)(t32 + tt) * NPROJ]; if (PASS == 2) gr[tt] = (unsigned)xp[(size_t)(t32 + tt) * NPROJ + (C_LG - C_LX)]; }
                asm volatile("" ::: "memory");
#pragma unroll
                for (int tt = 0; tt < 32; ++tt) {
                    const float x0 = __uint_as_float(xr[tt] << 16);
                    if (PASS == 2) GT[(t32 + tt) * LRU_XC_LD + lane] = (bf16)gr[tt];
                    const float xc = cw0 * xm3 + cw1 * xm2 + cw2 * xm1 + cw3 * x0 + cb;
                    xm3 = xm2; xm2 = xm1; xm1 = x0;
                    XC[(t32 + tt) * LRU_XC_LD + lane] = (bf16)f2bf(xc);
                }
                asm volatile("" ::: "memory");
            }
        }
        float st[2], ap[2];
#pragma unroll
        for (int nt = 0; nt < 2; ++nt) { st[nt] = (PASS == 2) ? HIN[(size_t)(b * NCHUNK + ch) * D_LRU + h * 64 + 32 * nt + cl] : 0.f; ap[nt] = 1.f; }
        bf16* gbase = PROJ + (size_t)(b * SEQ + t0) * NPROJ + C_LG + h * 64;
#pragma unroll 1
        for (int mt = 0; mt < 2; ++mt) {
            const int goff = (32 * mt + 4 * hh) * NPROJ + cl;
            abf16x8 af[4];
#pragma unroll
            for (int ks = 0; ks < 4; ++ks) af[ks] = *(const LAS abf16x8*)(XC + (32 * mt + cl) * LRU_XC_LD + 16 * ks + 8 * hh);
#pragma unroll
            for (int nt = 0; nt < 2; ++nt) {
                f32x16 R, I;
#pragma unroll
                for (int i = 0; i < 16; ++i) { R[i] = 0.f; I[i] = 0.f; }
#pragma unroll
                for (int ks = 0; ks < 4; ++ks) { R = __builtin_amdgcn_mfma_f32_32x32x16_bf16(af[ks], Wa[nt][ks], R, 0, 0, 0); I = __builtin_amdgcn_mfma_f32_32x32x16_bf16(af[ks], Wx[nt][ks], I, 0, 0, 0); }
                float a[16], uu[16];
#pragma unroll
                for (int i = 0; i < 16; ++i) {
                    const int tok = 32 * mt + (i & 3) + 8 * (i >> 2) + 4 * hh;
                    const float xc = bf2f(XC[tok * LRU_XC_LD + 32 * nt + cl]);
                    const float r = __builtin_amdgcn_rcpf(1.0f + __builtin_amdgcn_exp2f(-1.44269504089f * (R[i] + ba[nt])));
                    const float ig = __builtin_amdgcn_rcpf(1.0f + __builtin_amdgcn_exp2f(-1.44269504089f * (I[i] + bx[nt])));
                    const float av = __builtin_amdgcn_exp2f(1.44269504089f * c8[nt] * r);
                    a[i] = av; uu[i] = __builtin_amdgcn_sqrtf(fmaxf(1.0f - av * av, 0.f)) * (ig * xc);
                }
                float Ak[4], Uk[4], pA[4], pU[4], cin[4];
#pragma unroll
                for (int k = 0; k < 4; ++k) { Ak[k] = (a[4 * k] * a[4 * k + 1]) * (a[4 * k + 2] * a[4 * k + 3]); float v = uu[4 * k]; v = a[4 * k + 1] * v + uu[4 * k + 1]; v = a[4 * k + 2] * v + uu[4 * k + 2]; v = a[4 * k + 3] * v + uu[4 * k + 3]; Uk[k] = v; }
#pragma unroll
                for (int k = 0; k < 4; ++k) { pA[k] = __shfl_xor(Ak[k], 32); pU[k] = __shfl_xor(Uk[k], 32); }
                float s = st[nt];
#pragma unroll
                for (int k = 0; k < 4; ++k) {
                    const float A0 = hh ? pA[k] : Ak[k], U0 = hh ? pU[k] : Uk[k], A1 = hh ? Ak[k] : pA[k], U1 = hh ? Uk[k] : pU[k];
                    const float mid = A0 * s + U0;
                    cin[k] = hh ? mid : s;
                    s = A1 * mid + U1;
                    ap[nt] *= A0 * A1;
                }
                st[nt] = s;
                if (PASS == 2) {
#pragma unroll
                    for (int k = 0; k < 4; ++k) { float v = cin[k];
#pragma unroll
                        for (int j = 0; j < 4; ++j) { const int i = 4 * k + j; v = a[i] * v + uu[i];
                            const int gi = goff + (j + 8 * k) * NPROJ + 32 * nt;
                            const float gt = bf2f(GT[(32 * mt + j + 8 * k + 4 * hh) * LRU_XC_LD + 32 * nt + cl]); const bf16 yb = (bf16)f2bf(gelu_tanh(gt) * v); gbase[gi] = yb;
                            XC[(32 * mt + j + 8 * k + 4 * hh) * LRU_XC_LD + 32 * nt + cl] = yb; }
                        asm volatile("" ::: "memory"); }
                }
            }
        }
        if (PASS == 1) {
#pragma unroll
            for (int nt = 0; nt < 2; ++nt) { AGGA[(size_t)(b * NCHUNK + ch) * D_LRU + h * 64 + 32 * nt + cl] = ap[nt]; AGGH[(size_t)(b * NCHUNK + ch) * D_LRU + h * 64 + 32 * nt + cl] = st[nt]; }
        } else {
            { const LAS v4u* xr = (const LAS v4u*)(XC + lane * LRU_XC_LD); float ss = 0.f;
#pragma unroll
              for (int c8 = 0; c8 < 8; ++c8) { const v4u q = xr[c8]; ss += (bflo(q.x) * bflo(q.x) + bfhi(q.x) * bfhi(q.x)) + (bflo(q.y) * bflo(q.y) + bfhi(q.y) * bfhi(q.y)) + (bflo(q.z) * bflo(q.z) + bfhi(q.z) * bfhi(q.z)) + (bflo(q.w) * bflo(q.w) + bfhi(q.w) * bfhi(q.w)); }
              WSP(float, WS_SSQL)[((size_t)b * SEQ + t0 + lane) * 8 + h] = ss; }
        }
    }
}
__device__ __forceinline__ void lru_carry(Ctx& C) {
    const float* __restrict__ AGGA = WSP(float, WS_AGGA); const float* __restrict__ AGGH = WSP(float, WS_AGGH); float* __restrict__ HIN = WSP(float, WS_HIN);
    const int gt = C.bid * NTHR + C.tid;
    if (gt < BATCH * D_LRU) {
        const int b = gt / D_LRU, d = gt % D_LRU; float hs = 0.f;
        for (int c0 = 0; c0 < NCHUNK; c0 += 16) {
            float a[16], hh[16];
#pragma unroll
            for (int i = 0; i < 16; ++i) { a[i] = AGGA[(size_t)(b * NCHUNK + c0 + i) * D_LRU + d]; hh[i] = AGGH[(size_t)(b * NCHUNK + c0 + i) * D_LRU + d]; }
#pragma unroll
            for (int i = 0; i < 16; ++i) { HIN[(size_t)(b * NCHUNK + c0 + i) * D_LRU + d] = hs; hs = a[i] * hs + hh[i]; }
        }
    }
}

constexpr int ATT_KB = 0, ATT_VB = 32768, ATT_CK = 0, ATT_CV = 8192, ATT_IMP = 16384, ATT_IMP_LD = 132, ATT_OACC = 65536, ATT_OACC_LD = 65,
              ATT_L = ATT_OACC + 256 * ATT_OACC_LD * 4, ATT_LIST = ATT_L + 1024, ATT_CNT = ATT_LIST + 128 * 64, ATT_M2F = ATT_CNT + 512, ATT_M2R = ATT_M2F + 1024, ATT_END1 = ATT_M2R + 1024,
              ATT_BT = ATT_IMP + 256 * ATT_IMP_LD * 4, ATT_SELM = ATT_BT + 4 * 128 * 4, ATT_RL = ATT_SELM + 64 * 16, ATT_END = ATT_RL + 1024;
static_assert(ATT_END1 <= ATT_BT, "att lds overlay");
static_assert(ATT_END <= MISC_OFF, "att lds");
template <int CTRL> __device__ __forceinline__ unsigned dpp_u(unsigned v) { return (unsigned)__builtin_amdgcn_update_dpp((int)v, (int)v, CTRL, 0xF, 0xF, false); }
template <int CTRL> __device__ __forceinline__ float dpp_f(float v) { return __int_as_float(__builtin_amdgcn_update_dpp(__float_as_int(v), __float_as_int(v), CTRL, 0xF, 0xF, false)); }
__device__ __forceinline__ float quad_sum(float v) { v += dpp_f<0xB1>(v); v += dpp_f<0x4E>(v); return v; }
__device__ __forceinline__ unsigned row16_max(unsigned v) { unsigned t; t = dpp_u<0x128>(v); v = v > t ? v : t; t = dpp_u<0x124>(v); v = v > t ? v : t; t = dpp_u<0x122>(v); v = v > t ? v : t; t = dpp_u<0x121>(v); v = v > t ? v : t; return v; }
__device__ __forceinline__ unsigned row16_or(unsigned v) { v |= dpp_u<0x128>(v); v |= dpp_u<0x124>(v); v |= dpp_u<0x122>(v); v |= dpp_u<0x121>(v); return v; }

struct AttLane {
    int t, h, hl, tokl;
    unsigned koff0, voff0;
    const LAS float* btl;
};
#define BZ_PIN(b) asm volatile("" : "+v"(b[0]), "+v"(b[1]), "+v"(b[2]), "+v"(b[3]), "+v"(b[4]), "+v"(b[5]), "+v"(b[6]), "+v"(b[7]), "+v"(b[8]), "+v"(b[9]), "+v"(b[10]), "+v"(b[11]), "+v"(b[12]), "+v"(b[13]), "+v"(b[14]), "+v"(b[15]))
__device__ __forceinline__ void att_qk(const LAS unsigned char* Kb, const abf16x8 (&Qf)[4], const AttLane& A, f32x16& S0, f32x16& S1) {
    const f32x16 z = {0.f, 0.f, 0.f, 0.f, 0.f, 0.f, 0.f, 0.f, 0.f, 0.f, 0.f, 0.f, 0.f, 0.f, 0.f, 0.f};
    abf16x8 a0[4], a1[4];
#pragma unroll
    for (int ks = 0; ks < 4; ++ks) { a0[ks] = *(const LAS abf16x8*)(Kb + (A.koff0 ^ ((unsigned)(ks) << 5))); a1[ks] = *(const LAS abf16x8*)(Kb + 4096 + (A.koff0 ^ ((unsigned)(ks) << 5))); }
    S0 = __builtin_amdgcn_mfma_f32_32x32x16_bf16(a0[0], Qf[0], z, 0, 0, 0); S1 = __builtin_amdgcn_mfma_f32_32x32x16_bf16(a1[0], Qf[0], z, 0, 0, 0);
#pragma unroll
    for (int ks = 1; ks < 4; ++ks) { S0 = __builtin_amdgcn_mfma_f32_32x32x16_bf16(a0[ks], Qf[ks], S0, 0, 0, 0); S1 = __builtin_amdgcn_mfma_f32_32x32x16_bf16(a1[ks], Qf[ks], S1, 0, 0, 0); }
}
template <bool SLOW, bool WIN, int MODE>
__device__ __forceinline__ void att_sm(const f32x16& S0, const f32x16& S1, const AttLane& A, unsigned (&Pk)[2][8], float& lsum, const float m2, const int kp0, const int kstride, LAS float* improw, const int gbase, float& icar) {
    const float c1 = 1.44269504089f;
    const int dbase = A.t - kp0 - kstride * 8 * A.h;
#pragma unroll
    for (int st = 0; st < 2; ++st) {
        float p[16];
        float bz[16];
        if (SLOW) {
#pragma unroll
            for (int i = 0; i < 16; ++i) { const int dist = dbase - kstride * (32 * st + 16 * (i >> 3) + (i & 7)); bz[i] = A.btl[dist < 0 ? 0 : (dist > 127 ? 127 : dist)]; }
            BZ_PIN(bz);
        }
#pragma unroll
        for (int i = 0; i < 16; ++i) {
            const float sv = st ? S1[i] : S0[i];
            if (SLOW) {
                const int dist = dbase - kstride * (32 * st + 16 * (i >> 3) + (i & 7));
                bool valid = dist >= 0; if (WIN) valid = valid && (dist < 512);
                const float x = (sv + bz[i]) * c1 - m2;
                const float e = __builtin_amdgcn_exp2f(x);
                p[i] = valid ? e : 0.f;
            } else {
                p[i] = __builtin_amdgcn_exp2f(sv * c1 - m2);
            }
            lsum += p[i];
        }
        if (MODE >= 1) {
#pragma unroll
            for (int i = 0; i < 8; ++i) Pk[st][i] = pg8::cvt_pk_bf16(p[2 * i], p[2 * i + 1]);
        }
        if (MODE == 3) {
            float a[4], c[4];
#pragma unroll
            for (int u = 0; u < 4; ++u) { c[u] = 0.5f * p[4 * u + 3]; a[u] = (p[4 * u] + p[4 * u + 1]) + (p[4 * u + 2] + c[u]); }
            const float pc1 = __shfl_xor(c[1], 32), pc3 = __shfl_xor(c[3], 32);
            typedef float f32x2s __attribute__((ext_vector_type(2)));
            f32x2s w0, w1; w0.x = a[0] + (A.h ? pc1 : icar); w0.y = a[1] + c[0]; w1.x = a[2] + (A.h ? pc3 : pc1); w1.y = a[3] + c[2];
            icar = pc3;
            *(LAS f32x2s*)(improw + gbase + 8 * st) = w0; *(LAS f32x2s*)(improw + gbase + 8 * st + 4) = w1;
        }
        if (MODE == 2) {
#pragma unroll
            for (int u = 0; u < 4; ++u) {
                const float c = 0.5f * p[4 * u + 3];
                const float a = quad_sum((p[4 * u] + p[4 * u + 1]) + (p[4 * u + 2] + c)); const float cs = quad_sum(c);
                const int G = gbase + 8 * st + 4 * (u >> 1) + (u & 1);
                if (A.hl == 0) { (void)__builtin_amdgcn_ds_faddf(improw + G, a, 0, 0, false); if (G + 1 < NSELB) (void)__builtin_amdgcn_ds_faddf(improw + G + 1, cs, 0, 0, false); }
            }
        }
    }
}
__device__ __forceinline__ void att_pv(const LAS unsigned char* Vb, const AttLane& A, const unsigned (&Pk)[2][8], f32x16 (&O)[2]) {
#pragma unroll
    for (int s4 = 0; s4 < 4; ++s4) {
        typedef unsigned u4v __attribute__((ext_vector_type(4)));
        u4v pw; pw.x = Pk[s4 >> 1][4 * (s4 & 1) + 0]; pw.y = Pk[s4 >> 1][4 * (s4 & 1) + 1]; pw.z = Pk[s4 >> 1][4 * (s4 & 1) + 2]; pw.w = Pk[s4 >> 1][4 * (s4 & 1) + 3];
        const abf16x8 pb = __builtin_bit_cast(abf16x8, pw);
        const abf16x8 v0 = *(const LAS abf16x8*)(Vb + (A.voff0 ^ ((unsigned)(s4) << 5))); const abf16x8 v1 = *(const LAS abf16x8*)(Vb + 4096 + (A.voff0 ^ ((unsigned)(s4) << 5)));
        O[0] = __builtin_amdgcn_mfma_f32_32x32x16_bf16(v0, pb, O[0], 0, 0, 0); O[1] = __builtin_amdgcn_mfma_f32_32x32x16_bf16(v1, pb, O[1], 0, 0, 0);
    }
}
__device__ __forceinline__ void att_qk_half(const LAS unsigned char* Kb, const int st, const abf16x8 (&Qf)[4], const AttLane& A, f32x16& S) {
    const f32x16 z = {0.f, 0.f, 0.f, 0.f, 0.f, 0.f, 0.f, 0.f, 0.f, 0.f, 0.f, 0.f, 0.f, 0.f, 0.f, 0.f};
    abf16x8 a[4];
#pragma unroll
    for (int ks = 0; ks < 4; ++ks) a[ks] = *(const LAS abf16x8*)(Kb + st * 4096 + (A.koff0 ^ ((unsigned)(ks) << 5)));
    S = __builtin_amdgcn_mfma_f32_32x32x16_bf16(a[0], Qf[0], z, 0, 0, 0);
#pragma unroll
    for (int ks = 1; ks < 4; ++ks) S = __builtin_amdgcn_mfma_f32_32x32x16_bf16(a[ks], Qf[ks], S, 0, 0, 0);
}
template <bool SLOW, bool WIN>
__device__ __forceinline__ void att_sm_half(const f32x16& S, const int st, const AttLane& A, unsigned (&Pk)[8], float& lsum, const float m2, const int kp0) {
    const float c1 = 1.44269504089f;
    const int dbase = A.t - kp0 - 8 * A.h - 32 * st;
    float p[16];
    float bz[16];
    if (SLOW) {
#pragma unroll
        for (int i = 0; i < 16; ++i) { const int dist = dbase - (16 * (i >> 3) + (i & 7)); bz[i] = A.btl[dist < 0 ? 0 : (dist > 127 ? 127 : dist)]; }
        BZ_PIN(bz);
    }
#pragma unroll
    for (int i = 0; i < 16; ++i) {
        if (SLOW) {
            const int dist = dbase - (16 * (i >> 3) + (i & 7));
            const float e = __builtin_amdgcn_exp2f((S[i] + bz[i]) * c1 - m2);
            bool valid = dist >= 0; if (WIN) valid = valid && (dist < 512);
            p[i] = valid ? e : 0.f;
        } else p[i] = __builtin_amdgcn_exp2f(S[i] * c1 - m2);
        lsum += p[i];
    }
#pragma unroll
    for (int i = 0; i < 8; ++i) Pk[i] = pg8::cvt_pk_bf16(p[2 * i], p[2 * i + 1]);
}
template <bool ZERO = false>
__device__ __forceinline__ void att_pv_half(const LAS unsigned char* Vb, const int st, const AttLane& A, const unsigned (&Pk)[8], f32x16 (&O)[2]) {
    const f32x16 z = {0.f, 0.f, 0.f, 0.f, 0.f, 0.f, 0.f, 0.f, 0.f, 0.f, 0.f, 0.f, 0.f, 0.f, 0.f, 0.f};
#pragma unroll
    for (int u = 0; u < 2; ++u) {
        typedef unsigned u4v __attribute__((ext_vector_type(4)));
        u4v pw; pw.x = Pk[4 * u + 0]; pw.y = Pk[4 * u + 1]; pw.z = Pk[4 * u + 2]; pw.w = Pk[4 * u + 3];
        const abf16x8 pb = __builtin_bit_cast(abf16x8, pw);
        const abf16x8 v0 = *(const LAS abf16x8*)(Vb + (A.voff0 ^ ((unsigned)(2 * st + u) << 5))); const abf16x8 v1 = *(const LAS abf16x8*)(Vb + 4096 + (A.voff0 ^ ((unsigned)(2 * st + u) << 5)));
        O[0] = __builtin_amdgcn_mfma_f32_32x32x16_bf16(v0, pb, (ZERO && u == 0) ? z : O[0], 0, 0, 0); O[1] = __builtin_amdgcn_mfma_f32_32x32x16_bf16(v1, pb, (ZERO && u == 0) ? z : O[1], 0, 0, 0);
    }
}
template <bool SLOW, bool WIN, int MODE>
__device__ __forceinline__ void att_block(const LAS unsigned char* Kb, const LAS unsigned char* Vb, const abf16x8 (&Qf)[4], const AttLane& A, f32x16 (&O)[2], float& lsum, const float m2,
                                          const int kp0, const int kstride, LAS float* improw, const int gbase, float& icar) {
    f32x16 S0, S1; unsigned Pk[2][8];
    att_qk(Kb, Qf, A, S0, S1);
    att_sm<SLOW, WIN, MODE>(S0, S1, A, Pk, lsum, m2, kp0, kstride, improw, gbase, icar);
    if (MODE >= 1) att_pv(Vb, A, Pk, O);
}
struct AttStage { v4u k, v; };
__device__ __forceinline__ void att_fetch_k(AttStage& R, const bf16* Kg, int tid) { const int r = tid >> 3, c = tid & 7; R.k = *(const v4u*)(Kg + (size_t)r * HD + c * 8); }
__device__ __forceinline__ void att_fetch_v(AttStage& R, const bf16* VTg, int ldv, int tid) { const int r = tid >> 3, c = tid & 7; R.v = *(const v4u*)(VTg + (size_t)r * ldv + c * 8); }
__device__ __forceinline__ void att_put_k(const AttStage& R, LAS unsigned char* lds, int buf, int tid) { const int r = tid >> 3, c = tid & 7; *(LAS v4u*)(lds + ATT_KB + buf * 8192 + (r * 8 + (c ^ ((r >> 1) & 7))) * 16) = R.k; }
__device__ __forceinline__ void att_put_v(const AttStage& R, LAS unsigned char* lds, int buf, int tid) { const int r = tid >> 3, c = tid & 7; *(LAS v4u*)(lds + ATT_VB + buf * 8192 + (r * 8 + (c ^ ((r >> 1) & 7))) * 16) = R.v; }
__device__ __forceinline__ void att_put_c(const AttStage& R, LAS unsigned char* lds, int tid) { const int r = tid >> 3, c = tid & 7; const int o = (r * 8 + (c ^ ((r >> 1) & 7))) * 16;
    *(LAS v4u*)(lds + ATT_CK + o) = R.k; *(LAS v4u*)(lds + ATT_CV + o) = R.v; }
__device__ __forceinline__ void att_fetch(AttStage& R, const bf16* Kg, const bf16* VTg, int ldv, int tid) { att_fetch_k(R, Kg, tid); att_fetch_v(R, VTg, ldv, tid); }
__device__ __forceinline__ void att_put(const AttStage& R, LAS unsigned char* lds, int buf, int tid) { att_put_k(R, lds, buf, tid); att_put_v(R, lds, buf, tid); }
__device__ __forceinline__ void att_dma(const bf16* g, const int pitch, LAS unsigned char* dstw, const int tid) {
    const int r = tid >> 3, c = (tid & 7) ^ ((r >> 1) & 7);
    __builtin_amdgcn_global_load_lds((const unsigned*)(g + (size_t)r * pitch + c * 8), (LAS unsigned*)dstw, 16, 0, 0);
}
template <bool SLOW, bool WIN>
__device__ __forceinline__ void att_pipe_iter(LAS unsigned char* lds, const bf16* kg, const bf16* vg, const int i, const int j, const int jk, const int jv, const bool sel, const int wv,
                                              const abf16x8 (&Qf)[4], const AttLane& A, f32x16& S0, f32x16& S1, f32x16 (&O)[2], float& ls, const float m2, const int tid) {
    att_dma(kg + (size_t)jk * 64 * HD, HD, lds + ATT_KB + ((i + 3) & 3) * 8192 + wv * 1024, tid);
    att_dma(vg + jv * 64, SEQ, lds + ATT_VB + ((i + 2) % 3) * 8192 + wv * 1024, tid);
    const LAS unsigned char* Kc = lds + ATT_KB + (i & 3) * 8192; const LAS unsigned char* Kn = lds + ATT_KB + ((i + 1) & 3) * 8192; const LAS unsigned char* Vb = lds + ATT_VB + (i % 3) * 8192;
    if (__ballot(sel) != 0ull) {
        unsigned Pk0[8], Pk1[8];
        att_qk_half(Kc, 1, Qf, A, S1);
        att_sm_half<SLOW, WIN>(S0, 0, A, Pk0, ls, m2, 64 * j);
        __builtin_amdgcn_sched_barrier(0);
        att_qk_half(Kn, 0, Qf, A, S0);
        att_pv_half(Vb, 0, A, Pk0, O);
        att_sm_half<SLOW, WIN>(S1, 1, A, Pk1, ls, m2, 64 * j);
        att_pv_half(Vb, 1, A, Pk1, O);
    } else {
        att_qk_half(Kn, 0, Qf, A, S0);
    }
    asm volatile("s_waitcnt vmcnt(2)" ::: "memory");
    __builtin_amdgcn_s_barrier();
    asm volatile("" ::: "memory");
}
__device__ __forceinline__ void att_pipe_start(LAS unsigned char* lds, const bf16* kg, const bf16* vg, const int j0, const int j1, const int j2, const int wv, const abf16x8 (&Qf)[4], const AttLane& A, f32x16& S0, const int tid) {
    att_dma(kg + (size_t)j0 * 64 * HD, HD, lds + ATT_KB + 0 * 8192 + wv * 1024, tid); att_dma(vg + j0 * 64, SEQ, lds + ATT_VB + 0 * 8192 + wv * 1024, tid);
    att_dma(kg + (size_t)j1 * 64 * HD, HD, lds + ATT_KB + 1 * 8192 + wv * 1024, tid); att_dma(vg + j1 * 64, SEQ, lds + ATT_VB + 1 * 8192 + wv * 1024, tid);
    att_dma(kg + (size_t)j2 * 64 * HD, HD, lds + ATT_KB + 2 * 8192 + wv * 1024, tid);
    asm volatile("s_waitcnt vmcnt(0)" ::: "memory");
    __builtin_amdgcn_s_barrier();
    asm volatile("" ::: "memory");
    att_qk_half(lds + ATT_KB, 0, Qf, A, S0);
}
template <bool SLOW>
__device__ __forceinline__ void att_visit(const LAS unsigned char* Kb, const LAS unsigned char* Vb, const bf16* QNb, const int j, const int qi, const int grp, const int cnt,
                                          const LAS unsigned char* list, const LAS float* M2, LAS float* Oacc, LAS float* Lacc, const AttLane& A0, const int lane) {
    AttLane A = A0;
    const int sl = 8 * grp + ((lane & 31) >> 2); const bool valid = sl < cnt;
    const int tok = valid ? (int)list[sl] : 0; const int row = tok * 4 + A.hl;
    abf16x8 Qf[4];
#pragma unroll
    for (int ks = 0; ks < 4; ++ks) Qf[ks] = __builtin_bit_cast(abf16x8, *(const v4u*)(QNb + (size_t)tok * 512 + A.hl * HD + 16 * ks + 8 * A.h));
    const float m2 = valid ? M2[row] : 3.0e38f;
    A.t = qi * 64 + tok;
    f32x16 S0, S1, O[2]; unsigned Pk0[8], Pk1[8]; float ls = 0.f;
    att_qk_half(Kb, 0, Qf, A, S0); att_qk_half(Kb, 1, Qf, A, S1);
    att_sm_half<SLOW, false>(S0, 0, A, Pk0, ls, m2, 64 * j);
    att_pv_half<true>(Vb, 0, A, Pk0, O);
    att_sm_half<SLOW, false>(S1, 1, A, Pk1, ls, m2, 64 * j);
    att_pv_half<false>(Vb, 1, A, Pk1, O);
    ls += __shfl_xor(ls, 32);
    if (valid) {
        if (A.h == 0) (void)__hip_atomic_fetch_add((LAS int*)Lacc + row, __float2int_rn(ls * 1048576.0f), __ATOMIC_RELAXED, __HIP_MEMORY_SCOPE_WORKGROUP);
        LAS int* op = (LAS int*)Oacc + row * ATT_OACC_LD + 4 * A.h;
#pragma unroll
        for (int mt = 0; mt < 2; ++mt)
#pragma unroll
            for (int q = 0; q < 4; ++q) {
#pragma unroll
                for (int e = 0; e < 4; ++e) (void)__hip_atomic_fetch_add(op + 32 * mt + e + 8 * q, __float2int_rn(O[mt][4 * q + e] * 1048576.0f), __ATOMIC_RELAXED, __HIP_MEMORY_SCOPE_WORKGROUP);
                __builtin_amdgcn_sched_barrier(0); }
    }
}
__device__ __forceinline__ void phase_att(Ctx& C, int l) {
    const float* const gate_b = INP(16);
    const float* const k_norm_g = INP(12);
    bf16* PROJ = WSP(bf16, WS_PROJ); const bf16* QN = WSP(bf16, WS_QN); const bf16* KSN = WSP(bf16, WS_KSN); const bf16* KWN = WSP(bf16, WS_KWN);
    const bf16* VST = WSP(bf16, WS_VST); const bf16* VWT = WSP(bf16, WS_VWT); const bf16* KC = WSP(bf16, WS_KC); const bf16* VCT = WSP(bf16, WS_VC); const float* BT = WSP(float, WS_TAB);
    LAS unsigned char* lds = C.lds;
    LAS float* IMP = (LAS float*)(lds + ATT_IMP); LAS float* BTL = (LAS float*)(lds + ATT_BT); LAS unsigned* SELM = (LAS unsigned*)(lds + ATT_SELM);
    const int tid = C.tid, lane = C.lane, w = C.wave;
    const float c1 = 1.44269504089f;
    AttLane A; A.h = lane >> 5; A.hl = lane & 3; A.tokl = 8 * w + ((lane & 31) >> 2);
    { const int rho = lane & 31; const int key0 = (rho & 19) | ((rho & 4) << 1) | ((rho & 8) >> 1);
      const int fk = (key0 >> 1) & 7, fv = (rho >> 1) & 7;
#pragma unroll
      for (int s = 0; s < 1; ++s) { A.koff0 = (unsigned)(key0 * 128 + ((A.h ^ fk) << 4)); A.voff0 = (unsigned)(rho * 128 + ((A.h ^ fv) << 4)); } }
    A.btl = BTL + A.hl * 128;
    float kn; { float v = fabsf(k_norm_g[l * HD + lane]);
#pragma unroll
      for (int o = 1; o < 64; o <<= 1) v = fmaxf(v, __shfl_xor(v, o)); kn = 8.0f * 1.01f * v; }
    for (int slot = C.bid; slot < 1024; slot += C.G) {
        const int rr = slot >> 8, k32 = (slot & 255) >> 3, bg = slot & 7, b = bg >> 1, g = bg & 1;
        const int qi = (rr == 0) ? 127 - k32 : (rr == 1) ? 64 + k32 : (rr == 2) ? 63 - k32 : k32;
        const int head = g * HPG + A.hl; A.t = qi * 64 + A.tokl;
        bf16* const Pu = PROJ + ((size_t)b * SEQ + 64 * qi) * NPROJ; const bf16* const Qu = QN + ((size_t)b * SEQ + 64 * qi) * 512;
        const int pofs = A.tokl * NPROJ, qofs = A.tokl * 512 + head * HD + 8 * A.h;
        float* const finu = WSP(float, WS_FIN) + (size_t)C.bid * (512 * 32);
        __syncthreads();
        int tidq = tid; asm volatile("" : "+v"(tidq));
        BTL[tid] = BT[(g * HPG + (tid >> 7)) * 128 + (tid & 127)];
        abf16x8 Qf[4]; float qn2 = 0.f;
#pragma unroll
        for (int ks = 0; ks < 4; ++ks) { const v4u wq = *(const v4u*)(Qu + qofs + 16 * ks); Qf[ks] = __builtin_bit_cast(abf16x8, wq);
            qn2 += bflo(wq.x) * bflo(wq.x) + bfhi(wq.x) * bfhi(wq.x) + bflo(wq.y) * bflo(wq.y) + bfhi(wq.y) * bfhi(wq.y) + bflo(wq.z) * bflo(wq.z) + bfhi(wq.z) * bfhi(wq.z) + bflo(wq.w) * bflo(wq.w) + bfhi(wq.w) * bfhi(wq.w); }
        qn2 += __shfl_xor(qn2, 32);
        const float bmax = BT[NH * 128 + head];
        const float b31 = BT[head * 128 + 127];
        const float m2ref = (sqrtf(qn2) * kn + bmax) * c1;
        const float m2far = m2ref - b31 * c1;
        f32x16 O[2];
        AttStage R;
        const int nkb = (4 * qi + 3 + 63) >> 6;
        const bf16* kcg = KC + (size_t)bg * NCMPP * HD; const bf16* vcg = VCT + (size_t)bg * HD * NCMPP;
        float lc = 0.f;
#pragma unroll
        for (int i = 0; i < 16; ++i) { O[0][i] = 0.f; O[1][i] = 0.f; }
        float icar = 0.f;
        int rowq = A.tokl * 4 + A.hl; asm volatile("" : "+v"(rowq));
        LAS float* improw = IMP + rowq * ATT_IMP_LD;
        att_fetch(R, kcg, vcg, NCMPP, tidq);
        for (int kb = 0; kb < nkb; ++kb) {
            att_put_c(R, lds, tidq); __syncthreads();
            if (kb + 1 < nkb) att_fetch(R, kcg + (size_t)(kb + 1) * 64 * HD, vcg + (kb + 1) * 64, NCMPP, tidq);
            if (qi >= 16 * kb + 18) att_block<false, false, 3>(lds + ATT_CK, lds + ATT_CV, Qf, A, O, lc, m2far, 0, 0, improw, 16 * kb + 2 * A.h, icar);
            else att_block<true, false, 3>(lds + ATT_CK, lds + ATT_CV, Qf, A, O, lc, m2ref, 1024 * kb + 31, 16, improw, 16 * kb + 2 * A.h, icar);
            __syncthreads();
        }
        lc += __shfl_xor(lc, 32);
        const float rl = lc > 0.f ? 1.0f / lc : 0.f;
        if (A.h == 0) ((LAS float*)(lds + ATT_RL))[rowq] = rl;
#pragma unroll
        for (int q = 0; q < 4; ++q) { f32x4* fin = (f32x4*)(finu + tid * 32);
            const float gate0 = rl * sigmoid_f(bf2f(Pu[pofs + C_GT + 0 * NH + head]) + gate_b[l * 24 + 0 * NH + head]);
            fin[q] = (f32x4){gate0 * O[0][4 * q], gate0 * O[0][4 * q + 1], gate0 * O[0][4 * q + 2], gate0 * O[0][4 * q + 3]};
            fin[4 + q] = (f32x4){gate0 * O[1][4 * q], gate0 * O[1][4 * q + 1], gate0 * O[1][4 * q + 2], gate0 * O[1][4 * q + 3]}; }
        __builtin_amdgcn_fence(__ATOMIC_RELEASE, "wavefront"); __builtin_amdgcn_wave_barrier(); __builtin_amdgcn_fence(__ATOMIC_ACQUIRE, "wavefront"); asm volatile("" ::: "memory");
        if (qi < 16) { if ((lane & 3) == 0 && lane < 32) { LAS unsigned* sm = SELM + A.tokl * 4; sm[0] = (qi == 31) ? 0xffffffffu : ((2u << qi) - 1u); sm[1] = 0u; sm[2] = 0u; sm[3] = 0u; } }
        else {
            for (int rd = 0; rd < 2; ++rd) {
                const int tk = 8 * w + 4 * rd + (lane >> 4), l16 = lane & 15; const LAS float* ir = IMP + tk * 4 * ATT_IMP_LD;
                const LAS float* rlp = (const LAS float*)(lds + ATT_RL) + tk * 4; const float r4[4] = {rlp[0], rlp[1], rlp[2], rlp[3]};
                unsigned key[8];
#pragma unroll
                for (int k = 0; k < 8; ++k) { const int j = l16 + 16 * k;
                    const unsigned bits = __float_as_uint((r4[0] * ir[j] + r4[1] * ir[ATT_IMP_LD + j]) + (r4[2] * ir[2 * ATT_IMP_LD + j] + r4[3] * ir[3 * ATT_IMP_LD + j]));
                    key[k] = (j < qi) ? ((bits & 0xFFFFFF80u) | (unsigned)(127 - j)) : 0u; }
                for (int it = 0; it < 15; ++it) {
                    unsigned mx = key[0];
#pragma unroll
                    for (int k = 1; k < 8; ++k) mx = key[k] > mx ? key[k] : mx;
                    mx = row16_max(mx);
#pragma unroll
                    for (int k = 0; k < 8; ++k) key[k] = (key[k] == mx) ? 0u : key[k];
                }
                unsigned mw[4];
#pragma unroll
                for (int wd = 0; wd < 4; ++wd) { const int j0 = l16 + 32 * wd, j1 = j0 + 16; unsigned v = 0u;
                    if (j0 < qi && key[2 * wd] == 0u) v |= 1u << l16; if (j1 < qi && key[2 * wd + 1] == 0u) v |= 1u << (l16 + 16); mw[wd] = row16_or(v); }
#pragma unroll
                for (int wd = 0; wd < 4; ++wd) mw[wd] |= ((qi >> 5) == wd) ? (1u << (qi & 31)) : 0u;
                if (l16 == 0) { LAS unsigned* sm = SELM + tk * 4; sm[0] = mw[0]; sm[1] = mw[1]; sm[2] = mw[2]; sm[3] = mw[3]; }
            }
        }
        {
            LAS float* Oacc = (LAS float*)(lds + ATT_OACC); LAS float* Lacc = (LAS float*)(lds + ATT_L); LAS unsigned char* LIST = lds + ATT_LIST; LAS int* CNTL = (LAS int*)(lds + ATT_CNT);
            LAS float* M2F = (LAS float*)(lds + ATT_M2F); LAS float* M2R = (LAS float*)(lds + ATT_M2R);
            const bf16* kg = KSN + (size_t)bg * SEQ * HD; const bf16* vg = VST + (size_t)bg * HD * SEQ;
            const bf16* QNb = QN + ((size_t)b * SEQ + 64 * qi) * 512 + g * HPG * HD;
            const int nfast = qi >= 2 ? qi - 2 : 0, nb = qi + 1, nch = (nb + 1) >> 1;
#define SLC_SEQ(i) ((i) >= nb ? qi : ((i) < nfast ? (i) : qi - ((i) - nfast)))
            __syncthreads();
            { const unsigned mw0 = SELM[lane * 4 + 0], mw1 = SELM[lane * 4 + 1], mw2 = SELM[lane * 4 + 2], mw3 = SELM[lane * 4 + 3];
              for (int j = w; j <= qi; j += 8) {
                  const int wd = j >> 5; const unsigned mwj = wd == 0 ? mw0 : wd == 1 ? mw1 : wd == 2 ? mw2 : mw3;
                  const bool bit = (mwj >> (j & 31)) & 1u; const unsigned long long mk = __ballot(bit);
                  const unsigned rank = __builtin_amdgcn_mbcnt_hi((unsigned)(mk >> 32), __builtin_amdgcn_mbcnt_lo((unsigned)mk, 0u));
                  if (bit) LIST[j * 64 + rank] = (unsigned char)lane;
                  if (lane == 0) CNTL[j] = __popcll(mk); } }
            if (A.h == 0) { M2F[rowq] = m2far; M2R[rowq] = m2ref; }
            for (int i = tid; i < 256 * ATT_OACC_LD + 256; i += NTHR) Oacc[i] = 0.f;
            asm volatile("s_waitcnt vmcnt(0)" ::: "memory"); __syncthreads();
            const int nch4 = (nb + 3) >> 2;
            for (int c = 0; c < nch4; ++c) {
#pragma unroll
                for (int q = 0; q < 4; ++q) { const int jq = SLC_SEQ(4 * c + q);
                    att_dma(kg + (size_t)jq * 64 * HD, HD, lds + ATT_KB + q * 8192 + w * 1024, tidq); att_dma(vg + jq * 64, SEQ, lds + ATT_VB + q * 8192 + w * 1024, tidq); }
                int jb[4], cb[4], nvb[4]; int tot = 0;
#pragma unroll
                for (int q = 0; q < 4; ++q) { jb[q] = SLC_SEQ(4 * c + q); cb[q] = (4 * c + q < nb) ? CNTL[jb[q]] : 0; nvb[q] = (cb[q] + 7) >> 3; tot += nvb[q]; }
                asm volatile("s_waitcnt vmcnt(0)" ::: "memory"); __syncthreads();
                for (int v = w; v < tot; v += 8) {
                    int q = 0, vv = v;
                    if (vv >= nvb[0]) { vv -= nvb[0]; q = 1; if (vv >= nvb[1]) { vv -= nvb[1]; q = 2; if (vv >= nvb[2]) { vv -= nvb[2]; q = 3; } } }
                    const int j = q == 0 ? jb[0] : q == 1 ? jb[1] : q == 2 ? jb[2] : jb[3]; const int cn = q == 0 ? cb[0] : q == 1 ? cb[1] : q == 2 ? cb[2] : cb[3];
                    const bool slow = (4 * c + q) >= nfast;
                    const LAS unsigned char* Kb = lds + ATT_KB + q * 8192; const LAS unsigned char* Vb = lds + ATT_VB + q * 8192;
                    if (slow) att_visit<true>(Kb, Vb, QNb, j, qi, vv, cn, LIST + j * 64, M2R, Oacc, Lacc, A, lane);
                    else att_visit<false>(Kb, Vb, QNb, j, qi, vv, cn, LIST + j * 64, M2F, Oacc, Lacc, A, lane);
                }
                __syncthreads();
            }
#undef SLC_SEQ
        }
        {
#pragma unroll
            for (int i = 0; i < 16; ++i) { O[0][i] = 0.f; O[1][i] = 0.f; }
            float lw = 0.f;
            const bf16* kg = KWN + (size_t)bg * SEQ * HD; const bf16* vg = VWT + (size_t)bg * HD * SEQ;
#pragma unroll
            for (int ks = 0; ks < 4; ++ks) Qf[ks] = __builtin_bit_cast(abf16x8, *(const v4u*)(Qu + qofs + 16 * ks));
            const int f0 = qi >= 7 ? qi - 7 : 0, nfast = qi >= 3 ? qi - 3 - f0 + 1 : 0, nslow = 1 + (qi >= 1) + (qi >= 2) + (qi >= 8), nb = nfast + nslow;
#define WIN_SEQ(i) ((i) >= nb ? qi : ((i) < nfast ? f0 + (i) : (((i) - nfast) < 3 ? qi - ((i) - nfast) : qi - 8)))
#ifndef ATT_REP_WIN
#define ATT_REP_WIN 1
#endif
#pragma unroll
            for (int rep = 0; rep < ATT_REP_WIN; ++rep) {
            f32x16 S0, S1;
            att_pipe_start(lds, kg, vg, WIN_SEQ(0), WIN_SEQ(1), WIN_SEQ(2), w, Qf, A, S0, tidq);
            for (int i = 0; i < nfast; ++i) {
                att_pipe_iter<false, true>(lds, kg, vg, i, f0 + i, WIN_SEQ(i + 3), WIN_SEQ(i + 2), true, w, Qf, A, S0, S1, O, lw, m2far, tidq);
            }
            for (int i = nfast; i < nb; ++i) {
                att_pipe_iter<true, true>(lds, kg, vg, i, WIN_SEQ(i), WIN_SEQ(i + 3), WIN_SEQ(i + 2), true, w, Qf, A, S0, S1, O, lw, m2ref, tidq);
            }
            asm volatile("s_waitcnt vmcnt(0)" ::: "memory"); __syncthreads();
            }
#undef WIN_SEQ
            lw += __shfl_xor(lw, 32);
            const float gate1 = sigmoid_f(bf2f(Pu[pofs + C_GT + 1 * NH + head]) + gate_b[l * 24 + 1 * NH + head]);
            const float gate2 = sigmoid_f(bf2f(Pu[pofs + C_GT + 2 * NH + head]) + gate_b[l * 24 + 2 * NH + head]);
            const f32x4* fin = (const f32x4*)(finu + tid * 32);
            const float sc = lw > 0.f ? gate2 / lw : 0.f;
#pragma unroll
            for (int i = 0; i < 16; ++i) { O[0][i] = sc * O[0][i]; O[1][i] = sc * O[1][i]; }
#pragma unroll
            for (int q = 0; q < 4; ++q) {
                const f32x4 f0 = fin[q], f1 = fin[4 + q];
#pragma unroll
                for (int e = 0; e < 4; ++e) { O[0][4 * q + e] += f0[e]; O[1][4 * q + e] += f1[e]; }
                asm volatile("" ::: "memory"); }
            { const int row = A.tokl * 4 + A.hl; const int lsel = ((const LAS int*)(lds + ATT_L))[row]; const float s1 = lsel > 0 ? gate1 / (float)lsel : 0.f;
              const LAS int* oa = (const LAS int*)(lds + ATT_OACC) + row * ATT_OACC_LD + 4 * A.h;
#pragma unroll
              for (int mt = 0; mt < 2; ++mt)
#pragma unroll
                  for (int i = 0; i < 16; ++i) O[mt][i] += s1 * (float)oa[32 * mt + (i & 3) + 8 * (i >> 2)]; }
            bf16* op = Pu + (pofs + C_Q + head * HD + 4 * A.h);
#pragma unroll
            for (int mt = 0; mt < 2; ++mt)
#pragma unroll
                for (int q4 = 0; q4 < 4; ++q4) { v2u o; o.x = pg8::cvt_pk_bf16(O[mt][4 * q4], O[mt][4 * q4 + 1]); o.y = pg8::cvt_pk_bf16(O[mt][4 * q4 + 2], O[mt][4 * q4 + 3]); *(v2u*)(op + 32 * mt + 8 * q4) = o; }
            { float ss = 0.f;
#pragma unroll
              for (int i = 0; i < 16; ++i) ss += O[0][i] * O[0][i] + O[1][i] * O[1][i];
              ss += __shfl_xor(ss, 32);
              if (A.h == 0) WSP(float, WS_SSQA)[((size_t)b * SEQ + A.t) * 8 + head] = ss; }
        }
    }
    __syncthreads();
}
__device__ __forceinline__ void phase_norm2_router(Ctx& C, int l, int li  ) {
    const float* const norm2_g = INP(19);
    const float* const router_w = INP(23);
    const bf16* XB = WSP(bf16, WS_HN);
    int* TOPE = WSP(int, WS_TOPE); float* TOPW = WSP(float, WS_TOPW); int* POS = WSP(int, WS_POS);
    unsigned* CNT = WSP(unsigned, WS_CTL) + CW_MOECNT;
    LAS unsigned* lcnt = (LAS unsigned*)C.lds;
    const int lane = C.lane;
    float rwl[16][8];
#pragma unroll
    for (int j = 0; j < 2; ++j)
#pragma unroll
        for (int i = 0; i < 8; ++i) { const int ch = 512 * j + 8 * lane + i; const float gch = norm2_g[l * D + ch]; const float* wr = router_w + ((size_t)li * D + ch) * NE;
#pragma unroll
            for (int e = 0; e < 8; ++e) rwl[8 * j + i][e] = gch * wr[e]; }
    for (int blk = C.bid; blk < M / 128; blk += C.G) {
        __syncthreads();
        if (C.tid < 32) lcnt[C.tid] = 0u;
        __syncthreads();
        v4u nx0 = *(const v4u*)(XB + (size_t)(blk * 128 + C.wave * 16) * D + 8 * lane), nx1 = *(const v4u*)(XB + (size_t)(blk * 128 + C.wave * 16) * D + 512 + 8 * lane);
        for (int rr = 0; rr < 16; ++rr) {
            const int m = blk * 128 + C.wave * 16 + rr;
            const v4u w0v = nx0, w1v = nx1;
            if (rr + 1 < 16) { nx0 = *(const v4u*)(XB + (size_t)(m + 1) * D + 8 * lane); nx1 = *(const v4u*)(XB + (size_t)(m + 1) * D + 512 + 8 * lane); }
            const float xv[16] = {bflo(w0v.x), bfhi(w0v.x), bflo(w0v.y), bfhi(w0v.y), bflo(w0v.z), bfhi(w0v.z), bflo(w0v.w), bfhi(w0v.w),
                                  bflo(w1v.x), bfhi(w1v.x), bflo(w1v.y), bfhi(w1v.y), bflo(w1v.z), bfhi(w1v.z), bflo(w1v.w), bfhi(w1v.w)};
            float s = 0.f, lg[8];
#pragma unroll
            for (int e = 0; e < 8; ++e) lg[e] = 0.f;
#pragma unroll
            for (int i = 0; i < 16; ++i) { s += xv[i] * xv[i];
#pragma unroll
                for (int e = 0; e < 8; ++e) lg[e] += xv[i] * rwl[i][e]; }
            const float rstd = 1.0f / sqrtf(wave_sum(s) * (1.f / D) + RMS_EPS);
#pragma unroll
            for (int e = 0; e < 8; ++e) lg[e] = wave_sum(lg[e]) * rstd;
            int e0 = 0; float v0 = lg[0];
#pragma unroll
            for (int e = 1; e < 8; ++e) if (lg[e] > v0) { v0 = lg[e]; e0 = e; }
            int e1 = -1; float v1 = -3.0e38f;
#pragma unroll
            for (int e = 0; e < 8; ++e) if (e != e0 && lg[e] > v1) { v1 = lg[e]; e1 = e; }
            const float w0 = 1.0f / (1.0f + __expf(v1 - v0)), w1 = 1.0f - w0;
            if (lane == 0) {
                const unsigned p0 = atomicAdd((unsigned*)&lcnt[e0], 1u), p1 = atomicAdd((unsigned*)&lcnt[8 + e1], 1u);
                TOPE[m] = e0; TOPE[M + m] = e1; TOPW[m] = w0; TOPW[M + m] = w1; POS[m] = (int)p0; POS[M + m] = (int)p1; WSP(float, WS_RSTD)[m] = rstd;
            }
        }
        __syncthreads();
        if (C.tid < 16) lcnt[16 + C.tid] = atomicAdd(&CNT[C.tid], lcnt[C.tid]);
        __syncthreads();
        if (C.tid < 128) { const int m = blk * 128 + C.tid; POS[m] += (int)lcnt[16 + TOPE[m]]; POS[M + m] += (int)lcnt[24 + TOPE[M + m]]; }
    }
    __syncthreads();
}
__device__ __forceinline__ void phase_route2(Ctx& C) {
    const unsigned* CNT = WSP(unsigned, WS_CTL) + CW_MOECNT; int* META = WSP(int, WS_META);
    const int* TOPE = WSP(int, WS_TOPE); const float* TOPW = WSP(float, WS_TOPW); const int* POS = WSP(int, WS_POS);
    int* RT = WSP(int, WS_ROWTOK); float* RW = WSP(float, WS_ROWW);
    LAS int* off = (LAS int*)C.lds;
    __syncthreads();
    if (C.tid < 2) { int o = 0; for (int e = 0; e < NE; ++e) { off[C.tid * 9 + e] = o; o += (int)((CNT[C.tid * 8 + e] + 255u) & ~255u); } off[C.tid * 9 + 8] = o; }
    __syncthreads();
    if (C.bid == 0) {
        if (C.tid < 2) { for (int e = 0; e < 9; ++e) META[C.tid * 512 + e] = (e < 8) ? off[C.tid * 9 + e] : off[C.tid * 9 + 8] / 256; }
        if (C.tid < 2 * MOE_PANELS) { const int r = C.tid / MOE_PANELS, p = C.tid % MOE_PANELS; int e = 0; for (int k = 1; k < NE; ++k) if (p * 256 >= off[r * 9 + k]) e = k; META[r * 512 + 16 + p] = e; }
    }
    const int gt = C.bid * NTHR + C.tid, NGT = C.G * NTHR;
    for (int i = gt; i < 2 * M; i += NGT) { const int r = i / M; const int m = i % M; const int row = off[r * 9 + TOPE[i]] + POS[i]; RT[r * MOE_ROWS + row] = m; RW[r * MOE_ROWS + row] = TOPW[i]; WSP(float, WS_ROWRS)[r * MOE_ROWS + row] = WSP(float, WS_RSTD)[m]; }
    __syncthreads();
}
__device__ __forceinline__ void moe_scatter(Ctx& C, int r) {
    const unsigned* CNT = WSP(unsigned, WS_CTL) + CW_MOECNT; const int* TOPE = WSP(int, WS_TOPE) + r * M; const int* POS = WSP(int, WS_POS) + r * M;
    const bf16* XBs = WSP(bf16, WS_HN); unsigned char* XBUF = WSP(unsigned char, WS_XBUF);
    const int gw = C.bid * NWAVES + C.wave, NGW = C.G * NWAVES, lane = C.lane;
    int off[9]; { int o = 0;
#pragma unroll
        for (int e = 0; e < NE; ++e) { off[e] = o; o += (int)((CNT[r * 8 + e] + 255u) & ~255u); } off[8] = o; }
    for (int m0 = gw * 4; m0 < M; m0 += NGW * 4) {
        v4u a[4], b[4]; int row[4];
#pragma unroll
        for (int q = 0; q < 4; ++q) { const int m = m0 + q; const int e = TOPE[m]; int o = off[0];
#pragma unroll
            for (int k = 1; k < NE; ++k) o = (e == k) ? off[k] : o;
            row[q] = o + POS[m]; const v4u* s = (const v4u*)(XBs + (size_t)m * D); a[q] = s[2 * lane]; b[q] = s[2 * lane + 1]; }
#pragma unroll
        for (int q = 0; q < 4; ++q) { v4u o;
            o.x = pk4_fp8(bflo(a[q].x), bfhi(a[q].x), bflo(a[q].y), bfhi(a[q].y)); o.y = pk4_fp8(bflo(a[q].z), bfhi(a[q].z), bflo(a[q].w), bfhi(a[q].w));
            o.z = pk4_fp8(bflo(b[q].x), bfhi(b[q].x), bflo(b[q].y), bfhi(b[q].y)); o.w = pk4_fp8(bflo(b[q].z), bfhi(b[q].z), bflo(b[q].w), bfhi(b[q].w));
            ((v4u*)(XBUF + (size_t)row[q] * D))[lane] = o; }
    }
#pragma unroll
    for (int e = 0; e < NE; ++e) { const int p0 = off[e] + (int)CNT[r * 8 + e], p1 = off[e + 1];
        for (int row = p0 + gw; row < p1; row += NGW) ((v4u*)(XBUF + (size_t)row * D))[lane] = (v4u){0u, 0u, 0u, 0u}; }
}


#ifndef DUP_MASK
#define DUP_MASK 0
#endif
#define DUPRUN(bit, ...) do { __VA_ARGS__; if constexpr ((DUP_MASK >> (bit)) & 1) { xcd_barrier(bar); __VA_ARGS__; } } while (0)
#define IN(k) (lo <= (k) && (k) < hi)
#define SEAM(k) do { if (IN(k) && IN((k) + 1)) xcd_barrier(bar); } while (0)
template <int R>
__device__ __forceinline__ void moe_rank(Ctx& C, const XcdBarrier& bar, int lo, int hi, PG8_LAS unsigned char* glds) {
    constexpr int r = R; constexpr int pr = 15 + 2 * R;
    const int* META = WSP(int, WS_META) + r * 512;
    if (IN(pr)) {
        const int npan = META[8];
        pg8::Gemm g{WSP(pg8::bf16_t, WS_XBUF), WSP(pg8::bf16_t, WS_MGU), MOE_ROWS, NGU, D / 2}; pg8::StaticOrder S; S.init(npan, NGU / 256, C.G, C.bid); S.pexp = META + 16; S.estride = (size_t)NGU * D;
        pg8::EpiSwiGLU<2> E{WSP(pg8::bf16_t, WS_HID), FF, WSP(float, WS_ROWRS) + r * MOE_ROWS, nullptr};
        DUPRUN(10, pg8::gemm_phase<pg8::EpiSwiGLU<2>, pg8::StaticOrder, true, true, true>(glds, g, S, E));
    } SEAM(pr);
    if (IN(pr + 1)) {
        const int npan = META[8];
        pg8::Gemm g{WSP(pg8::bf16_t, WS_HID), WSP(pg8::bf16_t, WS_MD), MOE_ROWS, D, FF / 2}; pg8::StaticOrder S; S.init(npan, D / 256, C.G, C.bid); S.pexp = META + 16; S.estride = (size_t)D * FF;
        pg8::EpiMoeDown<R == 0> E{WSP(int, WS_ROWTOK) + r * MOE_ROWS, WSP(float, WS_ROWW) + r * MOE_ROWS, C.out, D, WSP(pg8::bf16_t, WS_HN)};
        pg8::gemm_phase<pg8::EpiMoeDown<R == 0>, pg8::StaticOrder, true, true, true, 0x7c7c7c7c>(glds, g, S, E);
        if constexpr (R == 0) moe_scatter(C, 1);
    } SEAM(pr + 1);
}
template <int L>
__device__ __forceinline__ void layer_phases(Ctx& C, const XcdBarrier& bar, int lo, int hi, PG8_LAS unsigned char* glds) {
    constexpr int l = L; constexpr int pb = (L == 0) ? 1 : 8;
    if (IN(pb + 0)) {
        pg8::StaticOrder S; S.init(M / 256, NPROJ / 256, C.G, C.bid);
        pg8::EpiBf16<true> E{WSP(pg8::bf16_t, WS_PROJ), NPROJ, WSP(float, WS_SSQ)};
        if constexpr (INPROJ_FP8(L)) { pg8::Gemm g{WSP(pg8::bf16_t, WS_QN), WSP(pg8::bf16_t, WS_WIN) + (size_t)l * NPROJ * D, M, NPROJ, D / 2};
            pg8::gemm_phase<pg8::EpiBf16<true>, pg8::StaticOrder, true, true, true>(glds, g, S, E); }
        else { pg8::Gemm g{WSP(pg8::bf16_t, WS_HN), WSP(pg8::bf16_t, WS_WIN) + (size_t)l * NPROJ * D, M, NPROJ, D};
        DUPRUN(1, pg8::gemm_phase<pg8::EpiBf16<true>, pg8::StaticOrder, true, true>(glds, g, S, E)); }
    } SEAM(pb + 0);
    if (IN(pb + 1)) { DUPRUN(2, prep_qknorm(C, l)); DUPRUN(3, prep_compress(C, l)); DUPRUN(4, lru_chunks<1>(C, l)); } SEAM(pb + 1);
    if (IN(pb + 2)) { lru_carry(C); DUPRUN(5, phase_att(C, l)); } SEAM(pb + 2);
    if (IN(pb + 3)) { lru_chunks<2>(C, l); } SEAM(pb + 3);
    if (IN(pb + 4)) {
        pg8::Gemm g{WSP(pg8::bf16_t, WS_PROJ) + C_LG, WSP(pg8::bf16_t, WS_WOUT) + (size_t)l * D * D, M, D, D, NPROJ, 0}; pg8::StaticOrder S; S.init(M / 256, D / 256, C.G, C.bid);
        PG8_LAS pg8::f32x2t* T = (PG8_LAS pg8::f32x2t*)(glds + 131072 + 1024);
        { pg8::Unit uu; for (int i = 0; S.next(i, uu) && i < 4; ++i) if (C.tid < 256) { const int row = uu.pm * 256 + C.tid;
              const float rl = pg8::rstd512(WSP(float, WS_SSQL), row), ra = pg8::rstd512(WSP(float, WS_SSQA), row); T[i * 256 + C.tid] = (pg8::f32x2t){rl / ra, ra}; }
          __syncthreads(); }
        const pg8::MidRatio Mi{T};
        pg8::EpiResBf16Norm<true> E{WSP(pg8::bf16_t, WS_HN), WSP(pg8::bf16_t, WS_HN), D, WSP(float, WS_SSQ), (l == 0) ? WSP(unsigned char, WS_QN) : nullptr, T};
        pg8::gemm_phase<pg8::EpiResBf16Norm<true>, pg8::StaticOrder, true, true, false, 0x7f7f7f7f, pg8::MidRatio>(glds, g, S, E, Mi);
    } SEAM(pb + 4);
    if constexpr (L == 0) {
        if (IN(6)) {
            pg8::Gemm g{WSP(pg8::bf16_t, WS_QN), WSP(pg8::bf16_t, WS_FGU), M, NGU, D / 2}; pg8::StaticOrder S; S.init(M / 256, NGU / 256, C.G, C.bid);
            pg8::EpiSwiGLU<1, true> E{WSP(pg8::bf16_t, WS_HID), FF, WSP(float, WS_SSQ), nullptr};
            DUPRUN(9, pg8::gemm_phase<pg8::EpiSwiGLU<1, true>, pg8::StaticOrder, true, true, true>(glds, g, S, E));
        } SEAM(6);
        if (IN(7)) {
            pg8::Gemm g{WSP(pg8::bf16_t, WS_HID), WSP(pg8::bf16_t, WS_FD), M, D, FF / 2}; pg8::StaticOrder S; S.init(M / 256, D / 256, C.G, C.bid);
            pg8::EpiResBf16Norm<false> E{WSP(pg8::bf16_t, WS_HN), WSP(pg8::bf16_t, WS_HN), D, WSP(float, WS_SSQ), INPROJ_FP8(1) ? WSP(unsigned char, WS_QN) : nullptr};
            if constexpr ((DUP_MASK >> 13) & 1) { pg8::EpiProbeSum EP{WSP(float, WS_MIX)}; pg8::gemm_phase<pg8::EpiProbeSum, pg8::StaticOrder, true, true>(glds, g, S, EP); xcd_barrier(bar); }
            pg8::gemm_phase<pg8::EpiResBf16Norm<false>, pg8::StaticOrder, true, true, true, 0x7c7c7c7c>(glds, g, S, E);
        } SEAM(7);
    } else {
        if (IN(13)) { phase_norm2_router(C, l, 0); } SEAM(13);
        if (IN(14)) { phase_route2(C); moe_scatter(C, 0); } SEAM(14);
        moe_rank<0>(C, bar, lo, hi, glds); moe_rank<1>(C, bar, lo, hi, glds);
    }
}
#undef IN
#undef SEAM
__global__ void __launch_bounds__(NTHR, 2) fwd(Args args) {
    extern __shared__ __attribute__((aligned(16))) unsigned char lds[];
    Ctx C;
    C.lds = (LAS unsigned char*)lds; C.ws = args.ws; C.out = args.out;
    C.tid = threadIdx.x; C.lane = C.tid & 63; C.wave = __builtin_amdgcn_readfirstlane(C.tid >> 6); C.G = gridDim.x; C.bid = blockIdx.x;
    volatile LAS unsigned* MISC = (volatile LAS unsigned*)(C.lds + MISC_OFF);
    if (C.tid < 64) ((LAS unsigned*)(C.lds + MISC_OFF))[C.tid] = 0u;
    __syncthreads();
    XcdBarrier bar; bar.bar = WSP(unsigned, WS_CTL) + CW_BAR; bar.x = 0; bar.st = nullptr;
    if (args.use_bar) bar = xcd_barrier_post(WSP(unsigned, WS_CTL) + CW_BAR, MISC + 8);
    const int lo = args.ph_lo, hi = args.ph_hi;
#define IN(k) (lo <= (k) && (k) < hi)
#define SEAM(k) do { if (IN(k) && IN((k) + 1)) xcd_barrier(bar); } while (0)
    PG8_LAS unsigned char* glds = (PG8_LAS unsigned char*)lds;

        if (IN(0)) { DUPRUN(0, phase_prologue(C)); } SEAM(0);
    layer_phases<0>(C, bar, lo, hi, glds);
    layer_phases<1>(C, bar, lo, hi, glds);
#undef IN
#undef SEAM
}

constexpr int N_PHASES = 19;
extern "C" void kernel_launch(void* const* d_in, const int* in_sizes, int n_in, void* d_out, int out_size, void* d_ws, size_t ws_size, hipStream_t stream) {
    static int grid = 0;
    if (grid == 0) {
        if (n_in != 27 || in_sizes[0] != M * D || out_size != M * D || ws_size < WS_END) { fprintf(stderr, "kernel_launch: unexpected shapes (n_in %d, in0 %d, out %d, ws %zu); nothing launched\n", n_in, n_in > 0 ? in_sizes[0] : -1, out_size, ws_size); grid = -1; return; }
        int dev = 0, cus = 0;
        if (hipGetDevice(&dev) != hipSuccess || hipDeviceGetAttribute(&cus, hipDeviceAttributeMultiprocessorCount, dev) != hipSuccess) { grid = -1; return; }
        if (hipFuncSetAttribute((const void*)fwd, hipFuncAttributeMaxDynamicSharedMemorySize, LDS_BYTES) != hipSuccess) { fprintf(stderr, "kernel_launch: hipFuncSetAttribute failed\n"); grid = -1; return; }
        int per_cu = 0;
        if (hipOccupancyMaxActiveBlocksPerMultiprocessor(&per_cu, (const void*)fwd, NTHR, LDS_BYTES) != hipSuccess || per_cu < 1) fprintf(stderr, "kernel_launch: occupancy query says %d\n", per_cu);
        (void)hipGetLastError();
        grid = cus;
    }
    if (grid < 0) return;
    if (hipMemsetAsync((char*)d_ws + WS_CTL, 0, CTL_ZERO_BYTES, stream) != hipSuccess) return;
    Args a{};
    for (int i = 0; i < 27; ++i) a.in[i] = (const float*)d_in[i];
    a.out = (float*)d_out; a.ws = (unsigned char*)d_ws; a.pad = 0;
#ifndef MK_SPLIT
#define MK_SPLIT 0
#endif
#if MK_SPLIT
    for (int p = 0; p < N_PHASES; ++p) { a.ph_lo = p; a.ph_hi = p + 1; a.use_bar = 0; hipLaunchKernelGGL(fwd, dim3(grid), dim3(NTHR), LDS_BYTES, stream, a); }
#else
    a.ph_lo = 0; a.ph_hi = N_PHASES; a.use_bar = 1; hipLaunchKernelGGL(fwd, dim3(grid), dim3(NTHR), LDS_BYTES, stream, a);
#endif
}
```
